# Optimizing an MI355X kernel written in HIP

```python
import math
import jax, jax.numpy as jnp
from jax import lax
import numpy as np

D_MODEL = 2048
BATCH = 2
SEQ = 16384
DEPTH = 2

CHUNK = 64
Q_BLOCK = 128
N_A_LAYERS = DEPTH // 2
N_B_LAYERS = DEPTH - N_A_LAYERS
HEAD_DIM = 128
DIFF_HEADS = D_MODEL // (2 * HEAD_DIM)
DIFF_VDIM = 2 * HEAD_DIM
FOX_HEADS = D_MODEL // HEAD_DIM
D_FF = 4 * D_MODEL
REL_BUCKETS = 32
REL_MAX_DIST = 128
NORM_EPS = 1e-6
SUBLN_EPS = 1e-5
NEG = -1e30

kernel_name = "yoco_diffattn_fox_hybrid"


def rmsnorm(x, g, eps=NORM_EPS):
    xf = x.astype(jnp.float32)
    y = xf * lax.rsqrt(jnp.mean(xf * xf, axis=-1, keepdims=True) + eps)
    return (y * g.astype(jnp.float32)).astype(x.dtype)


def t5_bucket(rel):
    half = REL_BUCKETS // 2
    max_exact = half // 2
    ret = jnp.where(rel > 0, half, 0)
    n = jnp.abs(rel)
    nf = jnp.maximum(n, 1).astype(jnp.float32)
    large = max_exact + (jnp.log(nf / max_exact) / math.log(REL_MAX_DIST / max_exact)
                         * (half - max_exact)).astype(jnp.int32)
    large = jnp.minimum(large, half - 1)
    return ret + jnp.where(n < max_exact, n, large)


def diff_attention(h, w_qkv, lq1, lk1, lq2, lk2, subln_g, rel_table, lambda_init):
    B, S, _ = h.shape
    nb = S // Q_BLOCK
    q, k, v = jnp.split(h @ w_qkv, 3, axis=-1)
    q = q.reshape(B, nb, Q_BLOCK, DIFF_HEADS, 2, HEAD_DIM).transpose(1, 0, 3, 4, 2, 5)
    k = k.reshape(B, S, DIFF_HEADS, 2, HEAD_DIM).transpose(0, 2, 3, 1, 4)
    v = v.reshape(B, S, DIFF_HEADS, DIFF_VDIM).transpose(0, 2, 1, 3)
    f32 = jnp.float32
    lam = (jnp.exp(jnp.sum(lq1.astype(f32) * lk1.astype(f32)))
           - jnp.exp(jnp.sum(lq2.astype(f32) * lk2.astype(f32))) + lambda_init)
    key_pos = jnp.arange(S, dtype=jnp.int32)
    scale = HEAD_DIM ** -0.5

    def block(args):
        qi, bi = args
        q_pos = bi * Q_BLOCK + jnp.arange(Q_BLOCK, dtype=jnp.int32)
        s = jnp.einsum('bhcqd,bhckd->bhcqk', qi, k).astype(f32) * scale
        rel = key_pos[None, :] - q_pos[:, None]
        bias = jnp.transpose(rel_table[t5_bucket(rel)], (2, 0, 1)).astype(f32)
        mask = (key_pos[None, :] // CHUNK) <= (q_pos[:, None] // CHUNK)
        s = jnp.where(mask, s + bias[None, :, None], NEG)
        p = jax.nn.softmax(s, axis=-1)
        a = p[:, :, 0] - lam * p[:, :, 1]
        return jnp.einsum('bhqk,bhkv->bhqv', a.astype(v.dtype), v)

    o = lax.map(block, (q, jnp.arange(nb, dtype=jnp.int32)))
    o = rmsnorm(o, subln_g, SUBLN_EPS) * (1.0 - lambda_init)
    return o.transpose(1, 0, 3, 2, 4).reshape(B, S, D_MODEL)


def shared_kv(h, g, w_k, w_v, w_f, b_f):
    B, S, _ = h.shape
    hn = rmsnorm(h, g)
    k = (hn @ w_k).reshape(B, S, FOX_HEADS, HEAD_DIM).transpose(0, 2, 1, 3)
    v = (hn @ w_v).reshape(B, S, FOX_HEADS, HEAD_DIM).transpose(0, 2, 1, 3)
    log_f = jax.nn.log_sigmoid((hn @ w_f + b_f).astype(jnp.float32))
    c = jnp.cumsum(log_f, axis=1).transpose(0, 2, 1)
    return k, v, c


def forgetting_attention(h, w_q, k, v, c):
    B, S, _ = h.shape
    nb = S // Q_BLOCK
    q = (h @ w_q).reshape(B, nb, Q_BLOCK, FOX_HEADS, HEAD_DIM).transpose(1, 0, 3, 2, 4)
    cq = c.reshape(B, FOX_HEADS, nb, Q_BLOCK).transpose(2, 0, 1, 3)
    key_pos = jnp.arange(S, dtype=jnp.int32)
    scale = HEAD_DIM ** -0.5

    def block(args):
        qi, ci, bi = args
        q_pos = bi * Q_BLOCK + jnp.arange(Q_BLOCK, dtype=jnp.int32)
        s = jnp.einsum('bhqd,bhkd->bhqk', qi, k).astype(jnp.float32) * scale
        mask = key_pos[None, :] <= q_pos[:, None]
        s = jnp.where(mask, s + ci[..., None] - c[:, :, None, :], NEG)
        p = jax.nn.softmax(s, axis=-1)
        return jnp.einsum('bhqk,bhkd->bhqd', p.astype(v.dtype), v)

    o = lax.map(block, (q, cq, jnp.arange(nb, dtype=jnp.int32)))
    return o.transpose(1, 0, 3, 2, 4).reshape(B, S, D_MODEL)


def sq_relu_mlp(h, w_in, w_out):
    return jnp.square(jax.nn.relu(h @ w_in)) @ w_out


def setup_inputs(seed: int = 0) -> dict:
    key = jax.random.key(seed)
    ks = jax.random.split(key, 24)
    D = D_MODEL
    nrm = jax.random.normal
    f32 = jnp.float32
    return {
        "x": nrm(ks[0], (BATCH, SEQ, D), f32),
        "rel_bias_table": 0.5 * nrm(ks[1], (REL_BUCKETS, DIFF_HEADS), f32),
        "attn_norm_g": 1.0 + 0.02 * nrm(ks[2], (DEPTH, D), f32),
        "mlp_norm_g": 1.0 + 0.02 * nrm(ks[3], (DEPTH, D), f32),
        "w_qkv_a": nrm(ks[4], (N_A_LAYERS, D, 3 * D), f32) * D ** -0.5,
        "lam_q1": 0.1 * nrm(ks[5], (N_A_LAYERS, HEAD_DIM), f32),
        "lam_k1": 0.1 * nrm(ks[6], (N_A_LAYERS, HEAD_DIM), f32),
        "lam_q2": 0.1 * nrm(ks[7], (N_A_LAYERS, HEAD_DIM), f32),
        "lam_k2": 0.1 * nrm(ks[8], (N_A_LAYERS, HEAD_DIM), f32),
        "subln_g": 1.0 + 0.02 * nrm(ks[9], (N_A_LAYERS, DIFF_VDIM), f32),
        "w_o_a": nrm(ks[10], (N_A_LAYERS, D, D), f32) * D ** -0.5,
        "kv_norm_g": 1.0 + 0.02 * nrm(ks[11], (D,), f32),
        "w_k_b": nrm(ks[12], (D, D), f32) * D ** -0.5,
        "w_v_b": nrm(ks[13], (D, D), f32) * D ** -0.5,
        "w_f_b": nrm(ks[14], (D, FOX_HEADS), f32) * D ** -0.5,
        "b_f_b": 2.0 + 0.1 * nrm(ks[15], (FOX_HEADS,), f32),
        "w_q_b": nrm(ks[16], (N_B_LAYERS, D, D), f32) * D ** -0.5,
        "w_o_b": nrm(ks[17], (N_B_LAYERS, D, D), f32) * D ** -0.5,
        "w_mlp_in": nrm(ks[18], (DEPTH, D, D_FF), f32) * D ** -0.5,
        "w_mlp_out": nrm(ks[19], (DEPTH, D_FF, D), f32) * D_FF ** -0.5,
        "final_norm_g": 1.0 + 0.02 * nrm(ks[20], (D,), f32),
    }


def reference(x, rel_bias_table, attn_norm_g, mlp_norm_g, w_qkv_a, lam_q1, lam_k1,
              lam_q2, lam_k2, subln_g, w_o_a, kv_norm_g, w_k_b, w_v_b, w_f_b, b_f_b,
              w_q_b, w_o_b, w_mlp_in, w_mlp_out, final_norm_g):
    h = x
    k_sh = v_sh = c_sh = None
    for layer in range(DEPTH):
        hn = rmsnorm(h, attn_norm_g[layer])
        if layer < N_A_LAYERS:
            i = layer
            lambda_init = 0.8 - 0.6 * math.exp(-0.3 * layer)
            o = diff_attention(hn, w_qkv_a[i], lam_q1[i], lam_k1[i], lam_q2[i], lam_k2[i],
                               subln_g[i], rel_bias_table, lambda_init)
            h = h + o @ w_o_a[i]
        else:
            j = layer - N_A_LAYERS
            if j == 0:
                k_sh, v_sh, c_sh = shared_kv(h, kv_norm_g, w_k_b, w_v_b, w_f_b, b_f_b)
            o = forgetting_attention(hn, w_q_b[j], k_sh, v_sh, c_sh)
            h = h + o @ w_o_b[j]
        hn = rmsnorm(h, mlp_norm_g[layer])
        h = h + sq_relu_mlp(hn, w_mlp_in[layer], w_mlp_out[layer])
    return rmsnorm(h, final_norm_g)
```

```cpp
#include <hip/hip_runtime.h>
#include <hip/hip_cooperative_groups.h>
#include <cstdio>
#include <cstdint>
namespace cg = cooperative_groups;
namespace pg8 {
#define PG8_LAS __attribute__((address_space(3)))
typedef unsigned short bf16_t;
typedef short bf16x8 __attribute__((ext_vector_type(8)));
typedef float f32x4 __attribute__((ext_vector_type(4)));
typedef unsigned u32x4 __attribute__((ext_vector_type(4)));
constexpr int BM = 256, BK = 64, HALF = 128, HTB = HALF * BK * 2  , STAGE_BYTES = 8 * HTB, NXCD = 8, WGM = 8;

__host__ __device__ __forceinline__ int lds_byte(int r, int c) { const int st = (r >> 4) * 2 + (c >> 5), rr = r & 15, cc = c & 31, ob = rr * 64 + cc * 2; return st * 1024 + (ob ^ (((ob >> 9) & 1) << 5)); }
__host__ __device__ __forceinline__ void stage_rc(int b, int& R, int& C) { const int st = b / 1024, sb = b % 1024, swz = sb ^ (((sb >> 9) & 1) << 5); R = (st >> 1) * 16 + swz / 64; C = (st & 1) * 32 + (swz % 64) / 2; }
__host__ __device__ __forceinline__ int perm32(int rho) { const int n = rho >> 4, i = rho & 15; return 8 * (i >> 2) + 4 * n + (i & 3); }

struct Unit { int pm, pn; };
struct Gemm { const bf16_t* A; const bf16_t* Bt; int M, N, K; };

struct StaticOrder {
    int nM, nN, nwg, G, c;
    __host__ __device__ void init(int M, int N, int G_, int c_) { nM = M / BM; nN = N / BM; nwg = nM * nN; G = G_; c = c_; }
    __host__ __device__ bool next(int i, Unit& u) const {
        const long L = (long)i * G + c; if (L >= nwg) return false;
        int wgid = (int)L; { const int q = nwg / NXCD, r = nwg % NXCD, xcd = wgid % NXCD, off = wgid / NXCD; wgid = (xcd < r ? xcd * (q + 1) : r * (q + 1) + (xcd - r) * q) + off; }
        const int nig = WGM * nN, gid = wgid / nig, fm = gid * WGM, gsz = (nM - fm) < WGM ? (nM - fm) : WGM;
        u.pm = fm + ((wgid % nig) % gsz); u.pn = (wgid % nig) / gsz; return true;
    }
    __device__ __forceinline__ void a_ready(const Unit&) const {}
    __device__ __forceinline__ void done(const Unit&) const {}
};

__device__ __forceinline__ unsigned cvt_pk_bf16(float lo, float hi) { unsigned r; asm volatile("v_cvt_pk_bf16_f32 %0, %1, %2" : "=v"(r) : "v"(lo), "v"(hi)); return r; }
typedef float f32x2 __attribute__((ext_vector_type(2)));
template <int MODE> struct EpiX {
    static constexpr bool PERM = true, AFTER_DRAIN = false;
    bf16_t* O; int ldc; const float* base; float* out; float* F;
    __device__ __forceinline__ void operator()(const f32x4 (&acc)[2][2][4][2], const Unit& u, int wr, int wc, int fr, int fq) const {
        const int row0 = u.pm * BM + wr * 64 + fr, col0 = u.pn * BM + wc * 32 + 8 * fq;
        const bool ftile = (MODE == 3) && (u.pn * BM >= 6144);
#pragma unroll
        for (int ai = 0; ai < 2; ++ai)
#pragma unroll
            for (int m = 0; m < 4; ++m) { const size_t row = (size_t)(row0 + ai * HALF + m * 16);
#pragma unroll
                for (int bj = 0; bj < 2; ++bj) { f32x4 v0 = acc[ai][bj][m][0], v1 = acc[ai][bj][m][1]; const int col = col0 + bj * HALF;
                    if (MODE == 2) { const float* bp = base + row * ldc + col; float* op = out + row * ldc + col;
                        const f32x4 b0 = *(const f32x4*)bp, b1 = *(const f32x4*)(bp + 4); *(f32x4*)op = b0 + v0; *(f32x4*)(op + 4) = b1 + v1; }
                    else if (ftile) { if (bj == 0 && wc == 0 && fq < 2) { float* fp = F + row * 16 + 8 * fq; *(f32x4*)fp = v0; *(f32x4*)(fp + 4) = v1; } }
                    else { if (MODE == 1) {
#pragma unroll
                            for (int e = 0; e < 4; ++e) { const float a = fmaxf(v0[e], 0.f), b = fmaxf(v1[e], 0.f); v0[e] = a * a; v1[e] = b * b; } }
                        u32x4 w; w.x = cvt_pk_bf16(v0[0], v0[1]); w.y = cvt_pk_bf16(v0[2], v0[3]); w.z = cvt_pk_bf16(v1[0], v1[1]); w.w = cvt_pk_bf16(v1[2], v1[3]);
                        *(u32x4*)(O + row * ldc + col) = w; } }
                if (MODE == 2) asm volatile("" ::: "memory"); }
    }
};
template <class Epi, class Sched, bool ALIGN_EPI = false, bool SP2 = false>
__device__ __forceinline__ void gemm_phase(PG8_LAS unsigned char* lds, const Gemm g, const Sched& S, const Epi& E) {
    int tid = threadIdx.x; asm volatile("" : "+v"(tid));
    const int wid = __builtin_amdgcn_readfirstlane(tid >> 6), lane = tid & 63, wr = wid >> 2, wc = wid & 3, fr = lane & 15, fq = lane >> 4;
    const int K = g.K, nt = K / BK;
    unsigned voffA[2], voffB[2];
#pragma unroll
    for (int i = 0; i < 2; ++i) { int R, C; stage_rc(tid * 16 + i * 8192, R, C); const int Rb = Epi::PERM ? ((R & ~31) + perm32(R & 31)) : R;
        voffA[i] = (unsigned)(R * K + C) * 2u; voffB[i] = (unsigned)(Rb * K + C) * 2u; }
    const size_t kstep = (size_t)(BK * 2);
    const size_t hstep = (size_t)HALF * K * 2;
    const size_t tstep = 2 * hstep;
    const unsigned ldsw = (unsigned)wid * 1024u;
    const int aoff = lds_byte(wr * 64 + fr, fq * 8), boff = lds_byte(wc * 32 + fr, fq * 8);
#define PG8_SA(b, h) (((b) * 2 + (h)) * HTB)
#define PG8_SB(b, h) ((4 + (b) * 2 + (h)) * HTB)
#define PG8_STAGE(bufoff, gbase, voff) do { _Pragma("unroll") for (int _i = 0; _i < 2; ++_i) \
        __builtin_amdgcn_global_load_lds((const unsigned*)((const char*)(gbase) + (voff)[_i]), (PG8_LAS unsigned*)(lds + (bufoff) + ldsw + _i * 8192), 16, 0, 0); } while (0)
#define PG8_LDA(dst, b, h) do { _Pragma("unroll") for (int m = 0; m < 4; ++m) _Pragma("unroll") for (int k = 0; k < 2; ++k) dst[m][k] = *(const PG8_LAS bf16x8*)(lds + PG8_SA(b, h) + aoff + m * 2048 + k * 1024); } while (0)
#define PG8_LDB(dst, b, h) do { _Pragma("unroll") for (int n = 0; n < 2; ++n) _Pragma("unroll") for (int k = 0; k < 2; ++k) dst[n][k] = *(const PG8_LAS bf16x8*)(lds + PG8_SB(b, h) + boff + n * 2048 + k * 1024); } while (0)
#define PG8_MMA(ai, bj, At, Bt) do { __builtin_amdgcn_s_setprio(1); _Pragma("unroll") for (int m = 0; m < 4; ++m) _Pragma("unroll") for (int n = 0; n < 2; ++n) _Pragma("unroll") for (int k = 0; k < 2; ++k) \
        acc[ai][bj][m][n] = __builtin_amdgcn_mfma_f32_16x16x32_bf16(Bt[n][k], At[m][k], acc[ai][bj][m][n], 0, 0, 0); __builtin_amdgcn_s_setprio(0); } while (0)
#define PG8_WAIT_V(n) asm volatile("s_waitcnt vmcnt(" #n ")" ::: "memory")
#define PG8_WAIT_L(n) asm volatile("s_waitcnt lgkmcnt(" #n ")" ::: "memory")
#define PG8_BAR __builtin_amdgcn_s_barrier()
#define PG8_SCHED __builtin_amdgcn_sched_barrier(0)
    Unit cur, nxt; int ui = 0;
    if (!S.next(0, cur)) return;
    f32x4 acc[2][2][4][2];
#pragma unroll
    for (int a = 0; a < 2; ++a)
#pragma unroll
        for (int b = 0; b < 2; ++b)
#pragma unroll
            for (int m = 0; m < 4; ++m)
#pragma unroll
                for (int n = 0; n < 2; ++n) acc[a][b][m][n] = (f32x4){0.f, 0.f, 0.f, 0.f};
    bf16x8 At[4][2], B0[2][2], B1[2][2];
    const char* cA = (const char*)g.A + (size_t)cur.pm * tstep; const char* cB = (const char*)g.Bt + (size_t)cur.pn * tstep;
    S.a_ready(cur);
    if constexpr (SP2) {
        PG8_STAGE(PG8_SB(0, 0), cB, voffB); PG8_STAGE(PG8_SB(0, 1), cB + hstep, voffB); PG8_STAGE(PG8_SA(0, 0), cA, voffA); PG8_STAGE(PG8_SA(0, 1), cA + hstep, voffA);
        if (wr == 1) PG8_BAR;
        PG8_WAIT_V(2); PG8_BAR;
        PG8_STAGE(PG8_SB(1, 0), cB + kstep, voffB); PG8_STAGE(PG8_SA(1, 0), cA + kstep, voffA); PG8_STAGE(PG8_SB(1, 1), cB + hstep + kstep, voffB);
        PG8_WAIT_V(6); PG8_BAR;
    } else {
        PG8_STAGE(PG8_SB(0, 0), cB, voffB); PG8_STAGE(PG8_SA(0, 0), cA, voffA); PG8_STAGE(PG8_SB(0, 1), cB + hstep, voffB); PG8_STAGE(PG8_SA(0, 1), cA + hstep, voffA);
        if (wr == 1) PG8_BAR;
        PG8_WAIT_V(4); PG8_BAR;
        PG8_STAGE(PG8_SB(1, 0), cB + kstep, voffB); PG8_STAGE(PG8_SA(1, 0), cA + kstep, voffA); PG8_STAGE(PG8_SB(1, 1), cB + hstep + kstep, voffB);
        PG8_WAIT_V(6); PG8_BAR;
    }
    for (;;) {
        const bool has_next = S.next(ui + 1, nxt);
        const char* nA = has_next ? (const char*)g.A + (size_t)nxt.pm * tstep : cA; const char* nB = has_next ? (const char*)g.Bt + (size_t)nxt.pn * tstep : cB;
        for (int t = 0; t < nt; t += 2) {
            const bool last = (t == nt - 2);
            const char* a1 = cA + (size_t)(t + 1) * kstep;
            const char* a2 = last ? nA : cA + (size_t)(t + 2) * kstep; const char* b2 = last ? nB : cB + (size_t)(t + 2) * kstep;
            const char* a3 = a2 + kstep; const char* b3 = b2 + kstep;
            if (last && has_next) S.a_ready(nxt);
            if constexpr (SP2) {
            PG8_LDB(B0, 0, 0); PG8_LDB(B1, 0, 1); PG8_SCHED; PG8_LDA(At, 0, 0); PG8_STAGE(PG8_SA(1, 1), a1 + hstep, voffA);
            PG8_WAIT_V(8); PG8_WAIT_L(0); PG8_BAR; PG8_MMA(0, 0, At, B0); PG8_MMA(0, 1, At, B1); PG8_BAR; PG8_SCHED;
            PG8_LDA(At, 0, 1); PG8_STAGE(PG8_SB(0, 0), b2, voffB); PG8_STAGE(PG8_SB(0, 1), b2 + hstep, voffB); PG8_STAGE(PG8_SA(0, 0), a2, voffA);
            PG8_WAIT_V(8); PG8_WAIT_L(0); PG8_BAR; PG8_MMA(1, 0, At, B0); PG8_MMA(1, 1, At, B1); PG8_BAR; PG8_SCHED;
            PG8_LDB(B0, 1, 0); PG8_LDB(B1, 1, 1); PG8_SCHED; PG8_LDA(At, 1, 0); PG8_STAGE(PG8_SA(0, 1), a2 + hstep, voffA);
            PG8_WAIT_V(8); PG8_WAIT_L(0); PG8_BAR; PG8_MMA(0, 0, At, B0); PG8_MMA(0, 1, At, B1); PG8_BAR; PG8_SCHED;
            PG8_LDA(At, 1, 1); PG8_STAGE(PG8_SB(1, 0), b3, voffB); PG8_STAGE(PG8_SB(1, 1), b3 + hstep, voffB); PG8_STAGE(PG8_SA(1, 0), a3, voffA);
            PG8_WAIT_V(8); PG8_WAIT_L(0); PG8_BAR; PG8_MMA(1, 0, At, B0); PG8_MMA(1, 1, At, B1); PG8_BAR; PG8_SCHED;
            } else {
            PG8_LDB(B0, 0, 0); PG8_SCHED; PG8_LDA(At, 0, 0); PG8_STAGE(PG8_SA(1, 1), a1 + hstep, voffA);
            PG8_WAIT_L(8); PG8_BAR; PG8_WAIT_L(0); PG8_MMA(0, 0, At, B0); PG8_BAR; PG8_SCHED;
            PG8_LDB(B1, 0, 1); PG8_STAGE(PG8_SB(0, 0), b2, voffB);
            PG8_BAR; PG8_WAIT_L(0); PG8_MMA(0, 1, At, B1); PG8_BAR;
            PG8_LDA(At, 0, 1); PG8_STAGE(PG8_SA(0, 0), a2, voffA);
            PG8_BAR; PG8_WAIT_L(0); PG8_MMA(1, 0, At, B0); PG8_BAR; PG8_SCHED;
            PG8_STAGE(PG8_SB(0, 1), b2 + hstep, voffB);
            PG8_WAIT_V(6); PG8_BAR; PG8_MMA(1, 1, At, B1); PG8_BAR;
            PG8_LDB(B0, 1, 0); PG8_SCHED; PG8_LDA(At, 1, 0); PG8_STAGE(PG8_SA(0, 1), a2 + hstep, voffA);
            PG8_WAIT_L(8); PG8_BAR; PG8_WAIT_L(0); PG8_MMA(0, 0, At, B0); PG8_BAR; PG8_SCHED;
            PG8_LDB(B1, 1, 1); PG8_STAGE(PG8_SB(1, 0), b3, voffB);
            PG8_BAR; PG8_WAIT_L(0); PG8_MMA(0, 1, At, B1); PG8_BAR;
            PG8_LDA(At, 1, 1); PG8_STAGE(PG8_SA(1, 0), a3, voffA);
            PG8_BAR; PG8_WAIT_L(0); PG8_MMA(1, 0, At, B0); PG8_BAR; PG8_SCHED;
            PG8_STAGE(PG8_SB(1, 1), b3 + hstep, voffB);
            PG8_WAIT_V(6); PG8_BAR; PG8_MMA(1, 1, At, B1); PG8_BAR;
            }
        }
        if constexpr (ALIGN_EPI) { if (wr == 0) PG8_BAR; }
        if constexpr (!Epi::AFTER_DRAIN) { E(acc, cur, wr, wc, fr, fq); S.done(cur); }
        if (!has_next) break;
#pragma unroll
        for (int a = 0; a < 2; ++a)
#pragma unroll
            for (int b = 0; b < 2; ++b)
#pragma unroll
                for (int m = 0; m < 4; ++m)
#pragma unroll
                    for (int n = 0; n < 2; ++n) acc[a][b][m][n] = (f32x4){0.f, 0.f, 0.f, 0.f};
        cur = nxt; cA = nA; cB = nB; ++ui;
        if constexpr (ALIGN_EPI) { if (wr == 1) PG8_BAR; }
    }
    PG8_WAIT_V(0);
    if constexpr (!ALIGN_EPI) { if (wr == 0) PG8_BAR; }
    PG8_BAR;
    if constexpr (Epi::AFTER_DRAIN) { E.fused(acc, cur, wr, wc, fr, fq, lds, wid, lane); S.done(cur); }
#undef PG8_SA
#undef PG8_SB
#undef PG8_STAGE
#undef PG8_LDA
#undef PG8_LDB
#undef PG8_MMA
#undef PG8_WAIT_V
#undef PG8_WAIT_L
#undef PG8_BAR
#undef PG8_SCHED
}
}
#ifndef PG8_SP2
#define PG8_SP2 true
#endif
#ifndef PG8_ALIGN
#define PG8_ALIGN true
#endif
namespace att {
typedef unsigned short bf16;
typedef short bf16x8 __attribute__((ext_vector_type(8)));
typedef short s16x4 __attribute__((ext_vector_type(4)));
typedef float f32x16 __attribute__((ext_vector_type(16)));
typedef float f32x4 __attribute__((ext_vector_type(4)));
typedef unsigned u32x4 __attribute__((ext_vector_type(4)));
constexpr int D = 128, NW = 8, QBLK = 32, KVBLK = 64, QB = NW * QBLK, LDQ = 6144, LDO = 2048;
constexpr float SCALE = 0.08838834764831845f, THR = 8.f;
constexpr int SHM_V = KVBLK * D * 2, SHM_K = KVBLK * 272;
constexpr int OFF_WS = 2 * SHM_V + 2 * SHM_K, OFF_CL = OFF_WS + NW * 64 * 4, OFF_TB = OFF_CL + 512, LDS_BYTES = OFF_TB + 8192;
#define KROW 272
#define KSWZ(row, colB) ((row) * KROW + (colB))
#define SBAR() __builtin_amdgcn_sched_barrier(0)
__device__ __forceinline__ int v_st(int k, int c) { const int kk = (k & ~0xC) | ((k & 4) << 1) | ((k & 8) >> 1); return ((kk >> 3) * 4 + (c >> 5)) * 512 + ((kk & 7) * 32 + (c & 31)) * 2; }
__device__ __forceinline__ int v_rd_base(int lane) { return ((lane & 3) << 3) | (((lane >> 2) & 3) << 6) | (((lane >> 4) & 1) << 5) | (((lane >> 5) & 1) << 8); }
constexpr int v_rd_off(int d0, int ks, int half) { return d0 * 512 + ks * 4096 + half * 2048; }
__device__ __forceinline__ int crow(int r, int hi) { return (r & 3) + 8 * (r >> 2) + 4 * hi; }
__device__ __forceinline__ unsigned cvtpk(float lo, float hi) { unsigned r; asm volatile("v_cvt_pk_bf16_f32 %0, %1, %2" : "=v"(r) : "v"(lo), "v"(hi)); return r; }
__device__ __forceinline__ void mask_tile(f32x16& p0, f32x16& p1, int dq, unsigned W) {
    const float NEG = -__builtin_inff();
#pragma unroll
    for (int r = 0; r < 16; ++r) { const int c = (r & 3) + 8 * (r >> 2);
        if ((unsigned)(dq - c) >= W) p0[r] = NEG;
        if ((unsigned)(dq - c - 32) >= W) p1[r] = NEG; }
}
__device__ __forceinline__ void add_bias(f32x16& p0, f32x16& p1, const float* tb, int relbase) {
    const float* t = tb + relbase;
#pragma unroll
    for (int r = 0; r < 16; ++r) { const int c = (r & 3) + 8 * (r >> 2); p0[r] += t[c]; p1[r] += t[c + 32]; }
}
__device__ __forceinline__ void partialSM(f32x16& p0, f32x16& p1, float& m_reg, float& mn, float& alpha) {
    float pmax = p0[0]; for (int r = 1; r < 16; ++r) pmax = fmaxf(pmax, p0[r]); for (int r = 0; r < 16; ++r) pmax = fmaxf(pmax, p1[r]);
    { auto rr = __builtin_amdgcn_permlane32_swap(__float_as_uint(pmax), __float_as_uint(pmax), false, false);
      pmax = fmaxf(__uint_as_float(rr[0]), __uint_as_float(rr[1])); }
    constexpr float C2 = 1.4426950408889634f * SCALE;
    if (__builtin_expect(__all((pmax - m_reg) * SCALE <= THR), 1)) { mn = m_reg; alpha = 1.f; }
    else { mn = fmaxf(m_reg, pmax); alpha = __builtin_amdgcn_exp2f((m_reg - mn) * C2); m_reg = mn; }
    const float mnL = -mn * C2;
    for (int r = 0; r < 16; ++r) p0[r] = fmaf(p0[r], C2, mnL); for (int r = 0; r < 16; ++r) p1[r] = fmaf(p1[r], C2, mnL);
    for (int r = 0; r < 16; ++r) p0[r] = __builtin_amdgcn_exp2f(p0[r]);
}
__device__ __forceinline__ void finishSM(f32x16& p0, f32x16& p1, float alpha, float& l_reg, bf16x8& pa0, bf16x8& pa1, bf16x8& pa2, bf16x8& pa3) {
    for (int r = 0; r < 16; ++r) p1[r] = __builtin_amdgcn_exp2f(p1[r]);
    float ps = 0; for (int r = 0; r < 16; ++r) ps += p0[r]; for (int r = 0; r < 16; ++r) ps += p1[r];
    { auto rr = __builtin_amdgcn_permlane32_swap(__float_as_uint(ps), __float_as_uint(ps), false, false);
      ps = __uint_as_float(rr[0]) + __uint_as_float(rr[1]); }
    l_reg = l_reg * alpha + ps;
#define PK4(P, B_, OUT) do { unsigned a0 = cvtpk(P[B_+0], P[B_+1]), a1 = cvtpk(P[B_+2], P[B_+3]);                          \
        unsigned b0 = cvtpk(P[B_+4], P[B_+5]), b1 = cvtpk(P[B_+6], P[B_+7]);                                             \
        auto r0 = __builtin_amdgcn_permlane32_swap(a0, b0, false, false); auto r1 = __builtin_amdgcn_permlane32_swap(a1, b1, false, false); \
        u32x4 w = {r0[0], r1[0], r0[1], r1[1]}; OUT = *reinterpret_cast<bf16x8*>(&w); } while (0)
    PK4(p0, 0, pa0); PK4(p0, 8, pa1); PK4(p1, 0, pa2); PK4(p1, 8, pa3);
#undef PK4
}
template <int KB, bool SK, int MODE>
__device__ __forceinline__ void qkt(f32x16& p0, f32x16& p1, const char* lds, int r32, int hi, const bf16x8* qr, bool act) {
    if (SK && !act) { const float NEG = -__builtin_inff();
#pragma unroll
        for (int r = 0; r < 16; ++r) { p0[r] = NEG; p1[r] = NEG; } return; }
    if (MODE == 1) { const float* cl = (const float*)(lds + OFF_CL) + KB * 64 + 4 * hi;
#pragma unroll
        for (int g = 0; g < 4; ++g) { const f32x4 a = *(const f32x4*)(cl + 8 * g), b = *(const f32x4*)(cl + 32 + 8 * g);
            p0[4 * g] = a[0]; p0[4 * g + 1] = a[1]; p0[4 * g + 2] = a[2]; p0[4 * g + 3] = a[3];
            p1[4 * g] = b[0]; p1[4 * g + 1] = b[1]; p1[4 * g + 2] = b[2]; p1[4 * g + 3] = b[3]; } }
    else { p0 = f32x16{}; p1 = f32x16{}; }
    const char* K_lds = lds + 2 * SHM_V;
    const char* kb0 = K_lds + KB * SHM_K + KSWZ(r32, hi * 16);
#pragma unroll
    for (int d0 = 0; d0 < 8; ++d0) { const char* a = kb0 + d0 * 32;
        bf16x8 b0 = *reinterpret_cast<const bf16x8*>(a);
        bf16x8 b1 = *reinterpret_cast<const bf16x8*>(a + 32 * KROW);
        p0 = __builtin_amdgcn_mfma_f32_32x32x16_bf16(b0, qr[d0], p0, 0, 0, 0);
        p1 = __builtin_amdgcn_mfma_f32_32x32x16_bf16(b1, qr[d0], p1, 0, 0, 0); }
}
template <int VB, bool SK>
__device__ __forceinline__ void pv_tile(f32x16* o, int vb0, bf16x8 pa0, bf16x8 pa1, bf16x8 pa2, bf16x8 pa3, bool act) {
    if (SK && !act) return;
#define TRRD(dst, off) asm volatile("ds_read_b64_tr_b16 %0, %1 offset:%2" : "=&v"(dst) : "v"(vb0), "i"(off) : "memory")
#define PV_D0(d0) do { s16x4 l0, l1, l2, l3, h0, h1, h2, h3; constexpr int b_ = VB * SHM_V + v_rd_off(d0, 0, 0); \
        TRRD(l0, b_); TRRD(h0, b_ + 2048); TRRD(l1, b_ + 4096); TRRD(h1, b_ + 6144); TRRD(l2, b_ + 8192); TRRD(h2, b_ + 10240); TRRD(l3, b_ + 12288); TRRD(h3, b_ + 14336); \
        asm volatile("s_waitcnt lgkmcnt(0)" ::: "memory"); SBAR(); \
        o[d0] = __builtin_amdgcn_mfma_f32_32x32x16_bf16(pa0, (bf16x8){l0[0], l0[1], l0[2], l0[3], h0[0], h0[1], h0[2], h0[3]}, o[d0], 0, 0, 0);   \
        o[d0] = __builtin_amdgcn_mfma_f32_32x32x16_bf16(pa1, (bf16x8){l1[0], l1[1], l1[2], l1[3], h1[0], h1[1], h1[2], h1[3]}, o[d0], 0, 0, 0);   \
        o[d0] = __builtin_amdgcn_mfma_f32_32x32x16_bf16(pa2, (bf16x8){l2[0], l2[1], l2[2], l2[3], h2[0], h2[1], h2[2], h2[3]}, o[d0], 0, 0, 0);   \
        o[d0] = __builtin_amdgcn_mfma_f32_32x32x16_bf16(pa3, (bf16x8){l3[0], l3[1], l3[2], l3[3], h3[0], h3[1], h3[2], h3[3]}, o[d0], 0, 0, 0); } while (0)
    PV_D0(0); PV_D0(1); PV_D0(2); PV_D0(3);
#undef PV_D0
#undef TRRD
}
struct BlockRef { const bf16* Q; const bf16* K; const bf16* V; bf16* O; const float* CB; int P0, jlo, h; };
struct Seam { bf16x8 qr[8]; bf16x8 st_v0, st_v1, st_k0, st_k1; };
#define LD8(p) (*reinterpret_cast<const bf16x8*>(p))
#define ROWQ(p, k0, rr) ((p) + (size_t)((k0) + (rr)) * LDQ + sc)
#define VMW() asm volatile("s_waitcnt vmcnt(0)" ::: "memory")
#define VMWN(n) asm volatile("s_waitcnt vmcnt(%0)" :: "i"(n) : "memory")
#define SLOAD_H(R, k0, bf) do { const char* kb__ = (const char*)(R).K + (size_t)(k0) * (LDQ * 2); const char* vb__ = (const char*)(R).V + (size_t)(k0) * (LDQ * 2); \
                         S.st_v0 = LD8(vb__ + vo0); S.st_v1 = LD8(vb__ + vo1); S.st_k0 = LD8(kb__ + vo0); S.st_k1 = LD8(kb__ + vo1);  \
                         if (MODE == 1) { if (wid == 0) __builtin_amdgcn_global_load_lds((const unsigned*)((const char*)((R).CB + (k0)) + lane4), (__attribute__((address_space(3))) unsigned*)(lds + OFF_CL + (bf) * 256), 4, 0, 0); } } while (0)
#define SWRITE_HK(bf) do { *(bf16x8*)(K_lds + (bf) * SHM_K + kws) = S.st_k0; *(bf16x8*)(K_lds + (bf) * SHM_K + kws + 32 * KROW) = S.st_k1; } while (0)
#define SWRITE_HV(bf) do { *(bf16x8*)(V_lds + (bf) * SHM_V + vst0) = S.st_v0; *(bf16x8*)(V_lds + (bf) * SHM_V + vst1) = S.st_v1; } while (0)
#define SWRITE_H(bf) do { SWRITE_HV(bf); SWRITE_HK(bf); } while (0)
template <int MODE>
__device__ __forceinline__ void attn_prime(const BlockRef& cur, char* lds, Seam& S) {
    int tid = threadIdx.x; asm volatile("" : "+v"(tid));
    const int wid = __builtin_amdgcn_readfirstlane(tid >> 6), lane = tid & 63, r32 = lane & 31, hi = lane >> 5;
    const int sr = tid >> 4, sc = (tid & 15) * 8, kws = KSWZ(sr, sc * 2); char* K_lds = lds + 2 * SHM_V;
    const int kb0 = cur.jlo * KVBLK;
    const unsigned vo0 = (unsigned)((sr * LDQ + sc) * 2), vo1 = vo0 + 32u * LDQ * 2u, lane4 = (unsigned)lane * 4u, qo = (unsigned)(((wid * QBLK + r32) * LDQ + hi * 8) * 2);
#pragma unroll
    for (int d0 = 0; d0 < 8; ++d0) S.qr[d0] = LD8((const char*)cur.Q + qo + d0 * 32);
    SLOAD_H(cur, kb0, 0); VMW(); SWRITE_HK(0);
    __syncthreads();
}
template <int MODE>
__device__ __forceinline__ void attn_block(const BlockRef& cur, const BlockRef& nxt, char* lds, Seam& S) {
    constexpr bool SK = (MODE == 0);
    int tid = threadIdx.x; asm volatile("" : "+v"(tid));
    const int wid = __builtin_amdgcn_readfirstlane(tid >> 6), lane = tid & 63, r32 = lane & 31, hi = lane >> 5;
    const int j_lo = cur.jlo, j_hi = cur.P0 / KVBLK + QB / KVBLK;
    const int NT = j_hi - j_lo;
    const int kbn = nxt.jlo * KVBLK;
    const int qlo = cur.P0 + wid * QBLK, qm = qlo + r32 - 4 * hi;
    char* V_lds = lds; char* K_lds = lds + 2 * SHM_V;
    float* ws = (float*)(lds + OFF_WS) + wid * 64; float* li_l = ws, * al_l = ws + 32;
    const float* tbh = (const float*)(lds + OFF_TB) + cur.h * 256;
    float m_reg = -1e30f, l_reg = 0; f32x16 o[4] = {};
    const int sr = tid >> 4, sc = (tid & 15) * 8, vst0 = v_st(sr, sc), vst1 = v_st(32 + sr, sc), kws = KSWZ(sr, sc * 2);
    const int vb0 = (int)(uintptr_t)V_lds + v_rd_base(lane);
    const unsigned vo0 = (unsigned)((sr * LDQ + sc) * 2), vo1 = vo0 + 32u * LDQ * 2u, lane4 = (unsigned)lane * 4u, qo = (unsigned)(((wid * QBLK + r32) * LDQ + hi * 8) * 2);
#define RESC(a) do { if (__any((a) < 1.f)) { if (hi == 0) al_l[r32] = (a); asm volatile("s_waitcnt lgkmcnt(0)" ::: "memory");              \
                     for (int d_ = 0; d_ < 4; ++d_) for (int r = 0; r < 16; ++r) o[d_][r] *= al_l[crow(r, hi)]; } } while (0)
#define KBASE(t) ((j_lo + (t)) * KVBLK)
#define ACT(t) (MODE == 0 ? (KBASE(t) <= qlo) : true)
#define MASKT(P0_, P1_, t) do { const int kb_ = KBASE(t);                                                                              \
        if (MODE == 1) { if (kb_ + KVBLK - 1 > qlo) mask_tile(P0_, P1_, qm - kb_, 0x40000000u); }                                       \
        else { if (kb_ <= qlo && kb_ + KVBLK - 1 - qlo >= -90) add_bias(P0_, P1_, tbh, kb_ - qm + 192); } } while (0)
    constexpr int NQL = 8;
#define SEAM_K0() do { VMWN(NQL); SWRITE_HK(0); SBAR(); } while (0)
    f32x16 pA0, pA1, pB0, pB1; float mnA, mnB, alA, alB; bf16x8 pa0, pa1, pa2, pa3;
    SWRITE_HV(0); SBAR();
    if (NT > 1) { SLOAD_H(cur, KBASE(1), 1); }
    SBAR(); qkt<0, SK, MODE>(pA0, pA1, lds, r32, hi, S.qr, ACT(0));
    MASKT(pA0, pA1, 0); partialSM(pA0, pA1, m_reg, mnA, alA);
    if (NT > 1) { VMW(); SWRITE_H(1); }
    __syncthreads();
#define HALF_STEP(PX0, PX1, mnX, alX, PY0, PY1, alY, t, KB, VB, SB) do {                                                      \
        SBAR(); qkt<KB, SK, MODE>(PX0, PX1, lds, r32, hi, S.qr, ACT(t));                                                      \
        finishSM(PY0, PY1, alY, l_reg, pa0, pa1, pa2, pa3); SBAR();                                                           \
        if ((t) + 1 < NT) { SLOAD_H(cur, KBASE((t) + 1), SB); SBAR(); }                                                           \
        pv_tile<VB, SK>(o, vb0, pa0, pa1, pa2, pa3, ACT((t) - 1)); MASKT(PX0, PX1, (t)); partialSM(PX0, PX1, m_reg, mnX, alX); \
        __syncthreads();                                                                                                      \
        if ((t) + 1 < NT) { VMW(); SWRITE_H(SB); }                                                                            \
        RESC(alX); __syncthreads(); } while (0)
    for (int t = 1; t + 1 < NT; t += 2) {
        HALF_STEP(pB0, pB1, mnB, alB, pA0, pA1, alA, t, 1, 0, 0);
        HALF_STEP(pA0, pA1, mnA, alA, pB0, pB1, alB, t + 1, 0, 1, 1);
    }
    const bool even = (NT & 1) == 0;
    if (even) { SBAR(); qkt<1, SK, MODE>(pB0, pB1, lds, r32, hi, S.qr, ACT(NT - 1)); SBAR(); }
    SLOAD_H(nxt, kbn, 0); SBAR();
#pragma unroll
    for (int d0 = 0; d0 < 8; ++d0) S.qr[d0] = LD8((const char*)nxt.Q + qo + d0 * 32);
    SBAR();
    finishSM(pA0, pA1, alA, l_reg, pa0, pa1, pa2, pa3); SBAR();
    pv_tile<0, SK>(o, vb0, pa0, pa1, pa2, pa3, ACT(even ? NT - 2 : NT - 1));
    if (even) { MASKT(pB0, pB1, NT - 1); partialSM(pB0, pB1, m_reg, mnB, alB); __syncthreads(); RESC(alB);
        finishSM(pB0, pB1, alB, l_reg, pa0, pa1, pa2, pa3); SBAR(); pv_tile<1, SK>(o, vb0, pa0, pa1, pa2, pa3, ACT(NT - 1)); }
    SBAR(); SEAM_K0();
    if (hi == 0) li_l[r32] = l_reg; asm volatile("s_waitcnt lgkmcnt(0)" ::: "memory");
    float rli[16];
#pragma unroll
    for (int r = 0; r < 16; ++r) rli[r] = __builtin_amdgcn_rcpf(li_l[crow(r, hi)]);
    char* Ow = (char*)cur.O; const unsigned oo = (unsigned)(((wid * QBLK + 4 * hi) * LDO + r32) * 2);
#pragma unroll
    for (int r = 0; r < 16; ++r) { const unsigned orow = (unsigned)(((r & 3) + 8 * (r >> 2)) * LDO * 2);
#pragma unroll
        for (int d0 = 0; d0 < 4; ++d0) { const float v = o[d0][r] * rli[r];
            const float vn = __shfl_xor(v, 1);
            if ((r32 & 1) == 0) *(unsigned*)(Ow + (oo + orow + d0 * 64)) = cvtpk(v, vn); } }
    __syncthreads();
#undef RESC
#undef KBASE
#undef ACT
#undef MASKT
#undef SEAM_K0
#undef HALF_STEP
}
#undef ROWQ
#undef VMW
#undef VMWN
#undef SLOAD_H
#undef SWRITE_HK
#undef SWRITE_HV
#undef SWRITE_H
#undef LD8
#undef SBAR
#undef KSWZ
#undef KROW
}
#define GAS __attribute__((address_space(1)))
#define LAS __attribute__((address_space(3)))
typedef unsigned short bf16;
typedef unsigned v4u __attribute__((ext_vector_type(4)));
typedef unsigned v2u __attribute__((ext_vector_type(2)));
typedef float f32x4 __attribute__((ext_vector_type(4)));
constexpr int NWAVES = 8;
constexpr int BATCH = 2, SEQ = 16384, DM = 2048, TOK = BATCH * SEQ, FF = 8192, NQKV = 6144, NQKV1 = 6400, FH = 16;
constexpr float NORM_EPS = 1e-6f, SUBLN_EPS = 1e-5f, LAMBDA_INIT = 0.2f;
constexpr size_t MiB = 1u << 20;
constexpr size_t WS_F = 0, WS_CB = 2 * MiB;
constexpr size_t WS_WQKV0 = 4 * MiB, WS_WOA = 28 * MiB, WS_WMI0 = 36 * MiB, WS_WMO0 = 68 * MiB, WS_WQKV1 = 100 * MiB, WS_WOB = 126 * MiB, WS_WMI1 = 134 * MiB, WS_WMO1 = 166 * MiB;
constexpr size_t WS_QKV = 200 * MiB;
constexpr size_t WS_OC = 584 * MiB;
constexpr size_t WS_HID = 200 * MiB;
constexpr size_t WS_XN = 840 * MiB;
constexpr size_t WS_END = 968 * MiB;
constexpr int LDS_BYTES = 147456;

__device__ __forceinline__ unsigned f2bf(float f) { unsigned u = __builtin_bit_cast(unsigned, f); return (u + 0x7fffu + ((u >> 16) & 1u)) >> 16; }
__device__ __forceinline__ unsigned pk2(float lo, float hi) { return f2bf(lo) | (f2bf(hi) << 16); }
__device__ __forceinline__ float bf2f(unsigned short b) { return __builtin_bit_cast(float, (unsigned)b << 16); }
__device__ __forceinline__ float wave_sum(float v) {
#pragma unroll
    for (int o = 1; o < 64; o <<= 1) v += __shfl_xor(v, o);
    return v;
}
__device__ __forceinline__ void transpose_item(const float* W, int K, int N, bf16* WT, int row_off, const float* g, LAS float* scr, int item, int lane) {
    const int nblk = N / 32, kb = item / nblk, nb = item % nblk, k0 = 64 * kb, n0 = 32 * nb;
#pragma unroll 8
    for (int i = 0; i < 32; ++i) { const int kk = 2 * i + (lane >> 5); float v = W[(size_t)(k0 + kk) * N + n0 + (lane & 31)]; if (g) v *= g[k0 + kk]; scr[kk * 33 + (lane & 31)] = v; }
    asm volatile("s_waitcnt lgkmcnt(0)" ::: "memory");
    const int c = lane & 7;
#pragma unroll
    for (int j = 0; j < 4; ++j) { const int n = (lane >> 3) + 8 * j; const LAS float* s = scr + (8 * c) * 33 + n;
        v4u o; o.x = pk2(s[0 * 33], s[1 * 33]); o.y = pk2(s[2 * 33], s[3 * 33]); o.z = pk2(s[4 * 33], s[5 * 33]); o.w = pk2(s[6 * 33], s[7 * 33]);
        *(v4u*)(WT + (size_t)(row_off + n0 + n) * K + k0 + 8 * c) = o; }
    asm volatile("s_waitcnt lgkmcnt(0)" ::: "memory");
}
__device__ __forceinline__ void norm_row_to_bf16(const float* xrow, bf16* orow, int lane) {
    const f32x4* xr = (const f32x4*)xrow + lane;
    f32x4 v[8]; float s = 0.f;
#pragma unroll
    for (int j = 0; j < 8; ++j) { v[j] = xr[64 * j]; s += (v[j].x * v[j].x + v[j].y * v[j].y) + (v[j].z * v[j].z + v[j].w * v[j].w); }
    const float rstd = 1.f / sqrtf(wave_sum(s) * (1.f / DM) + NORM_EPS);
    v2u* o8 = (v2u*)orow + lane;
#pragma unroll
    for (int j = 0; j < 8; ++j) { v2u w; w.x = pk2(v[j].x * rstd, v[j].y * rstd); w.y = pk2(v[j].z * rstd, v[j].w * rstd); o8[64 * j] = w; }
}
__device__ __forceinline__ void norm_phase(const float* src, bf16* dst, int gw, int NGW, int lane) {
    for (int m = gw; m < TOK; m += NGW) norm_row_to_bf16(src + (size_t)m * DM, dst + (size_t)m * DM, lane);
}
__device__ __forceinline__ void final_norm_phase(float* io, const float* g, int gw, int NGW, int lane) {
    for (int m = gw; m < TOK; m += NGW) {
        f32x4* xr = (f32x4*)(io + (size_t)m * DM) + lane; const f32x4* gr = (const f32x4*)g + lane;
        f32x4 v[8]; float s = 0.f;
#pragma unroll
        for (int j = 0; j < 8; ++j) { v[j] = xr[64 * j]; s += (v[j].x * v[j].x + v[j].y * v[j].y) + (v[j].z * v[j].z + v[j].w * v[j].w); }
        const float rstd = 1.f / sqrtf(wave_sum(s) * (1.f / DM) + NORM_EPS);
#pragma unroll
        for (int j = 0; j < 8; ++j) xr[64 * j] = v[j] * rstd * gr[64 * j];
    }
}
__device__ __forceinline__ void combine_phase(const bf16* OC, bf16* O, const float* lq1, const float* lk1, const float* lq2, const float* lk2, const float* sg, int gw, int NGW, int lane) {
    const float s1 = wave_sum(lq1[lane] * lk1[lane] + lq1[lane + 64] * lk1[lane + 64]), s2 = wave_sum(lq2[lane] * lk2[lane] + lq2[lane + 64] * lk2[lane + 64]);
    const float lam = expf(s1) - expf(s2) + LAMBDA_INIT;
    float gs[8];
#pragma unroll
    for (int e = 0; e < 8; ++e) gs[e] = sg[(lane & 31) * 8 + e] * (1.f - LAMBDA_INIT);
    for (int m = gw; m < TOK; m += NGW) {
        const v4u* a = (const v4u*)(OC + (size_t)m * DM) + lane; const v4u* b = (const v4u*)(OC + (size_t)TOK * DM + (size_t)m * DM) + lane; v4u* o = (v4u*)(O + (size_t)m * DM) + lane;
#pragma unroll
        for (int st = 0; st < 4; ++st) { const v4u av = a[64 * st], bv = b[64 * st]; float d[8]; float ss = 0.f;
#pragma unroll
            for (int e = 0; e < 4; ++e) { const unsigned aw = av[e], bw = bv[e];
                d[2 * e] = __builtin_bit_cast(float, aw << 16) - lam * __builtin_bit_cast(float, bw << 16);
                d[2 * e + 1] = __builtin_bit_cast(float, aw & 0xffff0000u) - lam * __builtin_bit_cast(float, bw & 0xffff0000u);
                ss += d[2 * e] * d[2 * e] + d[2 * e + 1] * d[2 * e + 1]; }
#pragma unroll
            for (int of = 1; of < 32; of <<= 1) ss += __shfl_xor(ss, of);
            const float rstd = 1.f / sqrtf(ss * (1.f / 256.f) + SUBLN_EPS);
            v4u w; w.x = pk2(d[0] * rstd * gs[0], d[1] * rstd * gs[1]); w.y = pk2(d[2] * rstd * gs[2], d[3] * rstd * gs[3]);
            w.z = pk2(d[4] * rstd * gs[4], d[5] * rstd * gs[5]); w.w = pk2(d[6] * rstd * gs[6], d[7] * rstd * gs[7]); o[64 * st] = w; }
    }
}
__device__ __forceinline__ void cumsum_phase(const float* F, const float* bfb, float* CB, LAS unsigned char* lds, int bx, int G, int tid) {
    LAS double* sc = (LAS double*)lds;
    for (int bh = bx; bh < BATCH * FH; bh += G) {
        const int b = bh / FH, h = bh % FH; const float bias = bfb[h];
        const float* fp = F + ((size_t)b * SEQ + (size_t)tid * 32) * FH + h;
        float ls[32]; double run = 0.0;
#pragma unroll
        for (int i = 0; i < 32; ++i) { const float x = fp[(size_t)i * FH] + bias; ls[i] = fminf(x, 0.f) - log1pf(expf(-fabsf(x))); run += (double)ls[i]; }
        sc[tid] = run; __syncthreads();
        int cur = 0;
        for (int of = 1; of < 512; of <<= 1) { double v = sc[cur * 512 + tid]; if (tid >= of) v += sc[cur * 512 + tid - of]; sc[(cur ^ 1) * 512 + tid] = v; cur ^= 1; __syncthreads(); }
        double acc = sc[cur * 512 + tid] - run;
        float* op = CB + (size_t)bh * SEQ + (size_t)tid * 32;
#pragma unroll
        for (int i = 0; i < 32; ++i) { acc += (double)ls[i]; op[i] = (float)(-acc * 11.313708498984761); }
        __syncthreads();
    }
}

struct Args { const float* in[21]; float* out; unsigned char* ws; };
template <int MODE> __device__ __forceinline__ bool attn_item(int i, int G, int bx, int& s, int& x) {
    constexpr int NS = MODE == 0 ? 64 : 32;
    if ((G & 7) == 0) { const int xcd = bx & 7, k = bx >> 3, kpx = G >> 3; const int idx = k + i * kpx; if (idx >= (NS / 8) * 32) return false; s = (idx >> 5) * 8 + xcd; x = idx & 31; return true; }
    const int L = bx + i * G; if (L >= NS * 32) return false; s = L >> 5; x = L & 31; return true;
}
template <int MODE> __device__ __forceinline__ att::BlockRef attn_ref(int s, int qb, const bf16* QKV, bf16* Obuf, const float* CB) {
    att::BlockRef r; r.P0 = qb * 256; r.jlo = 0;
    if (MODE == 0) { const int xcd = s & 7, sl = s >> 3, vh = sl & 1, c = (sl >> 1) & 1, bh = xcd * 2 + ((sl >> 2) & 1), b = bh >> 3, h = bh & 7;
        const bf16* base = QKV + (size_t)b * SEQ * NQKV;
        r.Q = base + (size_t)r.P0 * NQKV + h * 256 + c * 128; r.K = base + 2048 + h * 256 + c * 128; r.V = base + 4096 + h * 256 + vh * 128;
        r.O = Obuf + (size_t)c * TOK * DM + ((size_t)b * SEQ + r.P0) * DM + h * 256 + vh * 128; r.CB = nullptr; r.h = h; }
    else { const int b = s >> 4, h = s & 15; const bf16* base = QKV + (size_t)b * SEQ * NQKV;
        r.Q = base + (size_t)r.P0 * NQKV + h * 128; r.K = base + 2048 + h * 128; r.V = base + 4096 + h * 128;
        r.O = Obuf + ((size_t)b * SEQ + r.P0) * DM + h * 128; r.CB = CB + (size_t)s * SEQ; r.h = 0; }
    return r;
}
template <int MODE> __device__ __forceinline__ void attn_phase(char* lds, const bf16* QKV, bf16* Obuf, const float* CB, int G, int bx) {
    int i = 0, pass = 0, s = 0, x = 0;
    if (!attn_item<MODE>(0, G, bx, s, x)) return;
    att::BlockRef cur = attn_ref<MODE>(s, x, QKV, Obuf, CB);
    att::Seam S;
    att::attn_prime<MODE>(cur, lds, S);
    for (;;) {
        int sn = s, xn = x, in = i, passn = pass + 1; bool last = false;
        if (pass == 1) { passn = 0; in = i + 1; if (!attn_item<MODE>(in, G, bx, sn, xn)) last = true; }
        const att::BlockRef nxt = last ? cur : attn_ref<MODE>(sn, passn ? 63 - xn : xn, QKV, Obuf, CB);
        att::attn_block<MODE>(cur, nxt, lds, S);
        if (last) break;
        cur = nxt; s = sn; x = xn; i = in; pass = passn;
    }
}

__global__ void __launch_bounds__(NWAVES * 64, 2) yoco_fwd(Args args) {
    extern __shared__ __attribute__((aligned(16))) unsigned char lds[];
    cg::grid_group grid = cg::this_grid();
    LAS unsigned char* ldsl = (LAS unsigned char*)lds;
    const int G = gridDim.x, bx = blockIdx.x, NGW = G * NWAVES;
    int tid, lane, wave, gw;
#define FRESH() do { tid = threadIdx.x; asm volatile("" : "+v"(tid)); lane = tid & 63; wave = __builtin_amdgcn_readfirstlane(tid >> 6); gw = bx * NWAVES + wave; } while (0)
    FRESH();
    unsigned char* ws = args.ws;
    const float* x = args.in[0]; float* out = args.out;
    bf16* Wqkv0 = (bf16*)(ws + WS_WQKV0); bf16* Woa = (bf16*)(ws + WS_WOA); bf16* Wmi0 = (bf16*)(ws + WS_WMI0); bf16* Wmo0 = (bf16*)(ws + WS_WMO0);
    bf16* Wqkv1 = (bf16*)(ws + WS_WQKV1); bf16* Wob = (bf16*)(ws + WS_WOB); bf16* Wmi1 = (bf16*)(ws + WS_WMI1); bf16* Wmo1 = (bf16*)(ws + WS_WMO1);
    bf16* QKV = (bf16*)(ws + WS_QKV); bf16* OC = (bf16*)(ws + WS_OC); bf16* HID = (bf16*)(ws + WS_HID); bf16* XN = (bf16*)(ws + WS_XN);
    float* Fb = (float*)(ws + WS_F); float* CB = (float*)(ws + WS_CB);

    {
        LAS float* scr = (LAS float*)(ldsl + wave * 16384);
        const float* ag = args.in[2]; const float* mg = args.in[3]; const float* kg = args.in[11];
        constexpr int I_QKV = (DM / 64) * (NQKV / 32), I_DD = (DM / 64) * (DM / 32), I_MI = (DM / 64) * (FF / 32), I_MO = (FF / 64) * (DM / 32);
        constexpr int NITEMS = I_QKV + 5 * I_DD + 2 * I_MI + 2 * I_MO;
        for (int it = gw; it < NITEMS; it += NGW) {
            int r = it;
            if (r < I_QKV) { transpose_item(args.in[4], DM, NQKV, Wqkv0, 0, ag, scr, r, lane); continue; } r -= I_QKV;
            if (r < I_DD) { transpose_item(args.in[10], DM, DM, Woa, 0, nullptr, scr, r, lane); continue; } r -= I_DD;
            if (r < I_DD) { transpose_item(args.in[16], DM, DM, Wqkv1, 0, ag + DM, scr, r, lane); continue; } r -= I_DD;
            if (r < I_DD) { transpose_item(args.in[12], DM, DM, Wqkv1, DM, kg, scr, r, lane); continue; } r -= I_DD;
            if (r < I_DD) { transpose_item(args.in[13], DM, DM, Wqkv1, 2 * DM, kg, scr, r, lane); continue; } r -= I_DD;
            if (r < I_DD) { transpose_item(args.in[17], DM, DM, Wob, 0, nullptr, scr, r, lane); continue; } r -= I_DD;
            if (r < I_MI) { transpose_item(args.in[18], DM, FF, Wmi0, 0, mg, scr, r, lane); continue; } r -= I_MI;
            if (r < I_MI) { transpose_item(args.in[18] + (size_t)DM * FF, DM, FF, Wmi1, 0, mg + DM, scr, r, lane); continue; } r -= I_MI;
            if (r < I_MO) { transpose_item(args.in[19], FF, DM, Wmo0, 0, nullptr, scr, r, lane); continue; } r -= I_MO;
            transpose_item(args.in[19] + (size_t)FF * DM, FF, DM, Wmo1, 0, nullptr, scr, r, lane);
        }
        { const float* wf = args.in[14]; const int gt = bx * 512 + tid, NT_ = G * 512;
          for (int e = gt; e < (NQKV1 - NQKV) * DM; e += NT_) { const int n = e / DM, k = e % DM; Wqkv1[(size_t)(NQKV + n) * DM + k] = (n < FH) ? (bf16)f2bf(wf[(size_t)k * FH + n] * kg[k]) : (bf16)0; } }
        norm_phase(x, XN, gw, NGW, lane);
    }
    grid.sync();
    { pg8::Gemm g{XN, Wqkv0, TOK, NQKV, DM}; pg8::StaticOrder S; S.init(TOK, NQKV, G, bx);
      pg8::EpiX<0> E{QKV, NQKV, nullptr, nullptr, nullptr};
      pg8::gemm_phase<pg8::EpiX<0>, pg8::StaticOrder, PG8_ALIGN, PG8_SP2>(ldsl, g, S, E); }
    grid.sync();
    {
      FRESH(); const float* tab = args.in[1]; float* tb = (float*)(lds + att::OFF_TB);
      for (int idx = tid; idx < 2048; idx += 512) { const int h = idx >> 8, rel = (idx & 255) - 192; const int n = rel < 0 ? -rel : rel;
          int bk = n < 8 ? n : 8 + (n >= 12) + (n >= 16) + (n >= 23) + (n >= 32) + (n >= 46) + (n >= 64) + (n >= 91); if (rel > 0) bk += 16;
          tb[idx] = (tab[bk * 8 + h] - tab[15 * 8 + h]) * 11.313708498984761f; }
      __syncthreads();
#ifndef NO_ATT0
      attn_phase<0>((char*)lds, QKV, OC, nullptr, G, bx);
#endif
    }
    grid.sync();
    FRESH(); combine_phase(OC, XN, args.in[5], args.in[6], args.in[7], args.in[8], args.in[9], gw, NGW, lane);
    grid.sync();
    { pg8::Gemm g{XN, Woa, TOK, DM, DM}; pg8::StaticOrder S; S.init(TOK, DM, G, bx);
      pg8::EpiX<2> E{nullptr, DM, x, out, nullptr};
      pg8::gemm_phase<pg8::EpiX<2>, pg8::StaticOrder, PG8_ALIGN, PG8_SP2>(ldsl, g, S, E); }
    grid.sync();
    FRESH(); norm_phase(out, XN, gw, NGW, lane);
    grid.sync();
    { pg8::Gemm g{XN, Wmi0, TOK, FF, DM}; pg8::StaticOrder S; S.init(TOK, FF, G, bx);
      pg8::EpiX<1> E{HID, FF, nullptr, nullptr, nullptr};
      pg8::gemm_phase<pg8::EpiX<1>, pg8::StaticOrder, PG8_ALIGN, PG8_SP2>(ldsl, g, S, E); }
    grid.sync();
    { pg8::Gemm g{HID, Wmo0, TOK, DM, FF}; pg8::StaticOrder S; S.init(TOK, DM, G, bx);
      pg8::EpiX<2> E{nullptr, DM, out, out, nullptr};
      pg8::gemm_phase<pg8::EpiX<2>, pg8::StaticOrder, PG8_ALIGN, PG8_SP2>(ldsl, g, S, E); }
    grid.sync();
    FRESH(); norm_phase(out, XN, gw, NGW, lane);
    grid.sync();
    { pg8::Gemm g{XN, Wqkv1, TOK, NQKV1, DM}; pg8::StaticOrder S; S.init(TOK, NQKV1, G, bx);
      pg8::EpiX<3> E{QKV, NQKV, nullptr, nullptr, Fb};
      pg8::gemm_phase<pg8::EpiX<3>, pg8::StaticOrder, PG8_ALIGN, PG8_SP2>(ldsl, g, S, E); }
    grid.sync();
#ifndef NO_CUM
    FRESH(); cumsum_phase(Fb, args.in[15], CB, ldsl, bx, G, tid);
#endif
    grid.sync();
#ifndef NO_ATT1
    attn_phase<1>((char*)lds, QKV, XN, CB, G, bx);
#endif
    grid.sync();
    { pg8::Gemm g{XN, Wob, TOK, DM, DM}; pg8::StaticOrder S; S.init(TOK, DM, G, bx);
      pg8::EpiX<2> E{nullptr, DM, out, out, nullptr};
      pg8::gemm_phase<pg8::EpiX<2>, pg8::StaticOrder, PG8_ALIGN, PG8_SP2>(ldsl, g, S, E); }
    grid.sync();
    FRESH(); norm_phase(out, XN, gw, NGW, lane);
    grid.sync();
    { pg8::Gemm g{XN, Wmi1, TOK, FF, DM}; pg8::StaticOrder S; S.init(TOK, FF, G, bx);
      pg8::EpiX<1> E{HID, FF, nullptr, nullptr, nullptr};
      pg8::gemm_phase<pg8::EpiX<1>, pg8::StaticOrder, PG8_ALIGN, PG8_SP2>(ldsl, g, S, E); }
    grid.sync();
    { pg8::Gemm g{HID, Wmo1, TOK, DM, FF}; pg8::StaticOrder S; S.init(TOK, DM, G, bx);
      pg8::EpiX<2> E{nullptr, DM, out, out, nullptr};
      pg8::gemm_phase<pg8::EpiX<2>, pg8::StaticOrder, PG8_ALIGN, PG8_SP2>(ldsl, g, S, E); }
    grid.sync();
    FRESH(); final_norm_phase(out, args.in[20], gw, NGW, lane);
}

extern "C" void kernel_launch(void* const* d_in, const int* in_sizes, int n_in, void* d_out, int out_size, void* d_ws, size_t ws_size, hipStream_t stream) {
    static int grid = 0;
    if (grid == 0) {
        if (n_in != 21 || in_sizes[0] != TOK * DM || out_size != TOK * DM || ws_size < WS_END) { fprintf(stderr, "kernel_launch: unexpected shapes (n_in %d, in0 %d, out %d, ws %zu)\n", n_in, n_in > 0 ? in_sizes[0] : -1, out_size, ws_size); grid = -1; return; }
        int dev = 0, cus = 0, per_cu = 0;
        (void)hipGetDevice(&dev); (void)hipDeviceGetAttribute(&cus, hipDeviceAttributeMultiprocessorCount, dev);
        if (hipFuncSetAttribute((const void*)yoco_fwd, hipFuncAttributeMaxDynamicSharedMemorySize, LDS_BYTES) != hipSuccess) { fprintf(stderr, "kernel_launch: hipFuncSetAttribute failed\n"); grid = -1; return; }
        if (hipOccupancyMaxActiveBlocksPerMultiprocessor(&per_cu, (const void*)yoco_fwd, NWAVES * 64, LDS_BYTES) != hipSuccess || per_cu < 1) { fprintf(stderr, "kernel_launch: occupancy query gives %d\n", per_cu); per_cu = 1; }
        (void)hipGetLastError();
        grid = cus > 0 ? cus : 256;
    }
    if (grid < 0) return;
    Args a{};
    for (int i = 0; i < 21; ++i) a.in[i] = (const float*)d_in[i];
    a.out = (float*)d_out; a.ws = (unsigned char*)d_ws;
    void* kargs[] = {&a};
    hipError_t e = hipLaunchCooperativeKernel((const void*)yoco_fwd, dim3(grid), dim3(NWAVES * 64), kargs, LDS_BYTES, stream);
    if (e != hipSuccess) fprintf(stderr, "kernel_launch: cooperative launch failed: %s (grid %d)\n", hipGetErrorString(e), grid);
}
```

```cpp
#include <hip/hip_runtime.h>
#include <hip/hip_cooperative_groups.h>
#include <cstdio>
#include <cstdint>
namespace cg = cooperative_groups;
namespace pg8 {
#define PG8_LAS __attribute__((address_space(3)))
typedef unsigned short bf16_t;
typedef short bf16x8 __attribute__((ext_vector_type(8)));
typedef float f32x4 __attribute__((ext_vector_type(4)));
typedef unsigned u32x4 __attribute__((ext_vector_type(4)));
constexpr int BM = 256, BK = 64, HALF = 128, HTB = HALF * BK * 2  , STAGE_BYTES = 8 * HTB, NXCD = 8, WGM = 8;

__host__ __device__ __forceinline__ int lds_byte(int r, int c) { const int st = (r >> 4) * 2 + (c >> 5), rr = r & 15, cc = c & 31, ob = rr * 64 + cc * 2; return st * 1024 + (ob ^ (((ob >> 9) & 1) << 5)); }
__host__ __device__ __forceinline__ void stage_rc(int b, int& R, int& C) { const int st = b / 1024, sb = b % 1024, swz = sb ^ (((sb >> 9) & 1) << 5); R = (st >> 1) * 16 + swz / 64; C = (st & 1) * 32 + (swz % 64) / 2; }
__host__ __device__ __forceinline__ int perm32(int rho) { const int n = rho >> 4, i = rho & 15; return 8 * (i >> 2) + 4 * n + (i & 3); }

struct Unit { int pm, pn; };
struct Gemm { const bf16_t* A; const bf16_t* Bt; int M, N, K; };

struct StaticOrder {
    int nM, nN, nwg, G, c;
    __host__ __device__ void init(int M, int N, int G_, int c_) { nM = M / BM; nN = N / BM; nwg = nM * nN; G = G_; c = c_; }
    __host__ __device__ bool next(int i, Unit& u) const {
        const long L = (long)i * G + c; if (L >= nwg) return false;
        int wgid = (int)L; { const int q = nwg / NXCD, r = nwg % NXCD, xcd = wgid % NXCD, off = wgid / NXCD; wgid = (xcd < r ? xcd * (q + 1) : r * (q + 1) + (xcd - r) * q) + off; }
        const int nig = WGM * nN, gid = wgid / nig, fm = gid * WGM, gsz = (nM - fm) < WGM ? (nM - fm) : WGM;
        u.pm = fm + ((wgid % nig) % gsz); u.pn = (wgid % nig) / gsz; return true;
    }
    __device__ __forceinline__ void a_ready(const Unit&) const {}
    __device__ __forceinline__ void done(const Unit&) const {}
};

__device__ __forceinline__ unsigned cvt_pk_bf16(float lo, float hi) { unsigned r; asm volatile("v_cvt_pk_bf16_f32 %0, %1, %2" : "=v"(r) : "v"(lo), "v"(hi)); return r; }
typedef float f32x2 __attribute__((ext_vector_type(2)));
template <int MODE> struct EpiX {
    static constexpr bool PERM = true, AFTER_DRAIN = false;
    bf16_t* O; int ldc; const float* base; float* out; float* F;
    __device__ __forceinline__ void operator()(const f32x4 (&acc)[2][2][4][2], const Unit& u, int wr, int wc, int fr, int fq) const {
        const int row0 = u.pm * BM + wr * 64 + fr, col0 = u.pn * BM + wc * 32 + 8 * fq;
        const bool ftile = (MODE == 3) && (u.pn * BM >= 6144);
#pragma unroll
        for (int ai = 0; ai < 2; ++ai)
#pragma unroll
            for (int m = 0; m < 4; ++m) { const size_t row = (size_t)(row0 + ai * HALF + m * 16);
#pragma unroll
                for (int bj = 0; bj < 2; ++bj) { f32x4 v0 = acc[ai][bj][m][0], v1 = acc[ai][bj][m][1]; const int col = col0 + bj * HALF;
                    if (MODE == 2) { const float* bp = base + row * ldc + col; float* op = out + row * ldc + col;
                        const f32x4 b0 = *(const f32x4*)bp, b1 = *(const f32x4*)(bp + 4); *(f32x4*)op = b0 + v0; *(f32x4*)(op + 4) = b1 + v1; }
                    else if (ftile) { if (bj == 0 && wc == 0 && fq < 2) { float* fp = F + row * 16 + 8 * fq; *(f32x4*)fp = v0; *(f32x4*)(fp + 4) = v1; } }
                    else { if (MODE == 1) {
#pragma unroll
                            for (int e = 0; e < 4; ++e) { const float a = fmaxf(v0[e], 0.f), b = fmaxf(v1[e], 0.f); v0[e] = a * a; v1[e] = b * b; } }
                        u32x4 w; w.x = cvt_pk_bf16(v0[0], v0[1]); w.y = cvt_pk_bf16(v0[2], v0[3]); w.z = cvt_pk_bf16(v1[0], v1[1]); w.w = cvt_pk_bf16(v1[2], v1[3]);
                        *(u32x4*)(O + row * ldc + col) = w; } }
                if (MODE == 2) asm volatile("" ::: "memory"); }
    }
};
template <class Epi, class Sched, bool ALIGN_EPI = false, bool SP2 = false>
__device__ __forceinline__ void gemm_phase(PG8_LAS unsigned char* lds, const Gemm g, const Sched& S, const Epi& E) {
    int tid = threadIdx.x; asm volatile("" : "+v"(tid));
    const int wid = __builtin_amdgcn_readfirstlane(tid >> 6), lane = tid & 63, wr = wid >> 2, wc = wid & 3, fr = lane & 15, fq = lane >> 4;
    const int K = g.K, nt = K / BK;
    unsigned voffA[2], voffB[2];
#pragma unroll
    for (int i = 0; i < 2; ++i) { int R, C; stage_rc(tid * 16 + i * 8192, R, C); const int Rb = Epi::PERM ? ((R & ~31) + perm32(R & 31)) : R;
        voffA[i] = (unsigned)(R * K + C) * 2u; voffB[i] = (unsigned)(Rb * K + C) * 2u; }
    const size_t kstep = (size_t)(BK * 2);
    const size_t hstep = (size_t)HALF * K * 2;
    const size_t tstep = 2 * hstep;
    const unsigned ldsw = (unsigned)wid * 1024u;
    const int aoff = lds_byte(wr * 64 + fr, fq * 8), boff = lds_byte(wc * 32 + fr, fq * 8);
#define PG8_SA(b, h) (((b) * 2 + (h)) * HTB)
#define PG8_SB(b, h) ((4 + (b) * 2 + (h)) * HTB)
#define PG8_STAGE(bufoff, gbase, voff) do { _Pragma("unroll") for (int _i = 0; _i < 2; ++_i) \
        __builtin_amdgcn_global_load_lds((const unsigned*)((const char*)(gbase) + (voff)[_i]), (PG8_LAS unsigned*)(lds + (bufoff) + ldsw + _i * 8192), 16, 0, 0); } while (0)
#define PG8_LDA(dst, b, h) do { _Pragma("unroll") for (int m = 0; m < 4; ++m) _Pragma("unroll") for (int k = 0; k < 2; ++k) dst[m][k] = *(const PG8_LAS bf16x8*)(lds + PG8_SA(b, h) + aoff + m * 2048 + k * 1024); } while (0)
#define PG8_LDB(dst, b, h) do { _Pragma("unroll") for (int n = 0; n < 2; ++n) _Pragma("unroll") for (int k = 0; k < 2; ++k) dst[n][k] = *(const PG8_LAS bf16x8*)(lds + PG8_SB(b, h) + boff + n * 2048 + k * 1024); } while (0)
#define PG8_MMA(ai, bj, At, Bt) do { __builtin_amdgcn_s_setprio(1); _Pragma("unroll") for (int m = 0; m < 4; ++m) _Pragma("unroll") for (int n = 0; n < 2; ++n) _Pragma("unroll") for (int k = 0; k < 2; ++k) \
        acc[ai][bj][m][n] = __builtin_amdgcn_mfma_f32_16x16x32_bf16(Bt[n][k], At[m][k], acc[ai][bj][m][n], 0, 0, 0); __builtin_amdgcn_s_setprio(0); } while (0)
#define PG8_WAIT_V(n) asm volatile("s_waitcnt vmcnt(" #n ")" ::: "memory")
#define PG8_WAIT_L(n) asm volatile("s_waitcnt lgkmcnt(" #n ")" ::: "memory")
#define PG8_BAR __builtin_amdgcn_s_barrier()
#define PG8_SCHED __builtin_amdgcn_sched_barrier(0)
    Unit cur, nxt; int ui = 0;
    if (!S.next(0, cur)) return;
    f32x4 acc[2][2][4][2];
#pragma unroll
    for (int a = 0; a < 2; ++a)
#pragma unroll
        for (int b = 0; b < 2; ++b)
#pragma unroll
            for (int m = 0; m < 4; ++m)
#pragma unroll
                for (int n = 0; n < 2; ++n) acc[a][b][m][n] = (f32x4){0.f, 0.f, 0.f, 0.f};
    bf16x8 At[4][2], B0[2][2], B1[2][2];
    const char* cA = (const char*)g.A + (size_t)cur.pm * tstep; const char* cB = (const char*)g.Bt + (size_t)cur.pn * tstep;
    S.a_ready(cur);
    if constexpr (SP2) {
        PG8_STAGE(PG8_SB(0, 0), cB, voffB); PG8_STAGE(PG8_SB(0, 1), cB + hstep, voffB); PG8_STAGE(PG8_SA(0, 0), cA, voffA); PG8_STAGE(PG8_SA(0, 1), cA + hstep, voffA);
        if (wr == 1) PG8_BAR;
        PG8_WAIT_V(2); PG8_BAR;
        PG8_STAGE(PG8_SB(1, 0), cB + kstep, voffB); PG8_STAGE(PG8_SA(1, 0), cA + kstep, voffA); PG8_STAGE(PG8_SB(1, 1), cB + hstep + kstep, voffB);
        PG8_WAIT_V(6); PG8_BAR;
    } else {
        PG8_STAGE(PG8_SB(0, 0), cB, voffB); PG8_STAGE(PG8_SA(0, 0), cA, voffA); PG8_STAGE(PG8_SB(0, 1), cB + hstep, voffB); PG8_STAGE(PG8_SA(0, 1), cA + hstep, voffA);
        if (wr == 1) PG8_BAR;
        PG8_WAIT_V(4); PG8_BAR;
        PG8_STAGE(PG8_SB(1, 0), cB + kstep, voffB); PG8_STAGE(PG8_SA(1, 0), cA + kstep, voffA); PG8_STAGE(PG8_SB(1, 1), cB + hstep + kstep, voffB);
        PG8_WAIT_V(6); PG8_BAR;
    }
    for (;;) {
        const bool has_next = S.next(ui + 1, nxt);
        const char* nA = has_next ? (const char*)g.A + (size_t)nxt.pm * tstep : cA; const char* nB = has_next ? (const char*)g.Bt + (size_t)nxt.pn * tstep : cB;
        for (int t = 0; t < nt; t += 2) {
            const bool last = (t == nt - 2);
            const char* a1 = cA + (size_t)(t + 1) * kstep;
            const char* a2 = last ? nA : cA + (size_t)(t + 2) * kstep; const char* b2 = last ? nB : cB + (size_t)(t + 2) * kstep;
            const char* a3 = a2 + kstep; const char* b3 = b2 + kstep;
            if (last && has_next) S.a_ready(nxt);
            if constexpr (SP2) {
            PG8_LDB(B0, 0, 0); PG8_LDB(B1, 0, 1); PG8_SCHED; PG8_LDA(At, 0, 0); PG8_STAGE(PG8_SA(1, 1), a1 + hstep, voffA);
            PG8_WAIT_V(8); PG8_WAIT_L(0); PG8_BAR; PG8_MMA(0, 0, At, B0); PG8_MMA(0, 1, At, B1); PG8_BAR; PG8_SCHED;
            PG8_LDA(At, 0, 1); PG8_STAGE(PG8_SB(0, 0), b2, voffB); PG8_STAGE(PG8_SB(0, 1), b2 + hstep, voffB); PG8_STAGE(PG8_SA(0, 0), a2, voffA);
            PG8_WAIT_V(8); PG8_WAIT_L(0); PG8_BAR; PG8_MMA(1, 0, At, B0); PG8_MMA(1, 1, At, B1); PG8_BAR; PG8_SCHED;
            PG8_LDB(B0, 1, 0); PG8_LDB(B1, 1, 1); PG8_SCHED; PG8_LDA(At, 1, 0); PG8_STAGE(PG8_SA(0, 1), a2 + hstep, voffA);
            PG8_WAIT_V(8); PG8_WAIT_L(0); PG8_BAR; PG8_MMA(0, 0, At, B0); PG8_MMA(0, 1, At, B1); PG8_BAR; PG8_SCHED;
            PG8_LDA(At, 1, 1); PG8_STAGE(PG8_SB(1, 0), b3, voffB); PG8_STAGE(PG8_SB(1, 1), b3 + hstep, voffB); PG8_STAGE(PG8_SA(1, 0), a3, voffA);
            PG8_WAIT_V(8); PG8_WAIT_L(0); PG8_BAR; PG8_MMA(1, 0, At, B0); PG8_MMA(1, 1, At, B1); PG8_BAR; PG8_SCHED;
            } else {
            PG8_LDB(B0, 0, 0); PG8_SCHED; PG8_LDA(At, 0, 0); PG8_STAGE(PG8_SA(1, 1), a1 + hstep, voffA);
            PG8_WAIT_L(8); PG8_BAR; PG8_WAIT_L(0); PG8_MMA(0, 0, At, B0); PG8_BAR; PG8_SCHED;
            PG8_LDB(B1, 0, 1); PG8_STAGE(PG8_SB(0, 0), b2, voffB);
            PG8_BAR; PG8_WAIT_L(0); PG8_MMA(0, 1, At, B1); PG8_BAR;
            PG8_LDA(At, 0, 1); PG8_STAGE(PG8_SA(0, 0), a2, voffA);
            PG8_BAR; PG8_WAIT_L(0); PG8_MMA(1, 0, At, B0); PG8_BAR; PG8_SCHED;
            PG8_STAGE(PG8_SB(0, 1), b2 + hstep, voffB);
            PG8_WAIT_V(6); PG8_BAR; PG8_MMA(1, 1, At, B1); PG8_BAR;
            PG8_LDB(B0, 1, 0); PG8_SCHED; PG8_LDA(At, 1, 0); PG8_STAGE(PG8_SA(0, 1), a2 + hstep, voffA);
            PG8_WAIT_L(8); PG8_BAR; PG8_WAIT_L(0); PG8_MMA(0, 0, At, B0); PG8_BAR; PG8_SCHED;
            PG8_LDB(B1, 1, 1); PG8_STAGE(PG8_SB(1, 0), b3, voffB);
            PG8_BAR; PG8_WAIT_L(0); PG8_MMA(0, 1, At, B1); PG8_BAR;
            PG8_LDA(At, 1, 1); PG8_STAGE(PG8_SA(1, 0), a3, voffA);
            PG8_BAR; PG8_WAIT_L(0); PG8_MMA(1, 0, At, B0); PG8_BAR; PG8_SCHED;
            PG8_STAGE(PG8_SB(1, 1), b3 + hstep, voffB);
            PG8_WAIT_V(6); PG8_BAR; PG8_MMA(1, 1, At, B1); PG8_BAR;
            }
        }
        if constexpr (ALIGN_EPI) { if (wr == 0) PG8_BAR; }
        if constexpr (!Epi::AFTER_DRAIN) { E(acc, cur, wr, wc, fr, fq); S.done(cur); }
        if (!has_next) break;
#pragma unroll
        for (int a = 0; a < 2; ++a)
#pragma unroll
            for (int b = 0; b < 2; ++b)
#pragma unroll
                for (int m = 0; m < 4; ++m)
#pragma unroll
                    for (int n = 0; n < 2; ++n) acc[a][b][m][n] = (f32x4){0.f, 0.f, 0.f, 0.f};
        cur = nxt; cA = nA; cB = nB; ++ui;
        if constexpr (ALIGN_EPI) { if (wr == 1) PG8_BAR; }
    }
    PG8_WAIT_V(0);
    if constexpr (!ALIGN_EPI) { if (wr == 0) PG8_BAR; }
    PG8_BAR;
    if constexpr (Epi::AFTER_DRAIN) { E.fused(acc, cur, wr, wc, fr, fq, lds, wid, lane); S.done(cur); }
#undef PG8_SA
#undef PG8_SB
#undef PG8_STAGE
#undef PG8_LDA
#undef PG8_LDB
#undef PG8_MMA
#undef PG8_WAIT_V
#undef PG8_WAIT_L
#undef PG8_BAR
#undef PG8_SCHED
}
}
#ifndef PG8_SP2
#define PG8_SP2 true
#endif
#ifndef PG8_ALIGN
#define PG8_ALIGN true
#endif
namespace att {
typedef unsigned short bf16;
typedef short bf16x8 __attribute__((ext_vector_type(8)));
typedef short s16x4 __attribute__((ext_vector_type(4)));
typedef float f32x16 __attribute__((ext_vector_type(16)));
typedef float f32x4 __attribute__((ext_vector_type(4)));
typedef unsigned u32x4 __attribute__((ext_vector_type(4)));
constexpr int D = 128, NW = 8, QBLK = 32, KVBLK = 64, QB = NW * QBLK, LDQ = 6144, LDO = 2048;
constexpr float SCALE = 0.08838834764831845f, THR = 8.f;
constexpr int SHM_V = KVBLK * D * 2, SHM_K = KVBLK * 272;
constexpr int OFF_WS = 2 * SHM_V + 2 * SHM_K, OFF_CL = OFF_WS + NW * 64 * 4, OFF_TB = OFF_CL + 512, LDS_BYTES = OFF_TB + 8192;
#define KROW 272
#define KSWZ(row, colB) ((row) * KROW + (colB))
#define SBAR() __builtin_amdgcn_sched_barrier(0)
__device__ __forceinline__ int v_st(int k, int c) { const int kk = (k & ~0xC) | ((k & 4) << 1) | ((k & 8) >> 1); return ((kk >> 3) * 4 + (c >> 5)) * 512 + ((kk & 7) * 32 + (c & 31)) * 2; }
__device__ __forceinline__ int v_rd_base(int lane) { return ((lane & 3) << 3) | (((lane >> 2) & 3) << 6) | (((lane >> 4) & 1) << 5) | (((lane >> 5) & 1) << 8); }
constexpr int v_rd_off(int d0, int ks, int half) { return d0 * 512 + ks * 4096 + half * 2048; }
__device__ __forceinline__ int crow(int r, int hi) { return (r & 3) + 8 * (r >> 2) + 4 * hi; }
__device__ __forceinline__ unsigned cvtpk(float lo, float hi) { unsigned r; asm volatile("v_cvt_pk_bf16_f32 %0, %1, %2" : "=v"(r) : "v"(lo), "v"(hi)); return r; }
__device__ __forceinline__ void mask_tile(f32x16& p0, f32x16& p1, int dq, unsigned W) {
    const float NEG = -__builtin_inff();
#pragma unroll
    for (int r = 0; r < 16; ++r) { const int c = (r & 3) + 8 * (r >> 2);
        if ((unsigned)(dq - c) >= W) p0[r] = NEG;
        if ((unsigned)(dq - c - 32) >= W) p1[r] = NEG; }
}
__device__ __forceinline__ void add_bias(f32x16& p0, f32x16& p1, const float* tb, int relbase) {
    const float* t = tb + relbase;
#pragma unroll
    for (int r = 0; r < 16; ++r) { const int c = (r & 3) + 8 * (r >> 2); p0[r] += t[c]; p1[r] += t[c + 32]; }
}
__device__ __forceinline__ void partialSM(f32x16& p0, f32x16& p1, float& m_reg, float& mn, float& alpha) {
    float pmax = p0[0]; for (int r = 1; r < 16; ++r) pmax = fmaxf(pmax, p0[r]); for (int r = 0; r < 16; ++r) pmax = fmaxf(pmax, p1[r]);
    { auto rr = __builtin_amdgcn_permlane32_swap(__float_as_uint(pmax), __float_as_uint(pmax), false, false);
      pmax = fmaxf(__uint_as_float(rr[0]), __uint_as_float(rr[1])); }
    constexpr float C2 = 1.4426950408889634f * SCALE;
    if (__builtin_expect(__all((pmax - m_reg) * SCALE <= THR), 1)) { mn = m_reg; alpha = 1.f; }
    else { mn = fmaxf(m_reg, pmax); alpha = __builtin_amdgcn_exp2f((m_reg - mn) * C2); m_reg = mn; }
    const float mnL = -mn * C2;
    for (int r = 0; r < 16; ++r) p0[r] = fmaf(p0[r], C2, mnL); for (int r = 0; r < 16; ++r) p1[r] = fmaf(p1[r], C2, mnL);
    for (int r = 0; r < 16; ++r) p0[r] = __builtin_amdgcn_exp2f(p0[r]);
}
__device__ __forceinline__ void finishSM(f32x16& p0, f32x16& p1, float alpha, float& l_reg, bf16x8& pa0, bf16x8& pa1, bf16x8& pa2, bf16x8& pa3) {
    for (int r = 0; r < 16; ++r) p1[r] = __builtin_amdgcn_exp2f(p1[r]);
    float ps = 0; for (int r = 0; r < 16; ++r) ps += p0[r]; for (int r = 0; r < 16; ++r) ps += p1[r];
    { auto rr = __builtin_amdgcn_permlane32_swap(__float_as_uint(ps), __float_as_uint(ps), false, false);
      ps = __uint_as_float(rr[0]) + __uint_as_float(rr[1]); }
    l_reg = l_reg * alpha + ps;
#define PK4(P, B_, OUT) do { unsigned a0 = cvtpk(P[B_+0], P[B_+1]), a1 = cvtpk(P[B_+2], P[B_+3]);                          \
        unsigned b0 = cvtpk(P[B_+4], P[B_+5]), b1 = cvtpk(P[B_+6], P[B_+7]);                                             \
        auto r0 = __builtin_amdgcn_permlane32_swap(a0, b0, false, false); auto r1 = __builtin_amdgcn_permlane32_swap(a1, b1, false, false); \
        u32x4 w = {r0[0], r1[0], r0[1], r1[1]}; OUT = *reinterpret_cast<bf16x8*>(&w); } while (0)
    PK4(p0, 0, pa0); PK4(p0, 8, pa1); PK4(p1, 0, pa2); PK4(p1, 8, pa3);
#undef PK4
}
template <int KB, bool SK, int MODE>
__device__ __forceinline__ void qkt(f32x16& p0, f32x16& p1, const char* lds, int r32, int hi, const bf16x8* qr, bool act) {
    if (SK && !act) { const float NEG = -__builtin_inff();
#pragma unroll
        for (int r = 0; r < 16; ++r) { p0[r] = NEG; p1[r] = NEG; } return; }
    if (MODE == 1) { const float* cl = (const float*)(lds + OFF_CL) + KB * 64 + 4 * hi;
#pragma unroll
        for (int g = 0; g < 4; ++g) { const f32x4 a = *(const f32x4*)(cl + 8 * g), b = *(const f32x4*)(cl + 32 + 8 * g);
            p0[4 * g] = a[0]; p0[4 * g + 1] = a[1]; p0[4 * g + 2] = a[2]; p0[4 * g + 3] = a[3];
            p1[4 * g] = b[0]; p1[4 * g + 1] = b[1]; p1[4 * g + 2] = b[2]; p1[4 * g + 3] = b[3]; } }
    else { p0 = f32x16{}; p1 = f32x16{}; }
    const char* K_lds = lds + 2 * SHM_V;
    const char* kb0 = K_lds + KB * SHM_K + KSWZ(r32, hi * 16);
#pragma unroll
    for (int d0 = 0; d0 < 8; ++d0) { const char* a = kb0 + d0 * 32;
        bf16x8 b0 = *reinterpret_cast<const bf16x8*>(a);
        bf16x8 b1 = *reinterpret_cast<const bf16x8*>(a + 32 * KROW);
        p0 = __builtin_amdgcn_mfma_f32_32x32x16_bf16(b0, qr[d0], p0, 0, 0, 0);
        p1 = __builtin_amdgcn_mfma_f32_32x32x16_bf16(b1, qr[d0], p1, 0, 0, 0); }
}
template <int VB, bool SK>
__device__ __forceinline__ void pv_tile(f32x16* o, int vb0, bf16x8 pa0, bf16x8 pa1, bf16x8 pa2, bf16x8 pa3, bool act) {
    if (SK && !act) return;
#define TRRD(dst, off) asm volatile("ds_read_b64_tr_b16 %0, %1 offset:%2" : "=&v"(dst) : "v"(vb0), "i"(off) : "memory")
#define PV_D0(d0) do { s16x4 l0, l1, l2, l3, h0, h1, h2, h3; constexpr int b_ = VB * SHM_V + v_rd_off(d0, 0, 0); \
        TRRD(l0, b_); TRRD(h0, b_ + 2048); TRRD(l1, b_ + 4096); TRRD(h1, b_ + 6144); TRRD(l2, b_ + 8192); TRRD(h2, b_ + 10240); TRRD(l3, b_ + 12288); TRRD(h3, b_ + 14336); \
        asm volatile("s_waitcnt lgkmcnt(0)" ::: "memory"); SBAR(); \
        o[d0] = __builtin_amdgcn_mfma_f32_32x32x16_bf16(pa0, (bf16x8){l0[0], l0[1], l0[2], l0[3], h0[0], h0[1], h0[2], h0[3]}, o[d0], 0, 0, 0);   \
        o[d0] = __builtin_amdgcn_mfma_f32_32x32x16_bf16(pa1, (bf16x8){l1[0], l1[1], l1[2], l1[3], h1[0], h1[1], h1[2], h1[3]}, o[d0], 0, 0, 0);   \
        o[d0] = __builtin_amdgcn_mfma_f32_32x32x16_bf16(pa2, (bf16x8){l2[0], l2[1], l2[2], l2[3], h2[0], h2[1], h2[2], h2[3]}, o[d0], 0, 0, 0);   \
        o[d0] = __builtin_amdgcn_mfma_f32_32x32x16_bf16(pa3, (bf16x8){l3[0], l3[1], l3[2], l3[3], h3[0], h3[1], h3[2], h3[3]}, o[d0], 0, 0, 0); } while (0)
    PV_D0(0); PV_D0(1); PV_D0(2); PV_D0(3);
#undef PV_D0
#undef TRRD
}
struct BlockRef { const bf16* Q; const bf16* K; const bf16* V; bf16* O; const float* CB; int P0, jlo, h; };
struct Seam { bf16x8 qr[8]; bf16x8 st_v0, st_v1, st_k0, st_k1; };
#define LD8(p) (*reinterpret_cast<const bf16x8*>(p))
#define ROWQ(p, k0, rr) ((p) + (size_t)((k0) + (rr)) * LDQ + sc)
#define VMW() asm volatile("s_waitcnt vmcnt(0)" ::: "memory")
#define VMWN(n) asm volatile("s_waitcnt vmcnt(%0)" :: "i"(n) : "memory")
#define SLOAD_H(R, k0, bf) do { const char* kb__ = (const char*)(R).K + (size_t)(k0) * (LDQ * 2); const char* vb__ = (const char*)(R).V + (size_t)(k0) * (LDQ * 2); \
                         S.st_v0 = LD8(vb__ + vo0); S.st_v1 = LD8(vb__ + vo1); S.st_k0 = LD8(kb__ + vo0); S.st_k1 = LD8(kb__ + vo1);  \
                         if (MODE == 1) { if (wid == 0) __builtin_amdgcn_global_load_lds((const unsigned*)((const char*)((R).CB + (k0)) + lane4), (__attribute__((address_space(3))) unsigned*)(lds + OFF_CL + (bf) * 256), 4, 0, 0); } } while (0)
#define SWRITE_HK(bf) do { *(bf16x8*)(K_lds + (bf) * SHM_K + kws) = S.st_k0; *(bf16x8*)(K_lds + (bf) * SHM_K + kws + 32 * KROW) = S.st_k1; } while (0)
#define SWRITE_HV(bf) do { *(bf16x8*)(V_lds + (bf) * SHM_V + vst0) = S.st_v0; *(bf16x8*)(V_lds + (bf) * SHM_V + vst1) = S.st_v1; } while (0)
#define SWRITE_H(bf) do { SWRITE_HV(bf); SWRITE_HK(bf); } while (0)
template <int MODE>
__device__ __forceinline__ void attn_prime(const BlockRef& cur, char* lds, Seam& S) {
    int tid = threadIdx.x; asm volatile("" : "+v"(tid));
    const int wid = __builtin_amdgcn_readfirstlane(tid >> 6), lane = tid & 63, r32 = lane & 31, hi = lane >> 5;
    const int sr = tid >> 4, sc = (tid & 15) * 8, kws = KSWZ(sr, sc * 2); char* K_lds = lds + 2 * SHM_V;
    const int kb0 = cur.jlo * KVBLK;
    const unsigned vo0 = (unsigned)((sr * LDQ + sc) * 2), vo1 = vo0 + 32u * LDQ * 2u, lane4 = (unsigned)lane * 4u, qo = (unsigned)(((wid * QBLK + r32) * LDQ + hi * 8) * 2);
#pragma unroll
    for (int d0 = 0; d0 < 8; ++d0) S.qr[d0] = LD8((const char*)cur.Q + qo + d0 * 32);
    SLOAD_H(cur, kb0, 0); VMW(); SWRITE_HK(0);
    __syncthreads();
}
template <int MODE>
__device__ __forceinline__ void attn_block(const BlockRef& cur, const BlockRef& nxt, char* lds, Seam& S) {
    constexpr bool SK = (MODE == 0);
    int tid = threadIdx.x; asm volatile("" : "+v"(tid));
    const int wid = __builtin_amdgcn_readfirstlane(tid >> 6), lane = tid & 63, r32 = lane & 31, hi = lane >> 5;
    const int j_lo = cur.jlo, j_hi = cur.P0 / KVBLK + QB / KVBLK;
    const int NT = j_hi - j_lo;
    const int kbn = nxt.jlo * KVBLK;
    const int qlo = cur.P0 + wid * QBLK, qm = qlo + r32 - 4 * hi;
    char* V_lds = lds; char* K_lds = lds + 2 * SHM_V;
    float* ws = (float*)(lds + OFF_WS) + wid * 64; float* li_l = ws, * al_l = ws + 32;
    const float* tbh = (const float*)(lds + OFF_TB) + cur.h * 256;
    float m_reg = -1e30f, l_reg = 0; f32x16 o[4] = {};
    const int sr = tid >> 4, sc = (tid & 15) * 8, vst0 = v_st(sr, sc), vst1 = v_st(32 + sr, sc), kws = KSWZ(sr, sc * 2);
    const int vb0 = (int)(uintptr_t)V_lds + v_rd_base(lane);
    const unsigned vo0 = (unsigned)((sr * LDQ + sc) * 2), vo1 = vo0 + 32u * LDQ * 2u, lane4 = (unsigned)lane * 4u, qo = (unsigned)(((wid * QBLK + r32) * LDQ + hi * 8) * 2);
#define RESC(a) do { if (__any((a) < 1.f)) { if (hi == 0) al_l[r32] = (a); asm volatile("s_waitcnt lgkmcnt(0)" ::: "memory");              \
                     for (int d_ = 0; d_ < 4; ++d_) for (int r = 0; r < 16; ++r) o[d_][r] *= al_l[crow(r, hi)]; } } while (0)
#define KBASE(t) ((j_lo + (t)) * KVBLK)
#define ACT(t) (MODE == 0 ? (KBASE(t) <= qlo) : true)
#define MASKT(P0_, P1_, t) do { const int kb_ = KBASE(t);                                                                              \
        if (MODE == 1) { if (kb_ + KVBLK - 1 > qlo) mask_tile(P0_, P1_, qm - kb_, 0x40000000u); }                                       \
        else { if (kb_ <= qlo && kb_ + KVBLK - 1 - qlo >= -90) add_bias(P0_, P1_, tbh, kb_ - qm + 192); } } while (0)
    constexpr int NQL = 8;
#define SEAM_K0() do { VMWN(NQL); SWRITE_HK(0); SBAR(); } while (0)
    f32x16 pA0, pA1, pB0, pB1; float mnA, mnB, alA, alB; bf16x8 pa0, pa1, pa2, pa3;
    SWRITE_HV(0); SBAR();
    if (NT > 1) { SLOAD_H(cur, KBASE(1), 1); }
    SBAR(); qkt<0, SK, MODE>(pA0, pA1, lds, r32, hi, S.qr, ACT(0));
    MASKT(pA0, pA1, 0); partialSM(pA0, pA1, m_reg, mnA, alA);
    if (NT > 1) { VMW(); SWRITE_H(1); }
    __syncthreads();
#define HALF_STEP(PX0, PX1, mnX, alX, PY0, PY1, alY, t, KB, VB, SB) do {                                                      \
        SBAR(); qkt<KB, SK, MODE>(PX0, PX1, lds, r32, hi, S.qr, ACT(t));                                                      \
        finishSM(PY0, PY1, alY, l_reg, pa0, pa1, pa2, pa3); SBAR();                                                           \
        if ((t) + 1 < NT) { SLOAD_H(cur, KBASE((t) + 1), SB); SBAR(); }                                                           \
        pv_tile<VB, SK>(o, vb0, pa0, pa1, pa2, pa3, ACT((t) - 1)); MASKT(PX0, PX1, (t)); partialSM(PX0, PX1, m_reg, mnX, alX); \
        __syncthreads();                                                                                                      \
        if ((t) + 1 < NT) { VMW(); SWRITE_H(SB); }                                                                            \
        RESC(alX); __syncthreads(); } while (0)
    for (int t = 1; t + 1 < NT; t += 2) {
        HALF_STEP(pB0, pB1, mnB, alB, pA0, pA1, alA, t, 1, 0, 0);
        HALF_STEP(pA0, pA1, mnA, alA, pB0, pB1, alB, t + 1, 0, 1, 1);
    }
    const bool even = (NT & 1) == 0;
    if (even) { SBAR(); qkt<1, SK, MODE>(pB0, pB1, lds, r32, hi, S.qr, ACT(NT - 1)); SBAR(); }
    SLOAD_H(nxt, kbn, 0); SBAR();
#pragma unroll
    for (int d0 = 0; d0 < 8; ++d0) S.qr[d0] = LD8((const char*)nxt.Q + qo + d0 * 32);
    SBAR();
    finishSM(pA0, pA1, alA, l_reg, pa0, pa1, pa2, pa3); SBAR();
    pv_tile<0, SK>(o, vb0, pa0, pa1, pa2, pa3, ACT(even ? NT - 2 : NT - 1));
    if (even) { MASKT(pB0, pB1, NT - 1); partialSM(pB0, pB1, m_reg, mnB, alB); __syncthreads(); RESC(alB);
        finishSM(pB0, pB1, alB, l_reg, pa0, pa1, pa2, pa3); SBAR(); pv_tile<1, SK>(o, vb0, pa0, pa1, pa2, pa3, ACT(NT - 1)); }
    SBAR(); SEAM_K0();
    if (hi == 0) li_l[r32] = l_reg; asm volatile("s_waitcnt lgkmcnt(0)" ::: "memory");
    float rli[16];
#pragma unroll
    for (int r = 0; r < 16; ++r) rli[r] = __builtin_amdgcn_rcpf(li_l[crow(r, hi)]);
    char* Ow = (char*)cur.O; const unsigned oo = (unsigned)(((wid * QBLK + 4 * hi) * LDO + r32) * 2);
#pragma unroll
    for (int r = 0; r < 16; ++r) { const unsigned orow = (unsigned)(((r & 3) + 8 * (r >> 2)) * LDO * 2);
#pragma unroll
        for (int d0 = 0; d0 < 4; ++d0) { const float v = o[d0][r] * rli[r];
            const float vn = __shfl_xor(v, 1);
            if ((r32 & 1) == 0) *(unsigned*)(Ow + (oo + orow + d0 * 64)) = cvtpk(v, vn); } }
    __syncthreads();
#undef RESC
#undef KBASE
#undef ACT
#undef MASKT
#undef SEAM_K0
#undef HALF_STEP
}
#undef ROWQ
#undef VMW
#undef VMWN
#undef SLOAD_H
#undef SWRITE_HK
#undef SWRITE_HV
#undef SWRITE_H
#undef LD8
#undef SBAR
#undef KSWZ
#undef KROW
}
#define GAS __attribute__((address_space(1)))
#define LAS __attribute__((address_space(3)))
typedef unsigned short bf16;
typedef unsigned v4u __attribute__((ext_vector_type(4)));
typedef unsigned v2u __attribute__((ext_vector_type(2)));
typedef float f32x4 __attribute__((ext_vector_type(4)));
constexpr int NWAVES = 8;
constexpr int BATCH = 2, SEQ = 16384, DM = 2048, TOK = BATCH * SEQ, FF = 8192, NQKV = 6144, NQKV1 = 6400, FH = 16;
constexpr float NORM_EPS = 1e-6f, SUBLN_EPS = 1e-5f, LAMBDA_INIT = 0.2f;
constexpr size_t MiB = 1u << 20;
constexpr size_t WS_F = 0, WS_CB = 2 * MiB;
constexpr size_t WS_WQKV0 = 4 * MiB, WS_WOA = 28 * MiB, WS_WMI0 = 36 * MiB, WS_WMO0 = 68 * MiB, WS_WQKV1 = 100 * MiB, WS_WOB = 126 * MiB, WS_WMI1 = 134 * MiB, WS_WMO1 = 166 * MiB;
constexpr size_t WS_NRM = 198 * MiB;
constexpr size_t WS_QKV = 200 * MiB;
constexpr size_t WS_OC = 584 * MiB;
constexpr size_t WS_HID = 200 * MiB;
constexpr size_t WS_XN = 840 * MiB;
constexpr size_t WS_END = 968 * MiB;
constexpr int LDS_BYTES = 147456;

__device__ __forceinline__ unsigned f2bf(float f) { unsigned u = __builtin_bit_cast(unsigned, f); return (u + 0x7fffu + ((u >> 16) & 1u)) >> 16; }
__device__ __forceinline__ unsigned pk2(float lo, float hi) { return f2bf(lo) | (f2bf(hi) << 16); }
__device__ __forceinline__ float bf2f(unsigned short b) { return __builtin_bit_cast(float, (unsigned)b << 16); }
__device__ __forceinline__ float wave_sum(float v) {
#pragma unroll
    for (int o = 1; o < 64; o <<= 1) v += __shfl_xor(v, o);
    return v;
}
__device__ __forceinline__ void transpose_item(const float* W, int K, int N, bf16* WT, int row_off, const float* g, LAS float* scr, int item, int lane) {
    const int nblk = N / 32, kb = item / nblk, nb = item % nblk, k0 = 64 * kb, n0 = 32 * nb;
#pragma unroll 8
    for (int i = 0; i < 32; ++i) { const int kk = 2 * i + (lane >> 5); float v = W[(size_t)(k0 + kk) * N + n0 + (lane & 31)]; if (g) v *= g[k0 + kk]; scr[kk * 33 + (lane & 31)] = v; }
    asm volatile("s_waitcnt lgkmcnt(0)" ::: "memory");
    const int c = lane & 7;
#pragma unroll
    for (int j = 0; j < 4; ++j) { const int n = (lane >> 3) + 8 * j; const LAS float* s = scr + (8 * c) * 33 + n;
        v4u o; o.x = pk2(s[0 * 33], s[1 * 33]); o.y = pk2(s[2 * 33], s[3 * 33]); o.z = pk2(s[4 * 33], s[5 * 33]); o.w = pk2(s[6 * 33], s[7 * 33]);
        *(v4u*)(WT + (size_t)(row_off + n0 + n) * K + k0 + 8 * c) = o; }
    asm volatile("s_waitcnt lgkmcnt(0)" ::: "memory");
}
__device__ __forceinline__ void norm_row_to_bf16(const float* xrow, bf16* orow, int lane) {
    const f32x4* xr = (const f32x4*)xrow + lane;
    f32x4 v[8]; float s = 0.f;
#pragma unroll
    for (int j = 0; j < 8; ++j) { v[j] = xr[64 * j]; s += (v[j].x * v[j].x + v[j].y * v[j].y) + (v[j].z * v[j].z + v[j].w * v[j].w); }
    const float rstd = 1.f / sqrtf(wave_sum(s) * (1.f / DM) + NORM_EPS);
    v2u* o8 = (v2u*)orow + lane;
#pragma unroll
    for (int j = 0; j < 8; ++j) { v2u w; w.x = pk2(v[j].x * rstd, v[j].y * rstd); w.y = pk2(v[j].z * rstd, v[j].w * rstd); o8[64 * j] = w; }
}
__device__ __forceinline__ void norm_phase(const float* src, bf16* dst, int gw, int NGW, int lane) {
    for (int m = gw; m < TOK; m += NGW) norm_row_to_bf16(src + (size_t)m * DM, dst + (size_t)m * DM, lane);
}
__device__ __forceinline__ void final_norm_phase(float* io, const float* g, int gw, int NGW, int lane) {
    for (int m = gw; m < TOK; m += NGW) {
        f32x4* xr = (f32x4*)(io + (size_t)m * DM) + lane; const f32x4* gr = (const f32x4*)g + lane;
        f32x4 v[8]; float s = 0.f;
#pragma unroll
        for (int j = 0; j < 8; ++j) { v[j] = xr[64 * j]; s += (v[j].x * v[j].x + v[j].y * v[j].y) + (v[j].z * v[j].z + v[j].w * v[j].w); }
        const float rstd = 1.f / sqrtf(wave_sum(s) * (1.f / DM) + NORM_EPS);
#pragma unroll
        for (int j = 0; j < 8; ++j) xr[64 * j] = v[j] * rstd * gr[64 * j];
    }
}
__device__ __forceinline__ void combine_phase(const bf16* OC, bf16* O, const float* lq1, const float* lk1, const float* lq2, const float* lk2, const float* sg, int gw, int NGW, int lane) {
    const float s1 = wave_sum(lq1[lane] * lk1[lane] + lq1[lane + 64] * lk1[lane + 64]), s2 = wave_sum(lq2[lane] * lk2[lane] + lq2[lane + 64] * lk2[lane + 64]);
    const float lam = expf(s1) - expf(s2) + LAMBDA_INIT;
    float gs[8];
#pragma unroll
    for (int e = 0; e < 8; ++e) gs[e] = sg[(lane & 31) * 8 + e] * (1.f - LAMBDA_INIT);
    for (int m = gw; m < TOK; m += NGW) {
        const v4u* a = (const v4u*)(OC + (size_t)m * DM) + lane; const v4u* b = (const v4u*)(OC + (size_t)TOK * DM + (size_t)m * DM) + lane; v4u* o = (v4u*)(O + (size_t)m * DM) + lane;
#pragma unroll
        for (int st = 0; st < 4; ++st) { const v4u av = a[64 * st], bv = b[64 * st]; float d[8]; float ss = 0.f;
#pragma unroll
            for (int e = 0; e < 4; ++e) { const unsigned aw = av[e], bw = bv[e];
                d[2 * e] = __builtin_bit_cast(float, aw << 16) - lam * __builtin_bit_cast(float, bw << 16);
                d[2 * e + 1] = __builtin_bit_cast(float, aw & 0xffff0000u) - lam * __builtin_bit_cast(float, bw & 0xffff0000u);
                ss += d[2 * e] * d[2 * e] + d[2 * e + 1] * d[2 * e + 1]; }
#pragma unroll
            for (int of = 1; of < 32; of <<= 1) ss += __shfl_xor(ss, of);
            const float rstd = 1.f / sqrtf(ss * (1.f / 256.f) + SUBLN_EPS);
            v4u w; w.x = pk2(d[0] * rstd * gs[0], d[1] * rstd * gs[1]); w.y = pk2(d[2] * rstd * gs[2], d[3] * rstd * gs[3]);
            w.z = pk2(d[4] * rstd * gs[4], d[5] * rstd * gs[5]); w.w = pk2(d[6] * rstd * gs[6], d[7] * rstd * gs[7]); o[64 * st] = w; }
    }
}
__device__ __forceinline__ void cumsum_phase(const float* F, const float* bfb, float* CB, LAS unsigned char* lds, int bx, int G, int tid) {
    LAS double* sc = (LAS double*)lds;
    for (int bh = bx; bh < BATCH * FH; bh += G) {
        const int b = bh / FH, h = bh % FH; const float bias = bfb[h];
        const float* fp = F + ((size_t)b * SEQ + (size_t)tid * 32) * FH + h;
        float ls[32]; double run = 0.0;
#pragma unroll
        for (int i = 0; i < 32; ++i) { const float x = fp[(size_t)i * FH] + bias; ls[i] = fminf(x, 0.f) - log1pf(expf(-fabsf(x))); run += (double)ls[i]; }
        sc[tid] = run; __syncthreads();
        int cur = 0;
        for (int of = 1; of < 512; of <<= 1) { double v = sc[cur * 512 + tid]; if (tid >= of) v += sc[cur * 512 + tid - of]; sc[(cur ^ 1) * 512 + tid] = v; cur ^= 1; __syncthreads(); }
        double acc = sc[cur * 512 + tid] - run;
        float* op = CB + (size_t)bh * SEQ + (size_t)tid * 32;
#pragma unroll
        for (int i = 0; i < 32; ++i) { acc += (double)ls[i]; op[i] = (float)(-acc * 11.313708498984761); }
        __syncthreads();
    }
}

__device__ __forceinline__ void rownorm_phase(const bf16* QKV, unsigned* NRM, int bx, int G, int tid) {
    for (int vw = bx; vw < 256; vw += G) {
        const int bh = vw >> 3, part = vw & 7, b = bh >> 4, h = bh & 15;
        const char* base = (const char*)(QKV + ((size_t)b * SEQ + (size_t)part * 2048) * NQKV + h * 128);
        const unsigned vo = (unsigned)(((tid >> 4) * NQKV + (tid & 15) * 8) * 2);
        float mq = 0.f, mk = 0.f;
#pragma unroll 4
        for (int it = 0; it < 64; ++it) {
            const char* rp = base + (size_t)it * 32 * NQKV * 2;
            const v4u qv = *(const v4u*)(rp + vo), kv = *(const v4u*)(rp + vo + 2048 * 2);
            float sq = 0.f, sk = 0.f;
#pragma unroll
            for (int e = 0; e < 4; ++e) { const float a0 = __builtin_bit_cast(float, qv[e] << 16), a1 = __builtin_bit_cast(float, qv[e] & 0xffff0000u), b0 = __builtin_bit_cast(float, kv[e] << 16), b1 = __builtin_bit_cast(float, kv[e] & 0xffff0000u);
                sq += a0 * a0 + a1 * a1; sk += b0 * b0 + b1 * b1; }
#pragma unroll
            for (int of = 1; of < 16; of <<= 1) { sq += __shfl_xor(sq, of); sk += __shfl_xor(sk, of); }
            mq = fmaxf(mq, sq); mk = fmaxf(mk, sk);
        }
        mq = fmaxf(mq, __shfl_xor(mq, 16)); mq = fmaxf(mq, __shfl_xor(mq, 32)); mk = fmaxf(mk, __shfl_xor(mk, 16)); mk = fmaxf(mk, __shfl_xor(mk, 32));
        if ((tid & 63) == 0) { atomicMax(NRM + bh * 2, __float_as_uint(mq)); atomicMax(NRM + bh * 2 + 1, __float_as_uint(mk)); }
    }
}

struct Args { const float* in[21]; float* out; unsigned char* ws; };
template <int MODE> __device__ __forceinline__ bool attn_item(int i, int G, int bx, int& s, int& x) {
    constexpr int NS = MODE == 0 ? 64 : 32;
    if ((G & 7) == 0) { const int xcd = bx & 7, k = bx >> 3, kpx = G >> 3; const int idx = k + i * kpx; if (idx >= (NS / 8) * 32) return false; s = (idx >> 5) * 8 + xcd; x = idx & 31; return true; }
    const int L = bx + i * G; if (L >= NS * 32) return false; s = L >> 5; x = L & 31; return true;
}
template <int MODE> __device__ __forceinline__ att::BlockRef attn_ref(int s, int qb, int jlo, const bf16* QKV, bf16* Obuf, const float* CB) {
    att::BlockRef r; r.P0 = qb * 256; r.jlo = jlo;
    if (MODE == 0) { const int xcd = s & 7, sl = s >> 3, vh = sl & 1, c = (sl >> 1) & 1, bh = xcd * 2 + ((sl >> 2) & 1), b = bh >> 3, h = bh & 7;
        const bf16* base = QKV + (size_t)b * SEQ * NQKV;
        r.Q = base + (size_t)r.P0 * NQKV + h * 256 + c * 128; r.K = base + 2048 + h * 256 + c * 128; r.V = base + 4096 + h * 256 + vh * 128;
        r.O = Obuf + (size_t)c * TOK * DM + ((size_t)b * SEQ + r.P0) * DM + h * 256 + vh * 128; r.CB = nullptr; r.h = h; }
    else { const int b = s >> 4, h = s & 15; const bf16* base = QKV + (size_t)b * SEQ * NQKV;
        r.Q = base + (size_t)r.P0 * NQKV + h * 128; r.K = base + 2048 + h * 128; r.V = base + 4096 + h * 128;
        r.O = Obuf + ((size_t)b * SEQ + r.P0) * DM + h * 128; r.CB = CB + (size_t)s * SEQ; r.h = 0; }
    return r;
}
template <int MODE> __device__ __forceinline__ void attn_phase(char* lds, const bf16* QKV, bf16* Obuf, const float* CB, const unsigned* NRM, int G, int bx) {
    int* jt = (int*)(lds + att::OFF_TB);
    if (MODE == 1) {
        int tid = threadIdx.x; asm volatile("" : "+v"(tid)); const int w = __builtin_amdgcn_readfirstlane(tid >> 6), lane = tid & 63;
        if (tid < 64) jt[tid] = 0;
        __syncthreads();
        for (int e = w; e < 64; e += 8) { int s, x; if (!attn_item<MODE>(e >> 1, G, bx, s, x)) break;
            const int qb = (e & 1) ? 63 - x : x, jmax = qb * 4; const float* cb = CB + (size_t)s * SEQ;
            const float qn = sqrtf(__uint_as_float(NRM[s * 2])) * 1.01f, kn = sqrtf(__uint_as_float(NRM[s * 2 + 1])) * 1.01f;
            const float thr = cb[qb * 256] - 110.f * 11.313708498984761f - 2.f * qn * kn;
            int need = 0;
            for (int j0 = jmax - 1; j0 >= 0; j0 -= 64) { const int j = j0 - lane; const bool c = (j >= 0) && (cb[(j >= 0 ? j : 0) * 64 + 63] >= thr);
                const unsigned long long m = __ballot(c); const int n = __builtin_popcountll(m); need += n; if (n < 64) break; }
            if (lane == 0) jt[e] = jmax - need; }
        __syncthreads();
    }
    int i = 0, pass = 0, s = 0, x = 0;
    if (!attn_item<MODE>(0, G, bx, s, x)) return;
    att::BlockRef cur = attn_ref<MODE>(s, x, (MODE == 1) ? jt[0] : 0, QKV, Obuf, CB);
    att::Seam S;
    att::attn_prime<MODE>(cur, lds, S);
    for (;;) {
        int sn = s, xn = x, in = i, passn = pass + 1; bool last = false;
        if (pass == 1) { passn = 0; in = i + 1; if (!attn_item<MODE>(in, G, bx, sn, xn)) last = true; }
        const int jl = (MODE == 1 && in < 32) ? jt[in * 2 + passn] : 0;
        const att::BlockRef nxt = last ? cur : attn_ref<MODE>(sn, passn ? 63 - xn : xn, jl, QKV, Obuf, CB);
        att::attn_block<MODE>(cur, nxt, lds, S);
        if (last) break;
        cur = nxt; s = sn; x = xn; i = in; pass = passn;
    }
}

__global__ void __launch_bounds__(NWAVES * 64, 2) yoco_fwd(Args args) {
    extern __shared__ __attribute__((aligned(16))) unsigned char lds[];
    cg::grid_group grid = cg::this_grid();
    LAS unsigned char* ldsl = (LAS unsigned char*)lds;
    const int G = gridDim.x, bx = blockIdx.x, NGW = G * NWAVES;
    int tid, lane, wave, gw;
#define FRESH() do { tid = threadIdx.x; asm volatile("" : "+v"(tid)); lane = tid & 63; wave = __builtin_amdgcn_readfirstlane(tid >> 6); gw = bx * NWAVES + wave; } while (0)
    FRESH();
    unsigned char* ws = args.ws;
    const float* x = args.in[0]; float* out = args.out;
    bf16* Wqkv0 = (bf16*)(ws + WS_WQKV0); bf16* Woa = (bf16*)(ws + WS_WOA); bf16* Wmi0 = (bf16*)(ws + WS_WMI0); bf16* Wmo0 = (bf16*)(ws + WS_WMO0);
    bf16* Wqkv1 = (bf16*)(ws + WS_WQKV1); bf16* Wob = (bf16*)(ws + WS_WOB); bf16* Wmi1 = (bf16*)(ws + WS_WMI1); bf16* Wmo1 = (bf16*)(ws + WS_WMO1);
    bf16* QKV = (bf16*)(ws + WS_QKV); bf16* OC = (bf16*)(ws + WS_OC); bf16* HID = (bf16*)(ws + WS_HID); bf16* XN = (bf16*)(ws + WS_XN);
    float* Fb = (float*)(ws + WS_F); float* CB = (float*)(ws + WS_CB); unsigned* NRM = (unsigned*)(ws + WS_NRM);

    {
        LAS float* scr = (LAS float*)(ldsl + wave * 16384);
        const float* ag = args.in[2]; const float* mg = args.in[3]; const float* kg = args.in[11];
        constexpr int I_QKV = (DM / 64) * (NQKV / 32), I_DD = (DM / 64) * (DM / 32), I_MI = (DM / 64) * (FF / 32), I_MO = (FF / 64) * (DM / 32);
        constexpr int NITEMS = I_QKV + 5 * I_DD + 2 * I_MI + 2 * I_MO;
        for (int it = gw; it < NITEMS; it += NGW) {
            int r = it;
            if (r < I_QKV) { transpose_item(args.in[4], DM, NQKV, Wqkv0, 0, ag, scr, r, lane); continue; } r -= I_QKV;
            if (r < I_DD) { transpose_item(args.in[10], DM, DM, Woa, 0, nullptr, scr, r, lane); continue; } r -= I_DD;
            if (r < I_DD) { transpose_item(args.in[16], DM, DM, Wqkv1, 0, ag + DM, scr, r, lane); continue; } r -= I_DD;
            if (r < I_DD) { transpose_item(args.in[12], DM, DM, Wqkv1, DM, kg, scr, r, lane); continue; } r -= I_DD;
            if (r < I_DD) { transpose_item(args.in[13], DM, DM, Wqkv1, 2 * DM, kg, scr, r, lane); continue; } r -= I_DD;
            if (r < I_DD) { transpose_item(args.in[17], DM, DM, Wob, 0, nullptr, scr, r, lane); continue; } r -= I_DD;
            if (r < I_MI) { transpose_item(args.in[18], DM, FF, Wmi0, 0, mg, scr, r, lane); continue; } r -= I_MI;
            if (r < I_MI) { transpose_item(args.in[18] + (size_t)DM * FF, DM, FF, Wmi1, 0, mg + DM, scr, r, lane); continue; } r -= I_MI;
            if (r < I_MO) { transpose_item(args.in[19], FF, DM, Wmo0, 0, nullptr, scr, r, lane); continue; } r -= I_MO;
            transpose_item(args.in[19] + (size_t)FF * DM, FF, DM, Wmo1, 0, nullptr, scr, r, lane);
        }
        { const float* wf = args.in[14]; const int gt = bx * 512 + tid, NT_ = G * 512;
          for (int e = gt; e < (NQKV1 - NQKV) * DM; e += NT_) { const int n = e / DM, k = e % DM; Wqkv1[(size_t)(NQKV + n) * DM + k] = (n < FH) ? (bf16)f2bf(wf[(size_t)k * FH + n] * kg[k]) : (bf16)0; } }
        if (bx == 0 && tid < 64) NRM[tid] = 0u;
        norm_phase(x, XN, gw, NGW, lane);
    }
    grid.sync();
    { pg8::Gemm g{XN, Wqkv0, TOK, NQKV, DM}; pg8::StaticOrder S; S.init(TOK, NQKV, G, bx);
      pg8::EpiX<0> E{QKV, NQKV, nullptr, nullptr, nullptr};
      pg8::gemm_phase<pg8::EpiX<0>, pg8::StaticOrder, PG8_ALIGN, PG8_SP2>(ldsl, g, S, E); }
    grid.sync();
    {
      FRESH(); const float* tab = args.in[1]; float* tb = (float*)(lds + att::OFF_TB);
      for (int idx = tid; idx < 2048; idx += 512) { const int h = idx >> 8, rel = (idx & 255) - 192; const int n = rel < 0 ? -rel : rel;
          int bk = n < 8 ? n : 8 + (n >= 12) + (n >= 16) + (n >= 23) + (n >= 32) + (n >= 46) + (n >= 64) + (n >= 91); if (rel > 0) bk += 16;
          tb[idx] = (tab[bk * 8 + h] - tab[15 * 8 + h]) * 11.313708498984761f; }
      __syncthreads();
#ifndef NO_ATT0
      attn_phase<0>((char*)lds, QKV, OC, nullptr, nullptr, G, bx);
#endif
    }
    grid.sync();
    FRESH(); combine_phase(OC, XN, args.in[5], args.in[6], args.in[7], args.in[8], args.in[9], gw, NGW, lane);
    grid.sync();
    { pg8::Gemm g{XN, Woa, TOK, DM, DM}; pg8::StaticOrder S; S.init(TOK, DM, G, bx);
      pg8::EpiX<2> E{nullptr, DM, x, out, nullptr};
      pg8::gemm_phase<pg8::EpiX<2>, pg8::StaticOrder, PG8_ALIGN, PG8_SP2>(ldsl, g, S, E); }
    grid.sync();
    FRESH(); norm_phase(out, XN, gw, NGW, lane);
    grid.sync();
    { pg8::Gemm g{XN, Wmi0, TOK, FF, DM}; pg8::StaticOrder S; S.init(TOK, FF, G, bx);
      pg8::EpiX<1> E{HID, FF, nullptr, nullptr, nullptr};
      pg8::gemm_phase<pg8::EpiX<1>, pg8::StaticOrder, PG8_ALIGN, PG8_SP2>(ldsl, g, S, E); }
    grid.sync();
    { pg8::Gemm g{HID, Wmo0, TOK, DM, FF}; pg8::StaticOrder S; S.init(TOK, DM, G, bx);
      pg8::EpiX<2> E{nullptr, DM, out, out, nullptr};
      pg8::gemm_phase<pg8::EpiX<2>, pg8::StaticOrder, PG8_ALIGN, PG8_SP2>(ldsl, g, S, E); }
    grid.sync();
    FRESH(); norm_phase(out, XN, gw, NGW, lane);
    grid.sync();
    { pg8::Gemm g{XN, Wqkv1, TOK, NQKV1, DM}; pg8::StaticOrder S; S.init(TOK, NQKV1, G, bx);
      pg8::EpiX<3> E{QKV, NQKV, nullptr, nullptr, Fb};
      pg8::gemm_phase<pg8::EpiX<3>, pg8::StaticOrder, PG8_ALIGN, PG8_SP2>(ldsl, g, S, E); }
    grid.sync();
#ifndef NO_CUM
    FRESH(); cumsum_phase(Fb, args.in[15], CB, ldsl, bx, G, tid);
    rownorm_phase(QKV, NRM, bx, G, tid);
#endif
    grid.sync();
#ifndef NO_ATT1
    attn_phase<1>((char*)lds, QKV, XN, CB, NRM, G, bx);
#endif
    grid.sync();
    { pg8::Gemm g{XN, Wob, TOK, DM, DM}; pg8::StaticOrder S; S.init(TOK, DM, G, bx);
      pg8::EpiX<2> E{nullptr, DM, out, out, nullptr};
      pg8::gemm_phase<pg8::EpiX<2>, pg8::StaticOrder, PG8_ALIGN, PG8_SP2>(ldsl, g, S, E); }
    grid.sync();
    FRESH(); norm_phase(out, XN, gw, NGW, lane);
    grid.sync();
    { pg8::Gemm g{XN, Wmi1, TOK, FF, DM}; pg8::StaticOrder S; S.init(TOK, FF, G, bx);
      pg8::EpiX<1> E{HID, FF, nullptr, nullptr, nullptr};
      pg8::gemm_phase<pg8::EpiX<1>, pg8::StaticOrder, PG8_ALIGN, PG8_SP2>(ldsl, g, S, E); }
    grid.sync();
    { pg8::Gemm g{HID, Wmo1, TOK, DM, FF}; pg8::StaticOrder S; S.init(TOK, DM, G, bx);
      pg8::EpiX<2> E{nullptr, DM, out, out, nullptr};
      pg8::gemm_phase<pg8::EpiX<2>, pg8::StaticOrder, PG8_ALIGN, PG8_SP2>(ldsl, g, S, E); }
    grid.sync();
    FRESH(); final_norm_phase(out, args.in[20], gw, NGW, lane);
}

extern "C" void kernel_launch(void* const* d_in, const int* in_sizes, int n_in, void* d_out, int out_size, void* d_ws, size_t ws_size, hipStream_t stream) {
    static int grid = 0;
    if (grid == 0) {
        if (n_in != 21 || in_sizes[0] != TOK * DM || out_size != TOK * DM || ws_size < WS_END) { fprintf(stderr, "kernel_launch: unexpected shapes (n_in %d, in0 %d, out %d, ws %zu)\n", n_in, n_in > 0 ? in_sizes[0] : -1, out_size, ws_size); grid = -1; return; }
        int dev = 0, cus = 0, per_cu = 0;
        (void)hipGetDevice(&dev); (void)hipDeviceGetAttribute(&cus, hipDeviceAttributeMultiprocessorCount, dev);
        if (hipFuncSetAttribute((const void*)yoco_fwd, hipFuncAttributeMaxDynamicSharedMemorySize, LDS_BYTES) != hipSuccess) { fprintf(stderr, "kernel_launch: hipFuncSetAttribute failed\n"); grid = -1; return; }
        if (hipOccupancyMaxActiveBlocksPerMultiprocessor(&per_cu, (const void*)yoco_fwd, NWAVES * 64, LDS_BYTES) != hipSuccess || per_cu < 1) { fprintf(stderr, "kernel_launch: occupancy query gives %d\n", per_cu); per_cu = 1; }
        (void)hipGetLastError();
        grid = cus > 0 ? cus : 256;
    }
    if (grid < 0) return;
    Args a{};
    for (int i = 0; i < 21; ++i) a.in[i] = (const float*)d_in[i];
    a.out = (float*)d_out; a.ws = (unsigned char*)d_ws;
    void* kargs[] = {&a};
    hipError_t e = hipLaunchCooperativeKernel((const void*)yoco_fwd, dim3(grid), dim3(NWAVES * 64), kargs, LDS_BYTES, stream);
    if (e != hipSuccess) fprintf(stderr, "kernel_launch: cooperative launch failed: %s (grid %d)\n", hipGetErrorString(e), grid);
}
```

```cpp
#include <hip/hip_runtime.h>
#include <hip/hip_cooperative_groups.h>
#include <cstdio>
#include <cstdint>
namespace cg = cooperative_groups;
namespace pg8 {
#define PG8_LAS __attribute__((address_space(3)))
typedef unsigned short bf16_t;
typedef short bf16x8 __attribute__((ext_vector_type(8)));
typedef float f32x4 __attribute__((ext_vector_type(4)));
typedef unsigned u32x4 __attribute__((ext_vector_type(4)));
constexpr int BM = 256, BK = 64, HALF = 128, HTB = HALF * BK * 2  , STAGE_BYTES = 8 * HTB, NXCD = 8, WGM = 8;

__host__ __device__ __forceinline__ int lds_byte(int r, int c) { const int st = (r >> 4) * 2 + (c >> 5), rr = r & 15, cc = c & 31, ob = rr * 64 + cc * 2; return st * 1024 + (ob ^ (((ob >> 9) & 1) << 5)); }
__host__ __device__ __forceinline__ void stage_rc(int b, int& R, int& C) { const int st = b / 1024, sb = b % 1024, swz = sb ^ (((sb >> 9) & 1) << 5); R = (st >> 1) * 16 + swz / 64; C = (st & 1) * 32 + (swz % 64) / 2; }
__host__ __device__ __forceinline__ int perm32(int rho) { const int n = rho >> 4, i = rho & 15; return 8 * (i >> 2) + 4 * n + (i & 3); }

struct Unit { int pm, pn; };
struct Gemm { const bf16_t* A; const bf16_t* Bt; int M, N, K; };

struct StaticOrder {
    int nM, nN, nwg, G, c;
    __host__ __device__ void init(int M, int N, int G_, int c_) { nM = M / BM; nN = N / BM; nwg = nM * nN; G = G_; c = c_; }
    __host__ __device__ bool next(int i, Unit& u) const {
        const long L = (long)i * G + c; if (L >= nwg) return false;
        int wgid = (int)L; { const int q = nwg / NXCD, r = nwg % NXCD, xcd = wgid % NXCD, off = wgid / NXCD; wgid = (xcd < r ? xcd * (q + 1) : r * (q + 1) + (xcd - r) * q) + off; }
        const int nig = WGM * nN, gid = wgid / nig, fm = gid * WGM, gsz = (nM - fm) < WGM ? (nM - fm) : WGM;
        u.pm = fm + ((wgid % nig) % gsz); u.pn = (wgid % nig) / gsz; return true;
    }
    __device__ __forceinline__ void a_ready(const Unit&) const {}
    __device__ __forceinline__ void done(const Unit&) const {}
};

__device__ __forceinline__ unsigned cvt_pk_bf16(float lo, float hi) { unsigned r; asm volatile("v_cvt_pk_bf16_f32 %0, %1, %2" : "=v"(r) : "v"(lo), "v"(hi)); return r; }
typedef float f32x2 __attribute__((ext_vector_type(2)));
template <int MODE> struct EpiX {
    static constexpr bool PERM = true, AFTER_DRAIN = false;
    bf16_t* O; int ldc; const float* base; float* out; float* F;
    __device__ __forceinline__ void operator()(const f32x4 (&acc)[2][2][4][2], const Unit& u, int wr, int wc, int fr, int fq) const {
        const int row0 = u.pm * BM + wr * 64 + fr, col0 = u.pn * BM + wc * 32 + 8 * fq;
        const bool ftile = (MODE == 3) && (u.pn * BM >= 6144);
#pragma unroll
        for (int ai = 0; ai < 2; ++ai)
#pragma unroll
            for (int m = 0; m < 4; ++m) { const size_t row = (size_t)(row0 + ai * HALF + m * 16);
#pragma unroll
                for (int bj = 0; bj < 2; ++bj) { f32x4 v0 = acc[ai][bj][m][0], v1 = acc[ai][bj][m][1]; const int col = col0 + bj * HALF;
                    if (MODE == 2) { const float* bp = base + row * ldc + col; float* op = out + row * ldc + col;
                        const f32x4 b0 = *(const f32x4*)bp, b1 = *(const f32x4*)(bp + 4); *(f32x4*)op = b0 + v0; *(f32x4*)(op + 4) = b1 + v1; }
                    else if (ftile) { if (bj == 0 && wc == 0 && fq < 2) { float* fp = F + row * 16 + 8 * fq; *(f32x4*)fp = v0; *(f32x4*)(fp + 4) = v1; } }
                    else { if (MODE == 1) {
#pragma unroll
                            for (int e = 0; e < 4; ++e) { const float a = fmaxf(v0[e], 0.f), b = fmaxf(v1[e], 0.f); v0[e] = a * a; v1[e] = b * b; } }
                        u32x4 w; w.x = cvt_pk_bf16(v0[0], v0[1]); w.y = cvt_pk_bf16(v0[2], v0[3]); w.z = cvt_pk_bf16(v1[0], v1[1]); w.w = cvt_pk_bf16(v1[2], v1[3]);
                        *(u32x4*)(O + row * ldc + col) = w; } }
                if (MODE == 2) asm volatile("" ::: "memory"); }
    }
};
template <class Epi, class Sched, bool ALIGN_EPI = false, bool SP2 = false>
__device__ __forceinline__ void gemm_phase(PG8_LAS unsigned char* lds, const Gemm g, const Sched& S, const Epi& E) {
    int tid = threadIdx.x; asm volatile("" : "+v"(tid));
    const int wid = __builtin_amdgcn_readfirstlane(tid >> 6), lane = tid & 63, wr = wid >> 2, wc = wid & 3, fr = lane & 15, fq = lane >> 4;
    const int K = g.K, nt = K / BK;
    unsigned voffA[2], voffB[2];
#pragma unroll
    for (int i = 0; i < 2; ++i) { int R, C; stage_rc(tid * 16 + i * 8192, R, C); const int Rb = Epi::PERM ? ((R & ~31) + perm32(R & 31)) : R;
        voffA[i] = (unsigned)(R * K + C) * 2u; voffB[i] = (unsigned)(Rb * K + C) * 2u; }
    const size_t kstep = (size_t)(BK * 2);
    const size_t hstep = (size_t)HALF * K * 2;
    const size_t tstep = 2 * hstep;
    const unsigned ldsw = (unsigned)wid * 1024u;
    const int aoff = lds_byte(wr * 64 + fr, fq * 8), boff = lds_byte(wc * 32 + fr, fq * 8);
#define PG8_SA(b, h) (((b) * 2 + (h)) * HTB)
#define PG8_SB(b, h) ((4 + (b) * 2 + (h)) * HTB)
#define PG8_STAGE(bufoff, gbase, voff) do { _Pragma("unroll") for (int _i = 0; _i < 2; ++_i) \
        __builtin_amdgcn_global_load_lds((const unsigned*)((const char*)(gbase) + (voff)[_i]), (PG8_LAS unsigned*)(lds + (bufoff) + ldsw + _i * 8192), 16, 0, 0); } while (0)
#define PG8_LDA(dst, b, h) do { _Pragma("unroll") for (int m = 0; m < 4; ++m) _Pragma("unroll") for (int k = 0; k < 2; ++k) dst[m][k] = *(const PG8_LAS bf16x8*)(lds + PG8_SA(b, h) + aoff + m * 2048 + k * 1024); } while (0)
#define PG8_LDB(dst, b, h) do { _Pragma("unroll") for (int n = 0; n < 2; ++n) _Pragma("unroll") for (int k = 0; k < 2; ++k) dst[n][k] = *(const PG8_LAS bf16x8*)(lds + PG8_SB(b, h) + boff + n * 2048 + k * 1024); } while (0)
#define PG8_MMA(ai, bj, At, Bt) do { __builtin_amdgcn_s_setprio(1); _Pragma("unroll") for (int m = 0; m < 4; ++m) _Pragma("unroll") for (int n = 0; n < 2; ++n) _Pragma("unroll") for (int k = 0; k < 2; ++k) \
        acc[ai][bj][m][n] = __builtin_amdgcn_mfma_f32_16x16x32_bf16(Bt[n][k], At[m][k], acc[ai][bj][m][n], 0, 0, 0); __builtin_amdgcn_s_setprio(0); } while (0)
#define PG8_WAIT_V(n) asm volatile("s_waitcnt vmcnt(" #n ")" ::: "memory")
#define PG8_WAIT_L(n) asm volatile("s_waitcnt lgkmcnt(" #n ")" ::: "memory")
#define PG8_BAR __builtin_amdgcn_s_barrier()
#define PG8_SCHED __builtin_amdgcn_sched_barrier(0)
    Unit cur, nxt; int ui = 0;
    if (!S.next(0, cur)) return;
    f32x4 acc[2][2][4][2];
#pragma unroll
    for (int a = 0; a < 2; ++a)
#pragma unroll
        for (int b = 0; b < 2; ++b)
#pragma unroll
            for (int m = 0; m < 4; ++m)
#pragma unroll
                for (int n = 0; n < 2; ++n) acc[a][b][m][n] = (f32x4){0.f, 0.f, 0.f, 0.f};
    bf16x8 At[4][2], B0[2][2], B1[2][2];
    const char* cA = (const char*)g.A + (size_t)cur.pm * tstep; const char* cB = (const char*)g.Bt + (size_t)cur.pn * tstep;
    S.a_ready(cur);
    if constexpr (SP2) {
        PG8_STAGE(PG8_SB(0, 0), cB, voffB); PG8_STAGE(PG8_SB(0, 1), cB + hstep, voffB); PG8_STAGE(PG8_SA(0, 0), cA, voffA); PG8_STAGE(PG8_SA(0, 1), cA + hstep, voffA);
        if (wr == 1) PG8_BAR;
        PG8_WAIT_V(2); PG8_BAR;
        PG8_STAGE(PG8_SB(1, 0), cB + kstep, voffB); PG8_STAGE(PG8_SA(1, 0), cA + kstep, voffA); PG8_STAGE(PG8_SB(1, 1), cB + hstep + kstep, voffB);
        PG8_WAIT_V(6); PG8_BAR;
    } else {
        PG8_STAGE(PG8_SB(0, 0), cB, voffB); PG8_STAGE(PG8_SA(0, 0), cA, voffA); PG8_STAGE(PG8_SB(0, 1), cB + hstep, voffB); PG8_STAGE(PG8_SA(0, 1), cA + hstep, voffA);
        if (wr == 1) PG8_BAR;
        PG8_WAIT_V(4); PG8_BAR;
        PG8_STAGE(PG8_SB(1, 0), cB + kstep, voffB); PG8_STAGE(PG8_SA(1, 0), cA + kstep, voffA); PG8_STAGE(PG8_SB(1, 1), cB + hstep + kstep, voffB);
        PG8_WAIT_V(6); PG8_BAR;
    }
    for (;;) {
        const bool has_next = S.next(ui + 1, nxt);
        const char* nA = has_next ? (const char*)g.A + (size_t)nxt.pm * tstep : cA; const char* nB = has_next ? (const char*)g.Bt + (size_t)nxt.pn * tstep : cB;
        for (int t = 0; t < nt; t += 2) {
            const bool last = (t == nt - 2);
            const char* a1 = cA + (size_t)(t + 1) * kstep;
            const char* a2 = last ? nA : cA + (size_t)(t + 2) * kstep; const char* b2 = last ? nB : cB + (size_t)(t + 2) * kstep;
            const char* a3 = a2 + kstep; const char* b3 = b2 + kstep;
            if (last && has_next) S.a_ready(nxt);
            if constexpr (SP2) {
            PG8_LDB(B0, 0, 0); PG8_LDB(B1, 0, 1); PG8_SCHED; PG8_LDA(At, 0, 0); PG8_STAGE(PG8_SA(1, 1), a1 + hstep, voffA);
            PG8_WAIT_V(8); PG8_WAIT_L(0); PG8_BAR; PG8_MMA(0, 0, At, B0); PG8_MMA(0, 1, At, B1); PG8_BAR; PG8_SCHED;
            PG8_LDA(At, 0, 1); PG8_STAGE(PG8_SB(0, 0), b2, voffB); PG8_STAGE(PG8_SB(0, 1), b2 + hstep, voffB); PG8_STAGE(PG8_SA(0, 0), a2, voffA);
            PG8_WAIT_V(8); PG8_WAIT_L(0); PG8_BAR; PG8_MMA(1, 0, At, B0); PG8_MMA(1, 1, At, B1); PG8_BAR; PG8_SCHED;
            PG8_LDB(B0, 1, 0); PG8_LDB(B1, 1, 1); PG8_SCHED; PG8_LDA(At, 1, 0); PG8_STAGE(PG8_SA(0, 1), a2 + hstep, voffA);
            PG8_WAIT_V(8); PG8_WAIT_L(0); PG8_BAR; PG8_MMA(0, 0, At, B0); PG8_MMA(0, 1, At, B1); PG8_BAR; PG8_SCHED;
            PG8_LDA(At, 1, 1); PG8_STAGE(PG8_SB(1, 0), b3, voffB); PG8_STAGE(PG8_SB(1, 1), b3 + hstep, voffB); PG8_STAGE(PG8_SA(1, 0), a3, voffA);
            PG8_WAIT_V(8); PG8_WAIT_L(0); PG8_BAR; PG8_MMA(1, 0, At, B0); PG8_MMA(1, 1, At, B1); PG8_BAR; PG8_SCHED;
            } else {
            PG8_LDB(B0, 0, 0); PG8_SCHED; PG8_LDA(At, 0, 0); PG8_STAGE(PG8_SA(1, 1), a1 + hstep, voffA);
            PG8_WAIT_L(8); PG8_BAR; PG8_WAIT_L(0); PG8_MMA(0, 0, At, B0); PG8_BAR; PG8_SCHED;
            PG8_LDB(B1, 0, 1); PG8_STAGE(PG8_SB(0, 0), b2, voffB);
            PG8_BAR; PG8_WAIT_L(0); PG8_MMA(0, 1, At, B1); PG8_BAR;
            PG8_LDA(At, 0, 1); PG8_STAGE(PG8_SA(0, 0), a2, voffA);
            PG8_BAR; PG8_WAIT_L(0); PG8_MMA(1, 0, At, B0); PG8_BAR; PG8_SCHED;
            PG8_STAGE(PG8_SB(0, 1), b2 + hstep, voffB);
            PG8_WAIT_V(6); PG8_BAR; PG8_MMA(1, 1, At, B1); PG8_BAR;
            PG8_LDB(B0, 1, 0); PG8_SCHED; PG8_LDA(At, 1, 0); PG8_STAGE(PG8_SA(0, 1), a2 + hstep, voffA);
            PG8_WAIT_L(8); PG8_BAR; PG8_WAIT_L(0); PG8_MMA(0, 0, At, B0); PG8_BAR; PG8_SCHED;
            PG8_LDB(B1, 1, 1); PG8_STAGE(PG8_SB(1, 0), b3, voffB);
            PG8_BAR; PG8_WAIT_L(0); PG8_MMA(0, 1, At, B1); PG8_BAR;
            PG8_LDA(At, 1, 1); PG8_STAGE(PG8_SA(1, 0), a3, voffA);
            PG8_BAR; PG8_WAIT_L(0); PG8_MMA(1, 0, At, B0); PG8_BAR; PG8_SCHED;
            PG8_STAGE(PG8_SB(1, 1), b3 + hstep, voffB);
            PG8_WAIT_V(6); PG8_BAR; PG8_MMA(1, 1, At, B1); PG8_BAR;
            }
        }
        if constexpr (ALIGN_EPI) { if (wr == 0) PG8_BAR; }
        if constexpr (!Epi::AFTER_DRAIN) { E(acc, cur, wr, wc, fr, fq); S.done(cur); }
        if (!has_next) break;
#pragma unroll
        for (int a = 0; a < 2; ++a)
#pragma unroll
            for (int b = 0; b < 2; ++b)
#pragma unroll
                for (int m = 0; m < 4; ++m)
#pragma unroll
                    for (int n = 0; n < 2; ++n) acc[a][b][m][n] = (f32x4){0.f, 0.f, 0.f, 0.f};
        cur = nxt; cA = nA; cB = nB; ++ui;
        if constexpr (ALIGN_EPI) { if (wr == 1) PG8_BAR; }
    }
    PG8_WAIT_V(0);
    if constexpr (!ALIGN_EPI) { if (wr == 0) PG8_BAR; }
    PG8_BAR;
    if constexpr (Epi::AFTER_DRAIN) { E.fused(acc, cur, wr, wc, fr, fq, lds, wid, lane); S.done(cur); }
#undef PG8_SA
#undef PG8_SB
#undef PG8_STAGE
#undef PG8_LDA
#undef PG8_LDB
#undef PG8_MMA
#undef PG8_WAIT_V
#undef PG8_WAIT_L
#undef PG8_BAR
#undef PG8_SCHED
}
}
#ifndef PG8_SP2
#define PG8_SP2 true
#endif
#ifndef PG8_ALIGN
#define PG8_ALIGN true
#endif
namespace att {
typedef unsigned short bf16;
typedef short bf16x8 __attribute__((ext_vector_type(8)));
typedef short s16x4 __attribute__((ext_vector_type(4)));
typedef float f32x16 __attribute__((ext_vector_type(16)));
typedef float f32x4 __attribute__((ext_vector_type(4)));
typedef unsigned u32x4 __attribute__((ext_vector_type(4)));
constexpr int D = 128, NW = 8, QBLK = 32, KVBLK = 64, QB = NW * QBLK, LDQ = 6144, LDO = 2048;
constexpr float SCALE = 0.08838834764831845f, THR = 8.f;
constexpr int SHM_V = KVBLK * D * 2, SHM_K = KVBLK * 272;
constexpr int OFF_WS = 2 * SHM_V + 2 * SHM_K, OFF_CL = OFF_WS + NW * 64 * 4, OFF_TB = OFF_CL + 512, LDS_BYTES = OFF_TB + 8192;
#define KROW 272
#define KSWZ(row, colB) ((row) * KROW + (colB))
#define SBAR() __builtin_amdgcn_sched_barrier(0)
__device__ __forceinline__ int v_st(int k, int c) { const int kk = (k & ~0xC) | ((k & 4) << 1) | ((k & 8) >> 1); return ((kk >> 3) * 4 + (c >> 5)) * 512 + ((kk & 7) * 32 + (c & 31)) * 2; }
__device__ __forceinline__ int v_rd_base(int lane) { return ((lane & 3) << 3) | (((lane >> 2) & 3) << 6) | (((lane >> 4) & 1) << 5) | (((lane >> 5) & 1) << 8); }
constexpr int v_rd_off(int d0, int ks, int half) { return d0 * 512 + ks * 4096 + half * 2048; }
__device__ __forceinline__ int crow(int r, int hi) { return (r & 3) + 8 * (r >> 2) + 4 * hi; }
__device__ __forceinline__ unsigned cvtpk(float lo, float hi) { unsigned r; asm volatile("v_cvt_pk_bf16_f32 %0, %1, %2" : "=v"(r) : "v"(lo), "v"(hi)); return r; }
__device__ __forceinline__ void mask_tile(f32x16& p0, f32x16& p1, int dq, unsigned W) {
    const float NEG = -__builtin_inff();
#pragma unroll
    for (int r = 0; r < 16; ++r) { const int c = (r & 3) + 8 * (r >> 2);
        if ((unsigned)(dq - c) >= W) p0[r] = NEG;
        if ((unsigned)(dq - c - 32) >= W) p1[r] = NEG; }
}
__device__ __forceinline__ void add_bias(f32x16& p0, f32x16& p1, const float* tb, int relbase) {
    const float* t = tb + relbase;
#pragma unroll
    for (int r = 0; r < 16; ++r) { const int c = (r & 3) + 8 * (r >> 2); p0[r] += t[c]; p1[r] += t[c + 32]; }
}
__device__ __forceinline__ void partialSM(f32x16& p0, f32x16& p1, float& m_reg, float& mn, float& alpha) {
    float pmax = p0[0]; for (int r = 1; r < 16; ++r) pmax = fmaxf(pmax, p0[r]); for (int r = 0; r < 16; ++r) pmax = fmaxf(pmax, p1[r]);
    { auto rr = __builtin_amdgcn_permlane32_swap(__float_as_uint(pmax), __float_as_uint(pmax), false, false);
      pmax = fmaxf(__uint_as_float(rr[0]), __uint_as_float(rr[1])); }
    constexpr float C2 = 1.4426950408889634f * SCALE;
    if (__builtin_expect(__all((pmax - m_reg) * SCALE <= THR), 1)) { mn = m_reg; alpha = 1.f; }
    else { mn = fmaxf(m_reg, pmax); alpha = __builtin_amdgcn_exp2f((m_reg - mn) * C2); m_reg = mn; }
    const float mnL = -mn * C2;
    for (int r = 0; r < 16; ++r) p0[r] = fmaf(p0[r], C2, mnL); for (int r = 0; r < 16; ++r) p1[r] = fmaf(p1[r], C2, mnL);
    for (int r = 0; r < 16; ++r) p0[r] = __builtin_amdgcn_exp2f(p0[r]);
}
__device__ __forceinline__ void finishSM(f32x16& p0, f32x16& p1, float alpha, float& l_reg, bf16x8& pa0, bf16x8& pa1, bf16x8& pa2, bf16x8& pa3) {
    for (int r = 0; r < 16; ++r) p1[r] = __builtin_amdgcn_exp2f(p1[r]);
    float ps = 0; for (int r = 0; r < 16; ++r) ps += p0[r]; for (int r = 0; r < 16; ++r) ps += p1[r];
    { auto rr = __builtin_amdgcn_permlane32_swap(__float_as_uint(ps), __float_as_uint(ps), false, false);
      ps = __uint_as_float(rr[0]) + __uint_as_float(rr[1]); }
    l_reg = l_reg * alpha + ps;
#define PK4(P, B_, OUT) do { unsigned a0 = cvtpk(P[B_+0], P[B_+1]), a1 = cvtpk(P[B_+2], P[B_+3]);                          \
        unsigned b0 = cvtpk(P[B_+4], P[B_+5]), b1 = cvtpk(P[B_+6], P[B_+7]);                                             \
        auto r0 = __builtin_amdgcn_permlane32_swap(a0, b0, false, false); auto r1 = __builtin_amdgcn_permlane32_swap(a1, b1, false, false); \
        u32x4 w = {r0[0], r1[0], r0[1], r1[1]}; OUT = *reinterpret_cast<bf16x8*>(&w); } while (0)
    PK4(p0, 0, pa0); PK4(p0, 8, pa1); PK4(p1, 0, pa2); PK4(p1, 8, pa3);
#undef PK4
}
template <int KB, bool SK, int MODE>
__device__ __forceinline__ void qkt(f32x16& p0, f32x16& p1, const char* lds, int r32, int hi, const bf16x8* qr, bool act) {
    if (SK && !act) { const float NEG = -__builtin_inff();
#pragma unroll
        for (int r = 0; r < 16; ++r) { p0[r] = NEG; p1[r] = NEG; } return; }
    if (MODE == 1) { const float* cl = (const float*)(lds + OFF_CL) + KB * 64 + 4 * hi;
#pragma unroll
        for (int g = 0; g < 4; ++g) { const f32x4 a = *(const f32x4*)(cl + 8 * g), b = *(const f32x4*)(cl + 32 + 8 * g);
            p0[4 * g] = a[0]; p0[4 * g + 1] = a[1]; p0[4 * g + 2] = a[2]; p0[4 * g + 3] = a[3];
            p1[4 * g] = b[0]; p1[4 * g + 1] = b[1]; p1[4 * g + 2] = b[2]; p1[4 * g + 3] = b[3]; } }
    else { p0 = f32x16{}; p1 = f32x16{}; }
    const char* K_lds = lds + 2 * SHM_V;
    const char* kb0 = K_lds + KB * SHM_K + KSWZ(r32, hi * 16);
#pragma unroll
    for (int d0 = 0; d0 < 8; ++d0) { const char* a = kb0 + d0 * 32;
        bf16x8 b0 = *reinterpret_cast<const bf16x8*>(a);
        bf16x8 b1 = *reinterpret_cast<const bf16x8*>(a + 32 * KROW);
        p0 = __builtin_amdgcn_mfma_f32_32x32x16_bf16(b0, qr[d0], p0, 0, 0, 0);
        p1 = __builtin_amdgcn_mfma_f32_32x32x16_bf16(b1, qr[d0], p1, 0, 0, 0); }
}
template <int VB, bool SK>
__device__ __forceinline__ void pv_tile(f32x16* o, int vb0, bf16x8 pa0, bf16x8 pa1, bf16x8 pa2, bf16x8 pa3, bool act) {
    if (SK && !act) return;
#define TRRD(dst, off) asm volatile("ds_read_b64_tr_b16 %0, %1 offset:%2" : "=&v"(dst) : "v"(vb0), "i"(off) : "memory")
#define PV_D0(d0) do { s16x4 l0, l1, l2, l3, h0, h1, h2, h3; constexpr int b_ = VB * SHM_V + v_rd_off(d0, 0, 0); \
        TRRD(l0, b_); TRRD(h0, b_ + 2048); TRRD(l1, b_ + 4096); TRRD(h1, b_ + 6144); TRRD(l2, b_ + 8192); TRRD(h2, b_ + 10240); TRRD(l3, b_ + 12288); TRRD(h3, b_ + 14336); \
        asm volatile("s_waitcnt lgkmcnt(0)" ::: "memory"); SBAR(); \
        o[d0] = __builtin_amdgcn_mfma_f32_32x32x16_bf16(pa0, (bf16x8){l0[0], l0[1], l0[2], l0[3], h0[0], h0[1], h0[2], h0[3]}, o[d0], 0, 0, 0);   \
        o[d0] = __builtin_amdgcn_mfma_f32_32x32x16_bf16(pa1, (bf16x8){l1[0], l1[1], l1[2], l1[3], h1[0], h1[1], h1[2], h1[3]}, o[d0], 0, 0, 0);   \
        o[d0] = __builtin_amdgcn_mfma_f32_32x32x16_bf16(pa2, (bf16x8){l2[0], l2[1], l2[2], l2[3], h2[0], h2[1], h2[2], h2[3]}, o[d0], 0, 0, 0);   \
        o[d0] = __builtin_amdgcn_mfma_f32_32x32x16_bf16(pa3, (bf16x8){l3[0], l3[1], l3[2], l3[3], h3[0], h3[1], h3[2], h3[3]}, o[d0], 0, 0, 0); } while (0)
    PV_D0(0); PV_D0(1); PV_D0(2); PV_D0(3);
#undef PV_D0
#undef TRRD
}
struct BlockRef { const bf16* Q; const bf16* K; const bf16* V; bf16* O; const float* CB; int P0, jlo, h; };
struct Seam { bf16x8 qr[8]; bf16x8 st_v0, st_v1, st_k0, st_k1; };
#define LD8(p) (*reinterpret_cast<const bf16x8*>(p))
#define ROWQ(p, k0, rr) ((p) + (size_t)((k0) + (rr)) * LDQ + sc)
#define VMW() asm volatile("s_waitcnt vmcnt(0)" ::: "memory")
#define VMWN(n) asm volatile("s_waitcnt vmcnt(%0)" :: "i"(n) : "memory")
#define SLOAD_H(R, k0, bf) do { const char* kb__ = (const char*)(R).K + (size_t)(k0) * (LDQ * 2); const char* vb__ = (const char*)(R).V + (size_t)(k0) * (LDQ * 2); \
                         S.st_v0 = LD8(vb__ + vo0); S.st_v1 = LD8(vb__ + vo1); S.st_k0 = LD8(kb__ + vo0); S.st_k1 = LD8(kb__ + vo1);  \
                         if (MODE == 1) { if (wid == 0) __builtin_amdgcn_global_load_lds((const unsigned*)((const char*)((R).CB + (k0)) + lane4), (__attribute__((address_space(3))) unsigned*)(lds + OFF_CL + (bf) * 256), 4, 0, 0); } } while (0)
#define SWRITE_HK(bf) do { *(bf16x8*)(K_lds + (bf) * SHM_K + kws) = S.st_k0; *(bf16x8*)(K_lds + (bf) * SHM_K + kws + 32 * KROW) = S.st_k1; } while (0)
#define SWRITE_HV(bf) do { *(bf16x8*)(V_lds + (bf) * SHM_V + vst0) = S.st_v0; *(bf16x8*)(V_lds + (bf) * SHM_V + vst1) = S.st_v1; } while (0)
#define SWRITE_H(bf) do { SWRITE_HV(bf); SWRITE_HK(bf); } while (0)
template <int MODE>
__device__ __forceinline__ void attn_prime(const BlockRef& cur, char* lds, Seam& S) {
    int tid = threadIdx.x; asm volatile("" : "+v"(tid));
    const int wid = __builtin_amdgcn_readfirstlane(tid >> 6), lane = tid & 63, r32 = lane & 31, hi = lane >> 5;
    const int sr = tid >> 4, sc = (tid & 15) * 8, kws = KSWZ(sr, sc * 2); char* K_lds = lds + 2 * SHM_V;
    const int kb0 = cur.jlo * KVBLK;
    const unsigned vo0 = (unsigned)((sr * LDQ + sc) * 2), vo1 = vo0 + 32u * LDQ * 2u, lane4 = (unsigned)lane * 4u, qo = (unsigned)(((wid * QBLK + r32) * LDQ + hi * 8) * 2);
#pragma unroll
    for (int d0 = 0; d0 < 8; ++d0) S.qr[d0] = LD8((const char*)cur.Q + qo + d0 * 32);
    SLOAD_H(cur, kb0, 0); VMW(); SWRITE_HK(0);
    __syncthreads();
}
template <int MODE>
__device__ __forceinline__ void attn_block(const BlockRef& cur, const BlockRef& nxt, char* lds, Seam& S) {
    constexpr bool SK = (MODE == 0);
    int tid = threadIdx.x; asm volatile("" : "+v"(tid));
    const int wid = __builtin_amdgcn_readfirstlane(tid >> 6), lane = tid & 63, r32 = lane & 31, hi = lane >> 5;
    const int j_lo = cur.jlo, j_hi = cur.P0 / KVBLK + QB / KVBLK;
    const int NT = j_hi - j_lo;
    const int kbn = nxt.jlo * KVBLK;
    const int qlo = cur.P0 + wid * QBLK, qm = qlo + r32 - 4 * hi;
    char* V_lds = lds; char* K_lds = lds + 2 * SHM_V;
    float* ws = (float*)(lds + OFF_WS) + wid * 64; float* li_l = ws, * al_l = ws + 32;
    const float* tbh = (const float*)(lds + OFF_TB) + cur.h * 256;
    float m_reg = -1e30f, l_reg = 0; f32x16 o[4] = {};
    const int sr = tid >> 4, sc = (tid & 15) * 8, vst0 = v_st(sr, sc), vst1 = v_st(32 + sr, sc), kws = KSWZ(sr, sc * 2);
    const int vb0 = (int)(uintptr_t)V_lds + v_rd_base(lane);
    const unsigned vo0 = (unsigned)((sr * LDQ + sc) * 2), vo1 = vo0 + 32u * LDQ * 2u, lane4 = (unsigned)lane * 4u, qo = (unsigned)(((wid * QBLK + r32) * LDQ + hi * 8) * 2);
#define RESC(a) do { if (__any((a) < 1.f)) { if (hi == 0) al_l[r32] = (a); asm volatile("s_waitcnt lgkmcnt(0)" ::: "memory");              \
                     for (int d_ = 0; d_ < 4; ++d_) for (int r = 0; r < 16; ++r) o[d_][r] *= al_l[crow(r, hi)]; } } while (0)
#define KBASE(t) ((j_lo + (t)) * KVBLK)
#define ACT(t) (MODE == 0 ? (KBASE(t) <= qlo) : true)
#define MASKT(P0_, P1_, t) do { const int kb_ = KBASE(t);                                                                              \
        if (MODE == 1) { if (kb_ + KVBLK - 1 > qlo) mask_tile(P0_, P1_, qm - kb_, 0x40000000u); }                                       \
        else { if (kb_ <= qlo && kb_ + KVBLK - 1 - qlo >= -90) add_bias(P0_, P1_, tbh, kb_ - qm + 192); } } while (0)
    constexpr int NQL = 8;
#define SEAM_K0() do { VMWN(NQL); SWRITE_HK(0); SBAR(); } while (0)
    f32x16 pA0, pA1, pB0, pB1; float mnA, mnB, alA, alB; bf16x8 pa0, pa1, pa2, pa3;
    SWRITE_HV(0); SBAR();
    if (NT > 1) { SLOAD_H(cur, KBASE(1), 1); }
    SBAR(); qkt<0, SK, MODE>(pA0, pA1, lds, r32, hi, S.qr, ACT(0));
    MASKT(pA0, pA1, 0); partialSM(pA0, pA1, m_reg, mnA, alA);
    if (NT > 1) { VMW(); SWRITE_H(1); }
    __syncthreads();
#define HALF_STEP(PL, PX0, PX1, mnX, alX, PY0, PY1, alY, t, KB, VB, SB) do {                                                  \
        SBAR(); qkt<KB, (SK && !(PL)), MODE>(PX0, PX1, lds, r32, hi, S.qr, ACT(t));                                           \
        finishSM(PY0, PY1, alY, l_reg, pa0, pa1, pa2, pa3); SBAR();                                                           \
        if ((PL) || (t) + 1 < NT) { SLOAD_H(cur, KBASE((t) + 1), SB); SBAR(); }                                               \
        pv_tile<VB, (SK && !(PL))>(o, vb0, pa0, pa1, pa2, pa3, ACT((t) - 1)); if (!(PL)) MASKT(PX0, PX1, (t)); partialSM(PX0, PX1, m_reg, mnX, alX); \
        __syncthreads();                                                                                                      \
        if ((PL) || (t) + 1 < NT) { VMW(); SWRITE_H(SB); }                                                                    \
        RESC(alX); __syncthreads(); } while (0)
    int t = 1;
    { const int NH = NT - (MODE == 0 ? 6 : 4);
      for (; t + 1 < NH; t += 2) {
        HALF_STEP(true, pB0, pB1, mnB, alB, pA0, pA1, alA, t, 1, 0, 0);
        HALF_STEP(true, pA0, pA1, mnA, alA, pB0, pB1, alB, t + 1, 0, 1, 1);
      } }
    for (; t + 1 < NT; t += 2) {
        HALF_STEP(false, pB0, pB1, mnB, alB, pA0, pA1, alA, t, 1, 0, 0);
        HALF_STEP(false, pA0, pA1, mnA, alA, pB0, pB1, alB, t + 1, 0, 1, 1);
    }
    const bool even = (NT & 1) == 0;
    if (even) { SBAR(); qkt<1, SK, MODE>(pB0, pB1, lds, r32, hi, S.qr, ACT(NT - 1)); SBAR(); }
    SLOAD_H(nxt, kbn, 0); SBAR();
#pragma unroll
    for (int d0 = 0; d0 < 8; ++d0) S.qr[d0] = LD8((const char*)nxt.Q + qo + d0 * 32);
    SBAR();
    finishSM(pA0, pA1, alA, l_reg, pa0, pa1, pa2, pa3); SBAR();
    pv_tile<0, SK>(o, vb0, pa0, pa1, pa2, pa3, ACT(even ? NT - 2 : NT - 1));
    if (even) { MASKT(pB0, pB1, NT - 1); partialSM(pB0, pB1, m_reg, mnB, alB); __syncthreads(); RESC(alB);
        finishSM(pB0, pB1, alB, l_reg, pa0, pa1, pa2, pa3); SBAR(); pv_tile<1, SK>(o, vb0, pa0, pa1, pa2, pa3, ACT(NT - 1)); }
    SBAR(); SEAM_K0();
    if (hi == 0) li_l[r32] = l_reg; asm volatile("s_waitcnt lgkmcnt(0)" ::: "memory");
    float rli[16];
#pragma unroll
    for (int r = 0; r < 16; ++r) rli[r] = __builtin_amdgcn_rcpf(li_l[crow(r, hi)]);
    char* Ow = (char*)cur.O; const unsigned oo = (unsigned)(((wid * QBLK + 4 * hi) * LDO + r32) * 2);
#pragma unroll
    for (int r = 0; r < 16; ++r) { const unsigned orow = (unsigned)(((r & 3) + 8 * (r >> 2)) * LDO * 2);
#pragma unroll
        for (int d0 = 0; d0 < 4; ++d0) { const float v = o[d0][r] * rli[r];
            const float vn = __shfl_xor(v, 1);
            if ((r32 & 1) == 0) *(unsigned*)(Ow + (oo + orow + d0 * 64)) = cvtpk(v, vn); } }
    __syncthreads();
#undef RESC
#undef KBASE
#undef ACT
#undef MASKT
#undef SEAM_K0
#undef HALF_STEP
}
#undef ROWQ
#undef VMW
#undef VMWN
#undef SLOAD_H
#undef SWRITE_HK
#undef SWRITE_HV
#undef SWRITE_H
#undef LD8
#undef SBAR
#undef KSWZ
#undef KROW
}
#define GAS __attribute__((address_space(1)))
#define LAS __attribute__((address_space(3)))
typedef unsigned short bf16;
typedef unsigned v4u __attribute__((ext_vector_type(4)));
typedef unsigned v2u __attribute__((ext_vector_type(2)));
typedef float f32x4 __attribute__((ext_vector_type(4)));
constexpr int NWAVES = 8;
constexpr int BATCH = 2, SEQ = 16384, DM = 2048, TOK = BATCH * SEQ, FF = 8192, NQKV = 6144, NQKV1 = 6400, FH = 16;
constexpr float NORM_EPS = 1e-6f, SUBLN_EPS = 1e-5f, LAMBDA_INIT = 0.2f;
constexpr size_t MiB = 1u << 20;
constexpr size_t WS_F = 0, WS_CB = 2 * MiB;
constexpr size_t WS_WQKV0 = 4 * MiB, WS_WOA = 28 * MiB, WS_WMI0 = 36 * MiB, WS_WMO0 = 68 * MiB, WS_WQKV1 = 100 * MiB, WS_WOB = 126 * MiB, WS_WMI1 = 134 * MiB, WS_WMO1 = 166 * MiB;
constexpr size_t WS_NRM = 198 * MiB;
constexpr size_t WS_QKV = 200 * MiB;
constexpr size_t WS_OC = 584 * MiB;
constexpr size_t WS_HID = 200 * MiB;
constexpr size_t WS_XN = 840 * MiB;
constexpr size_t WS_END = 968 * MiB;
constexpr int LDS_BYTES = 147456;

__device__ __forceinline__ unsigned char* launder_p(unsigned char* p) { asm volatile("" : "+s"(p)); return p; }
__device__ __forceinline__ unsigned f2bf(float f) { unsigned u = __builtin_bit_cast(unsigned, f); return (u + 0x7fffu + ((u >> 16) & 1u)) >> 16; }
__device__ __forceinline__ unsigned pk2(float lo, float hi) { return f2bf(lo) | (f2bf(hi) << 16); }
__device__ __forceinline__ float bf2f(unsigned short b) { return __builtin_bit_cast(float, (unsigned)b << 16); }
__device__ __forceinline__ float wave_sum(float v) {
#pragma unroll
    for (int o = 1; o < 64; o <<= 1) v += __shfl_xor(v, o);
    return v;
}
__device__ __forceinline__ void transpose_item(const float* W, int K, int N, bf16* WT, int row_off, const float* g, LAS float* scr, int item, int lane) {
    const int nblk = N / 32, kb = item / nblk, nb = item % nblk, k0 = 64 * kb, n0 = 32 * nb;
#pragma unroll 8
    for (int i = 0; i < 32; ++i) { const int kk = 2 * i + (lane >> 5); float v = W[(size_t)(k0 + kk) * N + n0 + (lane & 31)]; if (g) v *= g[k0 + kk]; scr[kk * 33 + (lane & 31)] = v; }
    asm volatile("s_waitcnt lgkmcnt(0)" ::: "memory");
    const int c = lane & 7;
#pragma unroll
    for (int j = 0; j < 4; ++j) { const int n = (lane >> 3) + 8 * j; const LAS float* s = scr + (8 * c) * 33 + n;
        v4u o; o.x = pk2(s[0 * 33], s[1 * 33]); o.y = pk2(s[2 * 33], s[3 * 33]); o.z = pk2(s[4 * 33], s[5 * 33]); o.w = pk2(s[6 * 33], s[7 * 33]);
        *(v4u*)(WT + (size_t)(row_off + n0 + n) * K + k0 + 8 * c) = o; }
    asm volatile("s_waitcnt lgkmcnt(0)" ::: "memory");
}
__device__ __forceinline__ void norm_row_to_bf16(const float* xrow, bf16* orow, int lane) {
    const f32x4* xr = (const f32x4*)xrow + lane;
    f32x4 v[8]; float s = 0.f;
#pragma unroll
    for (int j = 0; j < 8; ++j) { v[j] = xr[64 * j]; s += (v[j].x * v[j].x + v[j].y * v[j].y) + (v[j].z * v[j].z + v[j].w * v[j].w); }
    const float rstd = 1.f / sqrtf(wave_sum(s) * (1.f / DM) + NORM_EPS);
    v2u* o8 = (v2u*)orow + lane;
#pragma unroll
    for (int j = 0; j < 8; ++j) { v2u w; w.x = pk2(v[j].x * rstd, v[j].y * rstd); w.y = pk2(v[j].z * rstd, v[j].w * rstd); o8[64 * j] = w; }
}
__device__ __forceinline__ void norm_phase(const float* src, bf16* dst, int gw, int NGW, int lane) {
    for (int m = gw; m < TOK; m += NGW) norm_row_to_bf16(src + (size_t)m * DM, dst + (size_t)m * DM, lane);
}
__device__ __forceinline__ void final_norm_phase(float* io, const float* g, int gw, int NGW, int lane) {
    for (int m = gw; m < TOK; m += NGW) {
        f32x4* xr = (f32x4*)(io + (size_t)m * DM) + lane; const f32x4* gr = (const f32x4*)g + lane;
        f32x4 v[8]; float s = 0.f;
#pragma unroll
        for (int j = 0; j < 8; ++j) { v[j] = xr[64 * j]; s += (v[j].x * v[j].x + v[j].y * v[j].y) + (v[j].z * v[j].z + v[j].w * v[j].w); }
        const float rstd = 1.f / sqrtf(wave_sum(s) * (1.f / DM) + NORM_EPS);
#pragma unroll
        for (int j = 0; j < 8; ++j) xr[64 * j] = v[j] * rstd * gr[64 * j];
    }
}
__device__ __forceinline__ void combine_phase(const bf16* OC, bf16* O, const float* lq1, const float* lk1, const float* lq2, const float* lk2, const float* sg, int gw, int NGW, int lane) {
    const float s1 = wave_sum(lq1[lane] * lk1[lane] + lq1[lane + 64] * lk1[lane + 64]), s2 = wave_sum(lq2[lane] * lk2[lane] + lq2[lane + 64] * lk2[lane + 64]);
    const float lam = expf(s1) - expf(s2) + LAMBDA_INIT;
    float gs[8];
#pragma unroll
    for (int e = 0; e < 8; ++e) gs[e] = sg[(lane & 31) * 8 + e] * (1.f - LAMBDA_INIT);
    for (int m = gw; m < TOK; m += NGW) {
        const v4u* a = (const v4u*)(OC + (size_t)m * DM) + lane; const v4u* b = (const v4u*)(OC + (size_t)TOK * DM + (size_t)m * DM) + lane; v4u* o = (v4u*)(O + (size_t)m * DM) + lane;
#pragma unroll
        for (int st = 0; st < 4; ++st) { const v4u av = a[64 * st], bv = b[64 * st]; float d[8]; float ss = 0.f;
#pragma unroll
            for (int e = 0; e < 4; ++e) { const unsigned aw = av[e], bw = bv[e];
                d[2 * e] = __builtin_bit_cast(float, aw << 16) - lam * __builtin_bit_cast(float, bw << 16);
                d[2 * e + 1] = __builtin_bit_cast(float, aw & 0xffff0000u) - lam * __builtin_bit_cast(float, bw & 0xffff0000u);
                ss += d[2 * e] * d[2 * e] + d[2 * e + 1] * d[2 * e + 1]; }
#pragma unroll
            for (int of = 1; of < 32; of <<= 1) ss += __shfl_xor(ss, of);
            const float rstd = 1.f / sqrtf(ss * (1.f / 256.f) + SUBLN_EPS);
            v4u w; w.x = pk2(d[0] * rstd * gs[0], d[1] * rstd * gs[1]); w.y = pk2(d[2] * rstd * gs[2], d[3] * rstd * gs[3]);
            w.z = pk2(d[4] * rstd * gs[4], d[5] * rstd * gs[5]); w.w = pk2(d[6] * rstd * gs[6], d[7] * rstd * gs[7]); o[64 * st] = w; }
    }
}
__device__ __forceinline__ void cumsum_phase(const float* F, const float* bfb, float* CB, LAS unsigned char* lds, int bx, int G, int tid) {
    LAS double* sc = (LAS double*)lds;
    for (int bh = bx; bh < BATCH * FH; bh += G) {
        const int b = bh / FH, h = bh % FH; const float bias = bfb[h];
        const float* fp = F + ((size_t)b * SEQ + (size_t)tid * 32) * FH + h;
        float ls[32]; double run = 0.0;
#pragma unroll
        for (int i = 0; i < 32; ++i) { const float x = fp[(size_t)i * FH] + bias; ls[i] = fminf(x, 0.f) - log1pf(expf(-fabsf(x))); run += (double)ls[i]; }
        sc[tid] = run; __syncthreads();
        int cur = 0;
        for (int of = 1; of < 512; of <<= 1) { double v = sc[cur * 512 + tid]; if (tid >= of) v += sc[cur * 512 + tid - of]; sc[(cur ^ 1) * 512 + tid] = v; cur ^= 1; __syncthreads(); }
        double acc = sc[cur * 512 + tid] - run;
        float* op = CB + (size_t)bh * SEQ + (size_t)tid * 32;
#pragma unroll
        for (int i = 0; i < 32; ++i) { acc += (double)ls[i]; op[i] = (float)(-acc * 11.313708498984761); }
        __syncthreads();
    }
}

__device__ __forceinline__ void rownorm_phase(const bf16* QKV, unsigned* NRM, int bx, int G, int tid) {
    for (int vw = bx; vw < 256; vw += G) {
        const int bh = vw >> 3, part = vw & 7, b = bh >> 4, h = bh & 15;
        const char* base = (const char*)(QKV + ((size_t)b * SEQ + (size_t)part * 2048) * NQKV + h * 128);
        const unsigned vo = (unsigned)(((tid >> 4) * NQKV + (tid & 15) * 8) * 2);
        float mq = 0.f, mk = 0.f;
#pragma unroll 4
        for (int it = 0; it < 64; ++it) {
            const char* rp = base + (size_t)it * 32 * NQKV * 2;
            const v4u qv = *(const v4u*)(rp + vo), kv = *(const v4u*)(rp + vo + 2048 * 2);
            float sq = 0.f, sk = 0.f;
#pragma unroll
            for (int e = 0; e < 4; ++e) { const float a0 = __builtin_bit_cast(float, qv[e] << 16), a1 = __builtin_bit_cast(float, qv[e] & 0xffff0000u), b0 = __builtin_bit_cast(float, kv[e] << 16), b1 = __builtin_bit_cast(float, kv[e] & 0xffff0000u);
                sq += a0 * a0 + a1 * a1; sk += b0 * b0 + b1 * b1; }
#pragma unroll
            for (int of = 1; of < 16; of <<= 1) { sq += __shfl_xor(sq, of); sk += __shfl_xor(sk, of); }
            mq = fmaxf(mq, sq); mk = fmaxf(mk, sk);
        }
        mq = fmaxf(mq, __shfl_xor(mq, 16)); mq = fmaxf(mq, __shfl_xor(mq, 32)); mk = fmaxf(mk, __shfl_xor(mk, 16)); mk = fmaxf(mk, __shfl_xor(mk, 32));
        if ((tid & 63) == 0) { atomicMax(NRM + bh * 2, __float_as_uint(mq)); atomicMax(NRM + bh * 2 + 1, __float_as_uint(mk)); }
    }
}

struct Args { const float* in[21]; float* out; unsigned char* ws; };
template <int MODE> __device__ __forceinline__ bool attn_item(int i, int G, int bx, int& s, int& x) {
    constexpr int NS = MODE == 0 ? 64 : 32;
    if ((G & 7) == 0) { const int xcd = bx & 7, k = bx >> 3, kpx = G >> 3; const int idx = k + i * kpx; if (idx >= (NS / 8) * 32) return false; s = (idx >> 5) * 8 + xcd; x = idx & 31; return true; }
    const int L = bx + i * G; if (L >= NS * 32) return false; s = L >> 5; x = L & 31; return true;
}
template <int MODE> __device__ __forceinline__ att::BlockRef attn_ref(int s, int qb, int jlo, const bf16* QKV, bf16* Obuf, const float* CB) {
    att::BlockRef r; r.P0 = qb * 256; r.jlo = jlo;
    if (MODE == 0) { const int xcd = s & 7, sl = s >> 3, vh = sl & 1, c = (sl >> 1) & 1, bh = xcd * 2 + ((sl >> 2) & 1), b = bh >> 3, h = bh & 7;
        const bf16* base = QKV + (size_t)b * SEQ * NQKV;
        r.Q = base + (size_t)r.P0 * NQKV + h * 256 + c * 128; r.K = base + 2048 + h * 256 + c * 128; r.V = base + 4096 + h * 256 + vh * 128;
        r.O = Obuf + (size_t)c * TOK * DM + ((size_t)b * SEQ + r.P0) * DM + h * 256 + vh * 128; r.CB = nullptr; r.h = h; }
    else { const int b = s >> 4, h = s & 15; const bf16* base = QKV + (size_t)b * SEQ * NQKV;
        r.Q = base + (size_t)r.P0 * NQKV + h * 128; r.K = base + 2048 + h * 128; r.V = base + 4096 + h * 128;
        r.O = Obuf + ((size_t)b * SEQ + r.P0) * DM + h * 128; r.CB = CB + (size_t)s * SEQ; r.h = 0; }
    return r;
}
template <int MODE> __device__ __forceinline__ void attn_phase(char* lds, const bf16* QKV, bf16* Obuf, const float* CB, const unsigned* NRM, int G, int bx) {
    int* jt = (int*)(lds + att::OFF_TB);
    if (MODE == 1) {
        int tid = threadIdx.x; asm volatile("" : "+v"(tid)); const int w = __builtin_amdgcn_readfirstlane(tid >> 6), lane = tid & 63;
        if (tid < 64) jt[tid] = 0;
        __syncthreads();
        for (int e = w; e < 64; e += 8) { int s, x; if (!attn_item<MODE>(e >> 1, G, bx, s, x)) break;
            const int qb = (e & 1) ? 63 - x : x, jmax = qb * 4; const float* cb = CB + (size_t)s * SEQ;
            const float qn = sqrtf(__uint_as_float(NRM[s * 2])) * 1.01f, kn = sqrtf(__uint_as_float(NRM[s * 2 + 1])) * 1.01f;
            const float thr = cb[qb * 256] - 110.f * 11.313708498984761f - 2.f * qn * kn;
            int need = 0;
            for (int j0 = jmax - 1; j0 >= 0; j0 -= 64) { const int j = j0 - lane; const bool c = (j >= 0) && (cb[(j >= 0 ? j : 0) * 64 + 63] >= thr);
                const unsigned long long m = __ballot(c); const int n = __builtin_popcountll(m); need += n; if (n < 64) break; }
            if (lane == 0) jt[e] = jmax - need; }
        __syncthreads();
    }
    int i = 0, pass = 0, s = 0, x = 0;
    if (!attn_item<MODE>(0, G, bx, s, x)) return;
    att::BlockRef cur = attn_ref<MODE>(s, x, (MODE == 1) ? jt[0] : 0, QKV, Obuf, CB);
    att::Seam S;
    att::attn_prime<MODE>(cur, lds, S);
    for (;;) {
        int sn = s, xn = x, in = i, passn = pass + 1; bool last = false;
        if (pass == 1) { passn = 0; in = i + 1; if (!attn_item<MODE>(in, G, bx, sn, xn)) last = true; }
        const int jl = (MODE == 1 && in < 32) ? jt[in * 2 + passn] : 0;
        const att::BlockRef nxt = last ? cur : attn_ref<MODE>(sn, passn ? 63 - xn : xn, jl, QKV, Obuf, CB);
        att::attn_block<MODE>(cur, nxt, lds, S);
        if (last) break;
        cur = nxt; s = sn; x = xn; i = in; pass = passn;
    }
}

__global__ void __launch_bounds__(NWAVES * 64, 2) yoco_fwd(Args args) {
    extern __shared__ __attribute__((aligned(16))) unsigned char lds[];
    cg::grid_group grid = cg::this_grid();
    LAS unsigned char* ldsl = (LAS unsigned char*)lds;
    const int G = gridDim.x, bx = blockIdx.x, NGW = G * NWAVES;
    int tid, lane, wave, gw;
#define FRESH() do { tid = threadIdx.x; asm volatile("" : "+v"(tid)); lane = tid & 63; wave = __builtin_amdgcn_readfirstlane(tid >> 6); gw = bx * NWAVES + wave; } while (0)
    FRESH();
#define WSP(T, off) ((T*)(launder_p(args.ws) + (off)))
#define Wqkv0 WSP(bf16, WS_WQKV0)
#define Woa WSP(bf16, WS_WOA)
#define Wmi0 WSP(bf16, WS_WMI0)
#define Wmo0 WSP(bf16, WS_WMO0)
#define Wqkv1 WSP(bf16, WS_WQKV1)
#define Wob WSP(bf16, WS_WOB)
#define Wmi1 WSP(bf16, WS_WMI1)
#define Wmo1 WSP(bf16, WS_WMO1)
#define QKV WSP(bf16, WS_QKV)
#define OC WSP(bf16, WS_OC)
#define HID WSP(bf16, WS_HID)
#define XN WSP(bf16, WS_XN)
#define Fb WSP(float, WS_F)
#define CB WSP(float, WS_CB)
#define NRM WSP(unsigned, WS_NRM)
#define out ((float*)launder_p((unsigned char*)args.out))
#define XIN ((const float*)launder_p((unsigned char*)args.in[0]))

    {
        LAS float* scr = (LAS float*)(ldsl + wave * 16384);
        bf16* const wqkv1 = Wqkv1;
        const float* ag = args.in[2]; const float* mg = args.in[3]; const float* kg = args.in[11];
        constexpr int I_QKV = (DM / 64) * (NQKV / 32), I_DD = (DM / 64) * (DM / 32), I_MI = (DM / 64) * (FF / 32), I_MO = (FF / 64) * (DM / 32);
        constexpr int NITEMS = I_QKV + 5 * I_DD + 2 * I_MI + 2 * I_MO;
        for (int it = gw; it < NITEMS; it += NGW) {
            int r = it;
            if (r < I_QKV) { transpose_item(args.in[4], DM, NQKV, Wqkv0, 0, ag, scr, r, lane); continue; } r -= I_QKV;
            if (r < I_DD) { transpose_item(args.in[10], DM, DM, Woa, 0, nullptr, scr, r, lane); continue; } r -= I_DD;
            if (r < I_DD) { transpose_item(args.in[16], DM, DM, wqkv1, 0, ag + DM, scr, r, lane); continue; } r -= I_DD;
            if (r < I_DD) { transpose_item(args.in[12], DM, DM, wqkv1, DM, kg, scr, r, lane); continue; } r -= I_DD;
            if (r < I_DD) { transpose_item(args.in[13], DM, DM, wqkv1, 2 * DM, kg, scr, r, lane); continue; } r -= I_DD;
            if (r < I_DD) { transpose_item(args.in[17], DM, DM, Wob, 0, nullptr, scr, r, lane); continue; } r -= I_DD;
            if (r < I_MI) { transpose_item(args.in[18], DM, FF, Wmi0, 0, mg, scr, r, lane); continue; } r -= I_MI;
            if (r < I_MI) { transpose_item(args.in[18] + (size_t)DM * FF, DM, FF, Wmi1, 0, mg + DM, scr, r, lane); continue; } r -= I_MI;
            if (r < I_MO) { transpose_item(args.in[19], FF, DM, Wmo0, 0, nullptr, scr, r, lane); continue; } r -= I_MO;
            transpose_item(args.in[19] + (size_t)FF * DM, FF, DM, Wmo1, 0, nullptr, scr, r, lane);
        }
        { const float* wf = args.in[14]; const int gt = bx * 512 + tid, NT_ = G * 512;
          for (int e = gt; e < (NQKV1 - NQKV) * DM; e += NT_) { const int n = e / DM, k = e % DM; wqkv1[(size_t)(NQKV + n) * DM + k] = (n < FH) ? (bf16)f2bf(wf[(size_t)k * FH + n] * kg[k]) : (bf16)0; } }
        if (bx == 0 && tid < 64) NRM[tid] = 0u;
        norm_phase(XIN, XN, gw, NGW, lane);
    }
    grid.sync();
    { pg8::Gemm g{XN, Wqkv0, TOK, NQKV, DM}; pg8::StaticOrder S; S.init(TOK, NQKV, G, bx);
      pg8::EpiX<0> E{QKV, NQKV, nullptr, nullptr, nullptr};
      pg8::gemm_phase<pg8::EpiX<0>, pg8::StaticOrder, PG8_ALIGN, PG8_SP2>(ldsl, g, S, E); }
    grid.sync();
    {
      FRESH(); const float* tab = args.in[1]; float* tb = (float*)(lds + att::OFF_TB);
      for (int idx = tid; idx < 2048; idx += 512) { const int h = idx >> 8, rel = (idx & 255) - 192; const int n = rel < 0 ? -rel : rel;
          int bk = n < 8 ? n : 8 + (n >= 12) + (n >= 16) + (n >= 23) + (n >= 32) + (n >= 46) + (n >= 64) + (n >= 91); if (rel > 0) bk += 16;
          tb[idx] = (tab[bk * 8 + h] - tab[15 * 8 + h]) * 11.313708498984761f; }
      __syncthreads();
#ifndef NO_ATT0
      attn_phase<0>((char*)lds, QKV, OC, nullptr, nullptr, G, bx);
#endif
    }
    grid.sync();
    FRESH(); combine_phase(OC, XN, args.in[5], args.in[6], args.in[7], args.in[8], args.in[9], gw, NGW, lane);
    grid.sync();
    { pg8::Gemm g{XN, Woa, TOK, DM, DM}; pg8::StaticOrder S; S.init(TOK, DM, G, bx);
      pg8::EpiX<2> E{nullptr, DM, XIN, out, nullptr};
      pg8::gemm_phase<pg8::EpiX<2>, pg8::StaticOrder, PG8_ALIGN, PG8_SP2>(ldsl, g, S, E); }
    grid.sync();
    FRESH(); norm_phase(out, XN, gw, NGW, lane);
    grid.sync();
    { pg8::Gemm g{XN, Wmi0, TOK, FF, DM}; pg8::StaticOrder S; S.init(TOK, FF, G, bx);
      pg8::EpiX<1> E{HID, FF, nullptr, nullptr, nullptr};
      pg8::gemm_phase<pg8::EpiX<1>, pg8::StaticOrder, PG8_ALIGN, PG8_SP2>(ldsl, g, S, E); }
    grid.sync();
    { pg8::Gemm g{HID, Wmo0, TOK, DM, FF}; pg8::StaticOrder S; S.init(TOK, DM, G, bx);
      pg8::EpiX<2> E{nullptr, DM, out, out, nullptr};
      pg8::gemm_phase<pg8::EpiX<2>, pg8::StaticOrder, PG8_ALIGN, PG8_SP2>(ldsl, g, S, E); }
    grid.sync();
    FRESH(); norm_phase(out, XN, gw, NGW, lane);
    grid.sync();
    { pg8::Gemm g{XN, Wqkv1, TOK, NQKV1, DM}; pg8::StaticOrder S; S.init(TOK, NQKV1, G, bx);
      pg8::EpiX<3> E{QKV, NQKV, nullptr, nullptr, Fb};
      pg8::gemm_phase<pg8::EpiX<3>, pg8::StaticOrder, PG8_ALIGN, PG8_SP2>(ldsl, g, S, E); }
    grid.sync();
#ifndef NO_CUM
    FRESH(); cumsum_phase(Fb, args.in[15], CB, ldsl, bx, G, tid);
    rownorm_phase(QKV, NRM, bx, G, tid);
#endif
    grid.sync();
#ifndef NO_ATT1
    attn_phase<1>((char*)lds, QKV, XN, CB, NRM, G, bx);
#endif
    grid.sync();
    { pg8::Gemm g{XN, Wob, TOK, DM, DM}; pg8::StaticOrder S; S.init(TOK, DM, G, bx);
      pg8::EpiX<2> E{nullptr, DM, out, out, nullptr};
      pg8::gemm_phase<pg8::EpiX<2>, pg8::StaticOrder, PG8_ALIGN, PG8_SP2>(ldsl, g, S, E); }
    grid.sync();
    FRESH(); norm_phase(out, XN, gw, NGW, lane);
    grid.sync();
    { pg8::Gemm g{XN, Wmi1, TOK, FF, DM}; pg8::StaticOrder S; S.init(TOK, FF, G, bx);
      pg8::EpiX<1> E{HID, FF, nullptr, nullptr, nullptr};
      pg8::gemm_phase<pg8::EpiX<1>, pg8::StaticOrder, PG8_ALIGN, PG8_SP2>(ldsl, g, S, E); }
    grid.sync();
    { pg8::Gemm g{HID, Wmo1, TOK, DM, FF}; pg8::StaticOrder S; S.init(TOK, DM, G, bx);
      pg8::EpiX<2> E{nullptr, DM, out, out, nullptr};
      pg8::gemm_phase<pg8::EpiX<2>, pg8::StaticOrder, PG8_ALIGN, PG8_SP2>(ldsl, g, S, E); }
    grid.sync();
    FRESH(); final_norm_phase(out, args.in[20], gw, NGW, lane);
}

#undef out
#undef XIN
extern "C" void kernel_launch(void* const* d_in, const int* in_sizes, int n_in, void* d_out, int out_size, void* d_ws, size_t ws_size, hipStream_t stream) {
    static int grid = 0;
    if (grid == 0) {
        if (n_in != 21 || in_sizes[0] != TOK * DM || out_size != TOK * DM || ws_size < WS_END) { fprintf(stderr, "kernel_launch: unexpected shapes (n_in %d, in0 %d, out %d, ws %zu)\n", n_in, n_in > 0 ? in_sizes[0] : -1, out_size, ws_size); grid = -1; return; }
        int dev = 0, cus = 0, per_cu = 0;
        (void)hipGetDevice(&dev); (void)hipDeviceGetAttribute(&cus, hipDeviceAttributeMultiprocessorCount, dev);
        if (hipFuncSetAttribute((const void*)yoco_fwd, hipFuncAttributeMaxDynamicSharedMemorySize, LDS_BYTES) != hipSuccess) { fprintf(stderr, "kernel_launch: hipFuncSetAttribute failed\n"); grid = -1; return; }
        if (hipOccupancyMaxActiveBlocksPerMultiprocessor(&per_cu, (const void*)yoco_fwd, NWAVES * 64, LDS_BYTES) != hipSuccess || per_cu < 1) { fprintf(stderr, "kernel_launch: occupancy query gives %d\n", per_cu); per_cu = 1; }
        (void)hipGetLastError();
        grid = cus > 0 ? cus : 256;
    }
    if (grid < 0) return;
    Args a{};
    for (int i = 0; i < 21; ++i) a.in[i] = (const float*)d_in[i];
    a.out = (float*)d_out; a.ws = (unsigned char*)d_ws;
    void* kargs[] = {&a};
    hipError_t e = hipLaunchCooperativeKernel((const void*)yoco_fwd, dim3(grid), dim3(NWAVES * 64), kargs, LDS_BYTES, stream);
    if (e != hipSuccess) fprintf(stderr, "kernel_launch: cooperative launch failed: %s (grid %d)\n", hipGetErrorString(e), grid);
}
```

```cpp
#include <hip/hip_runtime.h>
#include <hip/hip_cooperative_groups.h>
#include <cstdio>
#include <cstdint>
namespace cg = cooperative_groups;
namespace pg8 {
#define PG8_LAS __attribute__((address_space(3)))
typedef unsigned short bf16_t;
typedef short bf16x8 __attribute__((ext_vector_type(8)));
typedef float f32x4 __attribute__((ext_vector_type(4)));
typedef unsigned u32x4 __attribute__((ext_vector_type(4)));
constexpr int BM = 256, BK = 64, HALF = 128, HTB = HALF * BK * 2  , STAGE_BYTES = 8 * HTB, NXCD = 8, WGM = 8;

__host__ __device__ __forceinline__ int lds_byte(int r, int c) { const int st = (r >> 4) * 2 + (c >> 5), rr = r & 15, cc = c & 31, ob = rr * 64 + cc * 2; return st * 1024 + (ob ^ (((ob >> 9) & 1) << 5)); }
__host__ __device__ __forceinline__ void stage_rc(int b, int& R, int& C) { const int st = b / 1024, sb = b % 1024, swz = sb ^ (((sb >> 9) & 1) << 5); R = (st >> 1) * 16 + swz / 64; C = (st & 1) * 32 + (swz % 64) / 2; }
__host__ __device__ __forceinline__ int perm32(int rho) { const int n = rho >> 4, i = rho & 15; return 8 * (i >> 2) + 4 * n + (i & 3); }

struct Unit { int pm, pn; };
struct Gemm { const bf16_t* A; const bf16_t* Bt; int M, N, K; };

struct StaticOrder {
    int nM, nN, nwg, G, c;
    __host__ __device__ void init(int M, int N, int G_, int c_) { nM = M / BM; nN = N / BM; nwg = nM * nN; G = G_; c = c_; }
    __host__ __device__ bool next(int i, Unit& u) const {
        const long L = (long)i * G + c; if (L >= nwg) return false;
        int wgid = (int)L; { const int q = nwg / NXCD, r = nwg % NXCD, xcd = wgid % NXCD, off = wgid / NXCD; wgid = (xcd < r ? xcd * (q + 1) : r * (q + 1) + (xcd - r) * q) + off; }
        const int nig = WGM * nN, gid = wgid / nig, fm = gid * WGM, gsz = (nM - fm) < WGM ? (nM - fm) : WGM;
        u.pm = fm + ((wgid % nig) % gsz); u.pn = (wgid % nig) / gsz; return true;
    }
    __device__ __forceinline__ void a_ready(const Unit&) const {}
    __device__ __forceinline__ void done(const Unit&) const {}
};

__device__ __forceinline__ unsigned cvt_pk_bf16(float lo, float hi) { unsigned r; asm volatile("v_cvt_pk_bf16_f32 %0, %1, %2" : "=v"(r) : "v"(lo), "v"(hi)); return r; }
typedef float f32x2 __attribute__((ext_vector_type(2)));
template <int MODE, bool RS_IN, bool COPY, bool SUMSQ> struct EpiX {
    static constexpr bool PERM = true, AFTER_DRAIN = false;
    bf16_t* O; int ldc; const float* base; float* out; float* F; const float* rs_in; float* rs_out;
    __device__ __forceinline__ void operator()(const f32x4 (&acc)[2][2][4][2], const Unit& u, int wr, int wc, int fr, int fq) const {
        const int row0 = u.pm * BM + wr * 64 + fr, col0 = u.pn * BM + wc * 32 + 8 * fq;
        const bool ftile = (MODE == 3) && (u.pn * BM >= 6144);
#pragma unroll
        for (int ai = 0; ai < 2; ++ai)
#pragma unroll
            for (int m = 0; m < 4; ++m) { const size_t row = (size_t)(row0 + ai * HALF + m * 16);
                float rs = 1.f; if (RS_IN) rs = 1.f / sqrtf(rs_in[row] * (1.f / 2048.f) + 1e-6f);
                float ss = 0.f;
#pragma unroll
                for (int bj = 0; bj < 2; ++bj) { f32x4 v0 = acc[ai][bj][m][0], v1 = acc[ai][bj][m][1]; const int col = col0 + bj * HALF;
                    if (RS_IN) { v0 = v0 * rs; v1 = v1 * rs; }
                    if (MODE == 2) { const float* bp = base + row * ldc + col; float* op = out + row * ldc + col;
                        const f32x4 b0 = *(const f32x4*)bp, b1 = *(const f32x4*)(bp + 4); v0 = b0 + v0; v1 = b1 + v1; *(f32x4*)op = v0; *(f32x4*)(op + 4) = v1;
                        if (SUMSQ) ss += (v0[0] * v0[0] + v0[1] * v0[1]) + (v0[2] * v0[2] + v0[3] * v0[3]) + (v1[0] * v1[0] + v1[1] * v1[1]) + (v1[2] * v1[2] + v1[3] * v1[3]);
                        if (COPY) { u32x4 w; w.x = cvt_pk_bf16(v0[0], v0[1]); w.y = cvt_pk_bf16(v0[2], v0[3]); w.z = cvt_pk_bf16(v1[0], v1[1]); w.w = cvt_pk_bf16(v1[2], v1[3]); *(u32x4*)(O + row * ldc + col) = w; } }
                    else if (ftile) { if (bj == 0 && wc == 0 && fq < 2) { float* fp = F + row * 16 + 8 * fq; *(f32x4*)fp = v0; *(f32x4*)(fp + 4) = v1; } }
                    else { if (MODE == 1) {
#pragma unroll
                            for (int e = 0; e < 4; ++e) { const float a = fmaxf(v0[e], 0.f), b = fmaxf(v1[e], 0.f); v0[e] = a * a; v1[e] = b * b; } }
                        u32x4 w; w.x = cvt_pk_bf16(v0[0], v0[1]); w.y = cvt_pk_bf16(v0[2], v0[3]); w.z = cvt_pk_bf16(v1[0], v1[1]); w.w = cvt_pk_bf16(v1[2], v1[3]);
                        *(u32x4*)(O + row * ldc + col) = w; } }
                if (SUMSQ) { ss += __shfl_xor(ss, 16); ss += __shfl_xor(ss, 32); if (fq == 0) atomicAdd(rs_out + row, ss); }
                if (MODE == 2) asm volatile("" ::: "memory"); }
    }
};
template <class Epi, class Sched, bool ALIGN_EPI = false, bool SP2 = false>
__device__ __forceinline__ void gemm_phase(PG8_LAS unsigned char* lds, const Gemm g, const Sched& S, const Epi& E) {
    int tid = threadIdx.x; asm volatile("" : "+v"(tid));
    const int wid = __builtin_amdgcn_readfirstlane(tid >> 6), lane = tid & 63, wr = wid >> 2, wc = wid & 3, fr = lane & 15, fq = lane >> 4;
    const int K = g.K, nt = K / BK;
    unsigned voffA[2], voffB[2];
#pragma unroll
    for (int i = 0; i < 2; ++i) { int R, C; stage_rc(tid * 16 + i * 8192, R, C); const int Rb = Epi::PERM ? ((R & ~31) + perm32(R & 31)) : R;
        voffA[i] = (unsigned)(R * K + C) * 2u; voffB[i] = (unsigned)(Rb * K + C) * 2u; }
    const size_t kstep = (size_t)(BK * 2);
    const size_t hstep = (size_t)HALF * K * 2;
    const size_t tstep = 2 * hstep;
    const unsigned ldsw = (unsigned)wid * 1024u;
    const int aoff = lds_byte(wr * 64 + fr, fq * 8), boff = lds_byte(wc * 32 + fr, fq * 8);
#define PG8_SA(b, h) (((b) * 2 + (h)) * HTB)
#define PG8_SB(b, h) ((4 + (b) * 2 + (h)) * HTB)
#define PG8_STAGE(bufoff, gbase, voff) do { _Pragma("unroll") for (int _i = 0; _i < 2; ++_i) \
        __builtin_amdgcn_global_load_lds((const unsigned*)((const char*)(gbase) + (voff)[_i]), (PG8_LAS unsigned*)(lds + (bufoff) + ldsw + _i * 8192), 16, 0, 0); } while (0)
#define PG8_LDA(dst, b, h) do { _Pragma("unroll") for (int m = 0; m < 4; ++m) _Pragma("unroll") for (int k = 0; k < 2; ++k) dst[m][k] = *(const PG8_LAS bf16x8*)(lds + PG8_SA(b, h) + aoff + m * 2048 + k * 1024); } while (0)
#define PG8_LDB(dst, b, h) do { _Pragma("unroll") for (int n = 0; n < 2; ++n) _Pragma("unroll") for (int k = 0; k < 2; ++k) dst[n][k] = *(const PG8_LAS bf16x8*)(lds + PG8_SB(b, h) + boff + n * 2048 + k * 1024); } while (0)
#define PG8_MMA(ai, bj, At, Bt) do { __builtin_amdgcn_s_setprio(1); _Pragma("unroll") for (int m = 0; m < 4; ++m) _Pragma("unroll") for (int n = 0; n < 2; ++n) _Pragma("unroll") for (int k = 0; k < 2; ++k) \
        acc[ai][bj][m][n] = __builtin_amdgcn_mfma_f32_16x16x32_bf16(Bt[n][k], At[m][k], acc[ai][bj][m][n], 0, 0, 0); __builtin_amdgcn_s_setprio(0); } while (0)
#define PG8_WAIT_V(n) asm volatile("s_waitcnt vmcnt(" #n ")" ::: "memory")
#define PG8_WAIT_L(n) asm volatile("s_waitcnt lgkmcnt(" #n ")" ::: "memory")
#define PG8_BAR __builtin_amdgcn_s_barrier()
#define PG8_SCHED __builtin_amdgcn_sched_barrier(0)
    Unit cur, nxt; int ui = 0;
    if (!S.next(0, cur)) return;
    f32x4 acc[2][2][4][2];
#pragma unroll
    for (int a = 0; a < 2; ++a)
#pragma unroll
        for (int b = 0; b < 2; ++b)
#pragma unroll
            for (int m = 0; m < 4; ++m)
#pragma unroll
                for (int n = 0; n < 2; ++n) acc[a][b][m][n] = (f32x4){0.f, 0.f, 0.f, 0.f};
    bf16x8 At[4][2], B0[2][2], B1[2][2];
    const char* cA = (const char*)g.A + (size_t)cur.pm * tstep; const char* cB = (const char*)g.Bt + (size_t)cur.pn * tstep;
    S.a_ready(cur);
    if constexpr (SP2) {
        PG8_STAGE(PG8_SB(0, 0), cB, voffB); PG8_STAGE(PG8_SB(0, 1), cB + hstep, voffB); PG8_STAGE(PG8_SA(0, 0), cA, voffA); PG8_STAGE(PG8_SA(0, 1), cA + hstep, voffA);
        if (wr == 1) PG8_BAR;
        PG8_WAIT_V(2); PG8_BAR;
        PG8_STAGE(PG8_SB(1, 0), cB + kstep, voffB); PG8_STAGE(PG8_SA(1, 0), cA + kstep, voffA); PG8_STAGE(PG8_SB(1, 1), cB + hstep + kstep, voffB);
        PG8_WAIT_V(6); PG8_BAR;
    } else {
        PG8_STAGE(PG8_SB(0, 0), cB, voffB); PG8_STAGE(PG8_SA(0, 0), cA, voffA); PG8_STAGE(PG8_SB(0, 1), cB + hstep, voffB); PG8_STAGE(PG8_SA(0, 1), cA + hstep, voffA);
        if (wr == 1) PG8_BAR;
        PG8_WAIT_V(4); PG8_BAR;
        PG8_STAGE(PG8_SB(1, 0), cB + kstep, voffB); PG8_STAGE(PG8_SA(1, 0), cA + kstep, voffA); PG8_STAGE(PG8_SB(1, 1), cB + hstep + kstep, voffB);
        PG8_WAIT_V(6); PG8_BAR;
    }
    for (;;) {
        const bool has_next = S.next(ui + 1, nxt);
        const char* nA = has_next ? (const char*)g.A + (size_t)nxt.pm * tstep : cA; const char* nB = has_next ? (const char*)g.Bt + (size_t)nxt.pn * tstep : cB;
        for (int t = 0; t < nt; t += 2) {
            const bool last = (t == nt - 2);
            const char* a1 = cA + (size_t)(t + 1) * kstep;
            const char* a2 = last ? nA : cA + (size_t)(t + 2) * kstep; const char* b2 = last ? nB : cB + (size_t)(t + 2) * kstep;
            const char* a3 = a2 + kstep; const char* b3 = b2 + kstep;
            if (last && has_next) S.a_ready(nxt);
            if constexpr (SP2) {
            PG8_LDB(B0, 0, 0); PG8_LDB(B1, 0, 1); PG8_SCHED; PG8_LDA(At, 0, 0); PG8_STAGE(PG8_SA(1, 1), a1 + hstep, voffA);
            PG8_WAIT_V(8); PG8_WAIT_L(0); PG8_BAR; PG8_MMA(0, 0, At, B0); PG8_MMA(0, 1, At, B1); PG8_BAR; PG8_SCHED;
            PG8_LDA(At, 0, 1); PG8_STAGE(PG8_SB(0, 0), b2, voffB); PG8_STAGE(PG8_SB(0, 1), b2 + hstep, voffB); PG8_STAGE(PG8_SA(0, 0), a2, voffA);
            PG8_WAIT_V(8); PG8_WAIT_L(0); PG8_BAR; PG8_MMA(1, 0, At, B0); PG8_MMA(1, 1, At, B1); PG8_BAR; PG8_SCHED;
            PG8_LDB(B0, 1, 0); PG8_LDB(B1, 1, 1); PG8_SCHED; PG8_LDA(At, 1, 0); PG8_STAGE(PG8_SA(0, 1), a2 + hstep, voffA);
            PG8_WAIT_V(8); PG8_WAIT_L(0); PG8_BAR; PG8_MMA(0, 0, At, B0); PG8_MMA(0, 1, At, B1); PG8_BAR; PG8_SCHED;
            PG8_LDA(At, 1, 1); PG8_STAGE(PG8_SB(1, 0), b3, voffB); PG8_STAGE(PG8_SB(1, 1), b3 + hstep, voffB); PG8_STAGE(PG8_SA(1, 0), a3, voffA);
            PG8_WAIT_V(8); PG8_WAIT_L(0); PG8_BAR; PG8_MMA(1, 0, At, B0); PG8_MMA(1, 1, At, B1); PG8_BAR; PG8_SCHED;
            } else {
            PG8_LDB(B0, 0, 0); PG8_SCHED; PG8_LDA(At, 0, 0); PG8_STAGE(PG8_SA(1, 1), a1 + hstep, voffA);
            PG8_WAIT_L(8); PG8_BAR; PG8_WAIT_L(0); PG8_MMA(0, 0, At, B0); PG8_BAR; PG8_SCHED;
            PG8_LDB(B1, 0, 1); PG8_STAGE(PG8_SB(0, 0), b2, voffB);
            PG8_BAR; PG8_WAIT_L(0); PG8_MMA(0, 1, At, B1); PG8_BAR;
            PG8_LDA(At, 0, 1); PG8_STAGE(PG8_SA(0, 0), a2, voffA);
            PG8_BAR; PG8_WAIT_L(0); PG8_MMA(1, 0, At, B0); PG8_BAR; PG8_SCHED;
            PG8_STAGE(PG8_SB(0, 1), b2 + hstep, voffB);
            PG8_WAIT_V(6); PG8_BAR; PG8_MMA(1, 1, At, B1); PG8_BAR;
            PG8_LDB(B0, 1, 0); PG8_SCHED; PG8_LDA(At, 1, 0); PG8_STAGE(PG8_SA(0, 1), a2 + hstep, voffA);
            PG8_WAIT_L(8); PG8_BAR; PG8_WAIT_L(0); PG8_MMA(0, 0, At, B0); PG8_BAR; PG8_SCHED;
            PG8_LDB(B1, 1, 1); PG8_STAGE(PG8_SB(1, 0), b3, voffB);
            PG8_BAR; PG8_WAIT_L(0); PG8_MMA(0, 1, At, B1); PG8_BAR;
            PG8_LDA(At, 1, 1); PG8_STAGE(PG8_SA(1, 0), a3, voffA);
            PG8_BAR; PG8_WAIT_L(0); PG8_MMA(1, 0, At, B0); PG8_BAR; PG8_SCHED;
            PG8_STAGE(PG8_SB(1, 1), b3 + hstep, voffB);
            PG8_WAIT_V(6); PG8_BAR; PG8_MMA(1, 1, At, B1); PG8_BAR;
            }
        }
        if constexpr (ALIGN_EPI) { if (wr == 0) PG8_BAR; }
        if constexpr (!Epi::AFTER_DRAIN) { E(acc, cur, wr, wc, fr, fq); S.done(cur); }
        if (!has_next) break;
#pragma unroll
        for (int a = 0; a < 2; ++a)
#pragma unroll
            for (int b = 0; b < 2; ++b)
#pragma unroll
                for (int m = 0; m < 4; ++m)
#pragma unroll
                    for (int n = 0; n < 2; ++n) acc[a][b][m][n] = (f32x4){0.f, 0.f, 0.f, 0.f};
        cur = nxt; cA = nA; cB = nB; ++ui;
        if constexpr (ALIGN_EPI) { if (wr == 1) PG8_BAR; }
    }
    PG8_WAIT_V(0);
    if constexpr (!ALIGN_EPI) { if (wr == 0) PG8_BAR; }
    PG8_BAR;
    if constexpr (Epi::AFTER_DRAIN) { E.fused(acc, cur, wr, wc, fr, fq, lds, wid, lane); S.done(cur); }
#undef PG8_SA
#undef PG8_SB
#undef PG8_STAGE
#undef PG8_LDA
#undef PG8_LDB
#undef PG8_MMA
#undef PG8_WAIT_V
#undef PG8_WAIT_L
#undef PG8_BAR
#undef PG8_SCHED
}
}
#ifndef PG8_SP2
#define PG8_SP2 true
#endif
#ifndef PG8_ALIGN
#define PG8_ALIGN true
#endif
namespace att {
typedef unsigned short bf16;
typedef short bf16x8 __attribute__((ext_vector_type(8)));
typedef short s16x4 __attribute__((ext_vector_type(4)));
typedef float f32x16 __attribute__((ext_vector_type(16)));
typedef float f32x4 __attribute__((ext_vector_type(4)));
typedef unsigned u32x4 __attribute__((ext_vector_type(4)));
constexpr int D = 128, NW = 8, QBLK = 32, KVBLK = 64, QB = NW * QBLK, LDQ = 6144, LDO = 2048;
constexpr float SCALE = 0.08838834764831845f, THR = 8.f;
constexpr int SHM_V = KVBLK * D * 2, SHM_K = KVBLK * 272;
constexpr int OFF_WS = 2 * SHM_V + 2 * SHM_K, OFF_CL = OFF_WS + NW * 64 * 4, OFF_TB = OFF_CL + 512, LDS_BYTES = OFF_TB + 8192;
#define KROW 272
#define KSWZ(row, colB) ((row) * KROW + (colB))
#define SBAR() __builtin_amdgcn_sched_barrier(0)
__device__ __forceinline__ int v_st(int k, int c) { const int kk = (k & ~0xC) | ((k & 4) << 1) | ((k & 8) >> 1); return ((kk >> 3) * 4 + (c >> 5)) * 512 + ((kk & 7) * 32 + (c & 31)) * 2; }
__device__ __forceinline__ int v_rd_base(int lane) { return ((lane & 3) << 3) | (((lane >> 2) & 3) << 6) | (((lane >> 4) & 1) << 5) | (((lane >> 5) & 1) << 8); }
constexpr int v_rd_off(int d0, int ks, int half) { return d0 * 512 + ks * 4096 + half * 2048; }
__device__ __forceinline__ int crow(int r, int hi) { return (r & 3) + 8 * (r >> 2) + 4 * hi; }
__device__ __forceinline__ unsigned cvtpk(float lo, float hi) { unsigned r; asm volatile("v_cvt_pk_bf16_f32 %0, %1, %2" : "=v"(r) : "v"(lo), "v"(hi)); return r; }
__device__ __forceinline__ void mask_tile(f32x16& p0, f32x16& p1, int dq, unsigned W) {
    const float NEG = -__builtin_inff();
#pragma unroll
    for (int r = 0; r < 16; ++r) { const int c = (r & 3) + 8 * (r >> 2);
        if ((unsigned)(dq - c) >= W) p0[r] = NEG;
        if ((unsigned)(dq - c - 32) >= W) p1[r] = NEG; }
}
__device__ __forceinline__ void add_bias(f32x16& p0, f32x16& p1, const float* tb, int relbase) {
    const float* t = tb + relbase;
#pragma unroll
    for (int r = 0; r < 16; ++r) { const int c = (r & 3) + 8 * (r >> 2); p0[r] += t[c]; p1[r] += t[c + 32]; }
}
__device__ __forceinline__ void partialSM(f32x16& p0, f32x16& p1, float& m_reg, float& mn, float& alpha) {
    float pmax = p0[0]; for (int r = 1; r < 16; ++r) pmax = fmaxf(pmax, p0[r]); for (int r = 0; r < 16; ++r) pmax = fmaxf(pmax, p1[r]);
    { auto rr = __builtin_amdgcn_permlane32_swap(__float_as_uint(pmax), __float_as_uint(pmax), false, false);
      pmax = fmaxf(__uint_as_float(rr[0]), __uint_as_float(rr[1])); }
    constexpr float C2 = 1.4426950408889634f * SCALE;
    if (__builtin_expect(__all((pmax - m_reg) * SCALE <= THR), 1)) { mn = m_reg; alpha = 1.f; }
    else { mn = fmaxf(m_reg, pmax); alpha = __builtin_amdgcn_exp2f((m_reg - mn) * C2); m_reg = mn; }
    const float mnL = -mn * C2;
    for (int r = 0; r < 16; ++r) p0[r] = fmaf(p0[r], C2, mnL); for (int r = 0; r < 16; ++r) p1[r] = fmaf(p1[r], C2, mnL);
    for (int r = 0; r < 16; ++r) p0[r] = __builtin_amdgcn_exp2f(p0[r]);
}
__device__ __forceinline__ void finishSM(f32x16& p0, f32x16& p1, float alpha, float& l_reg, bf16x8& pa0, bf16x8& pa1, bf16x8& pa2, bf16x8& pa3) {
    for (int r = 0; r < 16; ++r) p1[r] = __builtin_amdgcn_exp2f(p1[r]);
    float ps = 0; for (int r = 0; r < 16; ++r) ps += p0[r]; for (int r = 0; r < 16; ++r) ps += p1[r];
    { auto rr = __builtin_amdgcn_permlane32_swap(__float_as_uint(ps), __float_as_uint(ps), false, false);
      ps = __uint_as_float(rr[0]) + __uint_as_float(rr[1]); }
    l_reg = l_reg * alpha + ps;
#define PK4(P, B_, OUT) do { unsigned a0 = cvtpk(P[B_+0], P[B_+1]), a1 = cvtpk(P[B_+2], P[B_+3]);                          \
        unsigned b0 = cvtpk(P[B_+4], P[B_+5]), b1 = cvtpk(P[B_+6], P[B_+7]);                                             \
        auto r0 = __builtin_amdgcn_permlane32_swap(a0, b0, false, false); auto r1 = __builtin_amdgcn_permlane32_swap(a1, b1, false, false); \
        u32x4 w = {r0[0], r1[0], r0[1], r1[1]}; OUT = *reinterpret_cast<bf16x8*>(&w); } while (0)
    PK4(p0, 0, pa0); PK4(p0, 8, pa1); PK4(p1, 0, pa2); PK4(p1, 8, pa3);
#undef PK4
}
template <int KB, bool SK, int MODE>
__device__ __forceinline__ void qkt(f32x16& p0, f32x16& p1, const char* lds, int r32, int hi, const bf16x8* qr, bool act) {
    if (SK && !act) { const float NEG = -__builtin_inff();
#pragma unroll
        for (int r = 0; r < 16; ++r) { p0[r] = NEG; p1[r] = NEG; } return; }
    if (MODE == 1) { const float* cl = (const float*)(lds + OFF_CL) + KB * 64 + 4 * hi;
#pragma unroll
        for (int g = 0; g < 4; ++g) { const f32x4 a = *(const f32x4*)(cl + 8 * g), b = *(const f32x4*)(cl + 32 + 8 * g);
            p0[4 * g] = a[0]; p0[4 * g + 1] = a[1]; p0[4 * g + 2] = a[2]; p0[4 * g + 3] = a[3];
            p1[4 * g] = b[0]; p1[4 * g + 1] = b[1]; p1[4 * g + 2] = b[2]; p1[4 * g + 3] = b[3]; } }
    else { p0 = f32x16{}; p1 = f32x16{}; }
    const char* K_lds = lds + 2 * SHM_V;
    const char* kb0 = K_lds + KB * SHM_K + KSWZ(r32, hi * 16);
#pragma unroll
    for (int d0 = 0; d0 < 8; ++d0) { const char* a = kb0 + d0 * 32;
        bf16x8 b0 = *reinterpret_cast<const bf16x8*>(a);
        bf16x8 b1 = *reinterpret_cast<const bf16x8*>(a + 32 * KROW);
        p0 = __builtin_amdgcn_mfma_f32_32x32x16_bf16(b0, qr[d0], p0, 0, 0, 0);
        p1 = __builtin_amdgcn_mfma_f32_32x32x16_bf16(b1, qr[d0], p1, 0, 0, 0); }
}
template <int VB, bool SK>
__device__ __forceinline__ void pv_tile(f32x16* o, int vb0, bf16x8 pa0, bf16x8 pa1, bf16x8 pa2, bf16x8 pa3, bool act) {
    if (SK && !act) return;
#define TRRD(dst, off) asm volatile("ds_read_b64_tr_b16 %0, %1 offset:%2" : "=&v"(dst) : "v"(vb0), "i"(off) : "memory")
#define PV_D0(d0) do { s16x4 l0, l1, l2, l3, h0, h1, h2, h3; constexpr int b_ = VB * SHM_V + v_rd_off(d0, 0, 0); \
        TRRD(l0, b_); TRRD(h0, b_ + 2048); TRRD(l1, b_ + 4096); TRRD(h1, b_ + 6144); TRRD(l2, b_ + 8192); TRRD(h2, b_ + 10240); TRRD(l3, b_ + 12288); TRRD(h3, b_ + 14336); \
        asm volatile("s_waitcnt lgkmcnt(0)" ::: "memory"); SBAR(); \
        o[d0] = __builtin_amdgcn_mfma_f32_32x32x16_bf16(pa0, (bf16x8){l0[0], l0[1], l0[2], l0[3], h0[0], h0[1], h0[2], h0[3]}, o[d0], 0, 0, 0);   \
        o[d0] = __builtin_amdgcn_mfma_f32_32x32x16_bf16(pa1, (bf16x8){l1[0], l1[1], l1[2], l1[3], h1[0], h1[1], h1[2], h1[3]}, o[d0], 0, 0, 0);   \
        o[d0] = __builtin_amdgcn_mfma_f32_32x32x16_bf16(pa2, (bf16x8){l2[0], l2[1], l2[2], l2[3], h2[0], h2[1], h2[2], h2[3]}, o[d0], 0, 0, 0);   \
        o[d0] = __builtin_amdgcn_mfma_f32_32x32x16_bf16(pa3, (bf16x8){l3[0], l3[1], l3[2], l3[3], h3[0], h3[1], h3[2], h3[3]}, o[d0], 0, 0, 0); } while (0)
    PV_D0(0); PV_D0(1); PV_D0(2); PV_D0(3);
#undef PV_D0
#undef TRRD
}
struct BlockRef { const bf16* Q; const bf16* K; const bf16* V; bf16* O; const float* CB; int P0, jlo, h; };
struct Seam { bf16x8 qr[8]; bf16x8 st_v0, st_v1, st_k0, st_k1; };
#define LD8(p) (*reinterpret_cast<const bf16x8*>(p))
#define ROWQ(p, k0, rr) ((p) + (size_t)((k0) + (rr)) * LDQ + sc)
#define VMW() asm volatile("s_waitcnt vmcnt(0)" ::: "memory")
#define VMWN(n) asm volatile("s_waitcnt vmcnt(%0)" :: "i"(n) : "memory")
#define SLOAD_H(R, k0, bf) do { const char* kb__ = (const char*)(R).K + (size_t)(k0) * (LDQ * 2); const char* vb__ = (const char*)(R).V + (size_t)(k0) * (LDQ * 2); \
                         S.st_v0 = LD8(vb__ + vo0); S.st_v1 = LD8(vb__ + vo1); S.st_k0 = LD8(kb__ + vo0); S.st_k1 = LD8(kb__ + vo1);  \
                         if (MODE == 1) { if (wid == 0) __builtin_amdgcn_global_load_lds((const unsigned*)((const char*)((R).CB + (k0)) + lane4), (__attribute__((address_space(3))) unsigned*)(lds + OFF_CL + (bf) * 256), 4, 0, 0); } } while (0)
#define SWRITE_HK(bf) do { *(bf16x8*)(K_lds + (bf) * SHM_K + kws) = S.st_k0; *(bf16x8*)(K_lds + (bf) * SHM_K + kws + 32 * KROW) = S.st_k1; } while (0)
#define SWRITE_HV(bf) do { *(bf16x8*)(V_lds + (bf) * SHM_V + vst0) = S.st_v0; *(bf16x8*)(V_lds + (bf) * SHM_V + vst1) = S.st_v1; } while (0)
#define SWRITE_H(bf) do { SWRITE_HV(bf); SWRITE_HK(bf); } while (0)
template <int MODE>
__device__ __forceinline__ void attn_prime(const BlockRef& cur, char* lds, Seam& S) {
    int tid = threadIdx.x; asm volatile("" : "+v"(tid));
    const int wid = __builtin_amdgcn_readfirstlane(tid >> 6), lane = tid & 63, r32 = lane & 31, hi = lane >> 5;
    const int sr = tid >> 4, sc = (tid & 15) * 8, kws = KSWZ(sr, sc * 2); char* K_lds = lds + 2 * SHM_V;
    const int kb0 = cur.jlo * KVBLK;
    const unsigned vo0 = (unsigned)((sr * LDQ + sc) * 2), vo1 = vo0 + 32u * LDQ * 2u, lane4 = (unsigned)lane * 4u, qo = (unsigned)(((wid * QBLK + r32) * LDQ + hi * 8) * 2);
#pragma unroll
    for (int d0 = 0; d0 < 8; ++d0) S.qr[d0] = LD8((const char*)cur.Q + qo + d0 * 32);
    SLOAD_H(cur, kb0, 0); VMW(); SWRITE_HK(0);
    __syncthreads();
}
template <int MODE>
__device__ __forceinline__ void attn_block(const BlockRef& cur, const BlockRef& nxt, char* lds, Seam& S) {
    constexpr bool SK = (MODE == 0);
    int tid = threadIdx.x; asm volatile("" : "+v"(tid));
    const int wid = __builtin_amdgcn_readfirstlane(tid >> 6), lane = tid & 63, r32 = lane & 31, hi = lane >> 5;
    const int j_lo = cur.jlo, j_hi = cur.P0 / KVBLK + QB / KVBLK;
    const int NT = j_hi - j_lo;
    const int kbn = nxt.jlo * KVBLK;
    const int qlo = cur.P0 + wid * QBLK, qm = qlo + r32 - 4 * hi;
    char* V_lds = lds; char* K_lds = lds + 2 * SHM_V;
    float* ws = (float*)(lds + OFF_WS) + wid * 64; float* li_l = ws, * al_l = ws + 32;
    const float* tbh = (const float*)(lds + OFF_TB) + cur.h * 256;
    float m_reg = -1e30f, l_reg = 0; f32x16 o[4] = {};
    const int sr = tid >> 4, sc = (tid & 15) * 8, vst0 = v_st(sr, sc), vst1 = v_st(32 + sr, sc), kws = KSWZ(sr, sc * 2);
    const int vb0 = (int)(uintptr_t)V_lds + v_rd_base(lane);
    const unsigned vo0 = (unsigned)((sr * LDQ + sc) * 2), vo1 = vo0 + 32u * LDQ * 2u, lane4 = (unsigned)lane * 4u, qo = (unsigned)(((wid * QBLK + r32) * LDQ + hi * 8) * 2);
#define RESC(a) do { if (__any((a) < 1.f)) { if (hi == 0) al_l[r32] = (a); asm volatile("s_waitcnt lgkmcnt(0)" ::: "memory");              \
                     for (int d_ = 0; d_ < 4; ++d_) for (int r = 0; r < 16; ++r) o[d_][r] *= al_l[crow(r, hi)]; } } while (0)
#define KBASE(t) ((j_lo + (t)) * KVBLK)
#define ACT(t) (MODE == 0 ? (KBASE(t) <= qlo) : true)
#define MASKT(P0_, P1_, t) do { const int kb_ = KBASE(t);                                                                              \
        if (MODE == 1) { if (kb_ + KVBLK - 1 > qlo) mask_tile(P0_, P1_, qm - kb_, 0x40000000u); }                                       \
        else { if (kb_ <= qlo && kb_ + KVBLK - 1 - qlo >= -90) add_bias(P0_, P1_, tbh, kb_ - qm + 192); } } while (0)
    constexpr int NQL = 8;
#define SEAM_K0() do { VMWN(NQL); SWRITE_HK(0); SBAR(); } while (0)
    f32x16 pA0, pA1, pB0, pB1; float mnA, mnB, alA, alB; bf16x8 pa0, pa1, pa2, pa3;
    SWRITE_HV(0); SBAR();
    if (NT > 1) { SLOAD_H(cur, KBASE(1), 1); }
    SBAR(); qkt<0, SK, MODE>(pA0, pA1, lds, r32, hi, S.qr, ACT(0));
    MASKT(pA0, pA1, 0); partialSM(pA0, pA1, m_reg, mnA, alA);
    if (NT > 1) { VMW(); SWRITE_H(1); }
    __syncthreads();
#define HALF_STEP(PL, PX0, PX1, mnX, alX, PY0, PY1, alY, t, KB, VB, SB) do {                                                  \
        SBAR(); qkt<KB, (SK && !(PL)), MODE>(PX0, PX1, lds, r32, hi, S.qr, ACT(t));                                           \
        finishSM(PY0, PY1, alY, l_reg, pa0, pa1, pa2, pa3); SBAR();                                                           \
        if ((PL) || (t) + 1 < NT) { SLOAD_H(cur, KBASE((t) + 1), SB); SBAR(); }                                               \
        pv_tile<VB, (SK && !(PL))>(o, vb0, pa0, pa1, pa2, pa3, ACT((t) - 1)); if (!(PL)) MASKT(PX0, PX1, (t)); partialSM(PX0, PX1, m_reg, mnX, alX); \
        __syncthreads();                                                                                                      \
        if ((PL) || (t) + 1 < NT) { VMW(); SWRITE_H(SB); }                                                                    \
        RESC(alX); __syncthreads(); } while (0)
    int t = 1;
    { const int NH = NT - (MODE == 0 ? 6 : 4);
      for (; t + 1 < NH; t += 2) {
        HALF_STEP(true, pB0, pB1, mnB, alB, pA0, pA1, alA, t, 1, 0, 0);
        HALF_STEP(true, pA0, pA1, mnA, alA, pB0, pB1, alB, t + 1, 0, 1, 1);
      } }
    for (; t + 1 < NT; t += 2) {
        HALF_STEP(false, pB0, pB1, mnB, alB, pA0, pA1, alA, t, 1, 0, 0);
        HALF_STEP(false, pA0, pA1, mnA, alA, pB0, pB1, alB, t + 1, 0, 1, 1);
    }
    const bool even = (NT & 1) == 0;
    if (even) { SBAR(); qkt<1, SK, MODE>(pB0, pB1, lds, r32, hi, S.qr, ACT(NT - 1)); SBAR(); }
    SLOAD_H(nxt, kbn, 0); SBAR();
#pragma unroll
    for (int d0 = 0; d0 < 8; ++d0) S.qr[d0] = LD8((const char*)nxt.Q + qo + d0 * 32);
    SBAR();
    finishSM(pA0, pA1, alA, l_reg, pa0, pa1, pa2, pa3); SBAR();
    pv_tile<0, SK>(o, vb0, pa0, pa1, pa2, pa3, ACT(even ? NT - 2 : NT - 1));
    if (even) { MASKT(pB0, pB1, NT - 1); partialSM(pB0, pB1, m_reg, mnB, alB); __syncthreads(); RESC(alB);
        finishSM(pB0, pB1, alB, l_reg, pa0, pa1, pa2, pa3); SBAR(); pv_tile<1, SK>(o, vb0, pa0, pa1, pa2, pa3, ACT(NT - 1)); }
    SBAR(); SEAM_K0();
    if (hi == 0) li_l[r32] = l_reg; asm volatile("s_waitcnt lgkmcnt(0)" ::: "memory");
    float rli[16];
#pragma unroll
    for (int r = 0; r < 16; ++r) rli[r] = __builtin_amdgcn_rcpf(li_l[crow(r, hi)]);
    char* Ow = (char*)cur.O; const unsigned oo = (unsigned)(((wid * QBLK + 4 * hi) * LDO + r32) * 2);
#pragma unroll
    for (int r = 0; r < 16; ++r) { const unsigned orow = (unsigned)(((r & 3) + 8 * (r >> 2)) * LDO * 2);
#pragma unroll
        for (int d0 = 0; d0 < 4; ++d0) { const float v = o[d0][r] * rli[r];
            const float vn = __shfl_xor(v, 1);
            if ((r32 & 1) == 0) *(unsigned*)(Ow + (oo + orow + d0 * 64)) = cvtpk(v, vn); } }
    __syncthreads();
#undef RESC
#undef KBASE
#undef ACT
#undef MASKT
#undef SEAM_K0
#undef HALF_STEP
}
#undef ROWQ
#undef VMW
#undef VMWN
#undef SLOAD_H
#undef SWRITE_HK
#undef SWRITE_HV
#undef SWRITE_H
#undef LD8
#undef SBAR
#undef KSWZ
#undef KROW
}
#define GAS __attribute__((address_space(1)))
#define LAS __attribute__((address_space(3)))
typedef unsigned short bf16;
typedef unsigned v4u __attribute__((ext_vector_type(4)));
typedef unsigned v2u __attribute__((ext_vector_type(2)));
typedef float f32x4 __attribute__((ext_vector_type(4)));
constexpr int NWAVES = 8;
constexpr int BATCH = 2, SEQ = 16384, DM = 2048, TOK = BATCH * SEQ, FF = 8192, NQKV = 6144, NQKV1 = 6400, FH = 16;
constexpr float NORM_EPS = 1e-6f, SUBLN_EPS = 1e-5f, LAMBDA_INIT = 0.2f;
constexpr size_t MiB = 1u << 20;
constexpr size_t WS_F = 0, WS_CB = 2 * MiB;
constexpr size_t WS_WQKV0 = 4 * MiB, WS_WOA = 28 * MiB, WS_WMI0 = 36 * MiB, WS_WMO0 = 68 * MiB, WS_WQKV1 = 100 * MiB, WS_WOB = 126 * MiB, WS_WMI1 = 134 * MiB, WS_WMO1 = 166 * MiB;
constexpr size_t WS_NRM = 198 * MiB;
constexpr size_t WS_RS = 198 * MiB + 65536;
constexpr size_t WS_BAR = 199 * MiB;
constexpr size_t WS_HB = 712 * MiB;
constexpr size_t WS_QKV = 200 * MiB;
constexpr size_t WS_OC = 584 * MiB;
constexpr size_t WS_HID = 200 * MiB;
constexpr size_t WS_XN = 840 * MiB;
constexpr size_t WS_END = 968 * MiB;
constexpr int LDS_BYTES = 147456;

__device__ __forceinline__ unsigned char* launder_p(unsigned char* p) { asm volatile("" : "+s"(p)); return p; }
__device__ __forceinline__ unsigned f2bf(float f) { unsigned u = __builtin_bit_cast(unsigned, f); return (u + 0x7fffu + ((u >> 16) & 1u)) >> 16; }
__device__ __forceinline__ unsigned pk2(float lo, float hi) { return f2bf(lo) | (f2bf(hi) << 16); }
__device__ __forceinline__ float bf2f(unsigned short b) { return __builtin_bit_cast(float, (unsigned)b << 16); }
__device__ __forceinline__ float wave_sum(float v) {
#pragma unroll
    for (int o = 1; o < 64; o <<= 1) v += __shfl_xor(v, o);
    return v;
}
__device__ __forceinline__ void transpose_item(const float* W, int K, int N, bf16* WT, int row_off, const float* g, LAS float* scr, int item, int lane) {
    const int nblk = N / 32, kb = item / nblk, nb = item % nblk, k0 = 64 * kb, n0 = 32 * nb;
#pragma unroll 8
    for (int i = 0; i < 32; ++i) { const int kk = 2 * i + (lane >> 5); float v = W[(size_t)(k0 + kk) * N + n0 + (lane & 31)]; if (g) v *= g[k0 + kk]; scr[kk * 33 + (lane & 31)] = v; }
    asm volatile("s_waitcnt lgkmcnt(0)" ::: "memory");
    const int c = lane & 7;
#pragma unroll
    for (int j = 0; j < 4; ++j) { const int n = (lane >> 3) + 8 * j; const LAS float* s = scr + (8 * c) * 33 + n;
        v4u o; o.x = pk2(s[0 * 33], s[1 * 33]); o.y = pk2(s[2 * 33], s[3 * 33]); o.z = pk2(s[4 * 33], s[5 * 33]); o.w = pk2(s[6 * 33], s[7 * 33]);
        *(v4u*)(WT + (size_t)(row_off + n0 + n) * K + k0 + 8 * c) = o; }
    asm volatile("s_waitcnt lgkmcnt(0)" ::: "memory");
}
__device__ __forceinline__ void norm_row_to_bf16(const float* xrow, bf16* orow, int lane) {
    const f32x4* xr = (const f32x4*)xrow + lane;
    f32x4 v[8]; float s = 0.f;
#pragma unroll
    for (int j = 0; j < 8; ++j) { v[j] = xr[64 * j]; s += (v[j].x * v[j].x + v[j].y * v[j].y) + (v[j].z * v[j].z + v[j].w * v[j].w); }
    const float rstd = 1.f / sqrtf(wave_sum(s) * (1.f / DM) + NORM_EPS);
    v2u* o8 = (v2u*)orow + lane;
#pragma unroll
    for (int j = 0; j < 8; ++j) { v2u w; w.x = pk2(v[j].x * rstd, v[j].y * rstd); w.y = pk2(v[j].z * rstd, v[j].w * rstd); o8[64 * j] = w; }
}
__device__ __forceinline__ void norm_phase(const float* src, bf16* dst, int gw, int NGW, int lane) {
    for (int m = gw; m < TOK; m += NGW) norm_row_to_bf16(src + (size_t)m * DM, dst + (size_t)m * DM, lane);
}
__device__ __forceinline__ void final_norm_phase(float* io, const float* g, const float* rs, int gw, int NGW, int lane) {
    for (int m = gw; m < TOK; m += NGW) {
        f32x4* xr = (f32x4*)(io + (size_t)m * DM) + lane; const f32x4* gr = (const f32x4*)g + lane;
        const float rstd = 1.f / sqrtf(rs[m] * (1.f / DM) + NORM_EPS);
#pragma unroll
        for (int j = 0; j < 8; ++j) xr[64 * j] = xr[64 * j] * rstd * gr[64 * j];
    }
}
__device__ __forceinline__ void combine_phase(const bf16* OC, bf16* O, const float* lq1, const float* lk1, const float* lq2, const float* lk2, const float* sg, int gw, int NGW, int lane) {
    const float s1 = wave_sum(lq1[lane] * lk1[lane] + lq1[lane + 64] * lk1[lane + 64]), s2 = wave_sum(lq2[lane] * lk2[lane] + lq2[lane + 64] * lk2[lane + 64]);
    const float lam = expf(s1) - expf(s2) + LAMBDA_INIT;
    float gs[8];
#pragma unroll
    for (int e = 0; e < 8; ++e) gs[e] = sg[(lane & 31) * 8 + e] * (1.f - LAMBDA_INIT);
    for (int m = gw; m < TOK; m += NGW) {
        const v4u* a = (const v4u*)(OC + (size_t)m * DM) + lane; const v4u* b = (const v4u*)(OC + (size_t)TOK * DM + (size_t)m * DM) + lane; v4u* o = (v4u*)(O + (size_t)m * DM) + lane;
#pragma unroll
        for (int st = 0; st < 4; ++st) { const v4u av = a[64 * st], bv = b[64 * st]; float d[8]; float ss = 0.f;
#pragma unroll
            for (int e = 0; e < 4; ++e) { const unsigned aw = av[e], bw = bv[e];
                d[2 * e] = __builtin_bit_cast(float, aw << 16) - lam * __builtin_bit_cast(float, bw << 16);
                d[2 * e + 1] = __builtin_bit_cast(float, aw & 0xffff0000u) - lam * __builtin_bit_cast(float, bw & 0xffff0000u);
                ss += d[2 * e] * d[2 * e] + d[2 * e + 1] * d[2 * e + 1]; }
#pragma unroll
            for (int of = 1; of < 32; of <<= 1) ss += __shfl_xor(ss, of);
            const float rstd = 1.f / sqrtf(ss * (1.f / 256.f) + SUBLN_EPS);
            v4u w; w.x = pk2(d[0] * rstd * gs[0], d[1] * rstd * gs[1]); w.y = pk2(d[2] * rstd * gs[2], d[3] * rstd * gs[3]);
            w.z = pk2(d[4] * rstd * gs[4], d[5] * rstd * gs[5]); w.w = pk2(d[6] * rstd * gs[6], d[7] * rstd * gs[7]); o[64 * st] = w; }
    }
}
__device__ __forceinline__ void cumsum_phase(const float* F, const float* bfb, float* CB, LAS unsigned char* lds, int bx, int G, int tid) {
    LAS double* sc = (LAS double*)lds;
    for (int bh = bx; bh < BATCH * FH; bh += G) {
        const int b = bh / FH, h = bh % FH; const float bias = bfb[h];
        const float* fp = F + ((size_t)b * SEQ + (size_t)tid * 32) * FH + h;
        float ls[32]; double run = 0.0;
#pragma unroll
        for (int i = 0; i < 32; ++i) { const float x = fp[(size_t)i * FH] + bias; ls[i] = fminf(x, 0.f) - log1pf(expf(-fabsf(x))); run += (double)ls[i]; }
        sc[tid] = run; __syncthreads();
        int cur = 0;
        for (int of = 1; of < 512; of <<= 1) { double v = sc[cur * 512 + tid]; if (tid >= of) v += sc[cur * 512 + tid - of]; sc[(cur ^ 1) * 512 + tid] = v; cur ^= 1; __syncthreads(); }
        double acc = sc[cur * 512 + tid] - run;
        float* op = CB + (size_t)bh * SEQ + (size_t)tid * 32;
#pragma unroll
        for (int i = 0; i < 32; ++i) { acc += (double)ls[i]; op[i] = (float)(-acc * 11.313708498984761); }
        __syncthreads();
    }
}

__device__ __forceinline__ void rownorm_phase(const bf16* QKV, unsigned* NRM, int bx, int G, int tid) {
    for (int vw = bx; vw < 256; vw += G) {
        const int bh = vw >> 3, part = vw & 7, b = bh >> 4, h = bh & 15;
        const char* base = (const char*)(QKV + ((size_t)b * SEQ + (size_t)part * 2048) * NQKV + h * 128);
        const unsigned vo = (unsigned)(((tid >> 4) * NQKV + (tid & 15) * 8) * 2);
        float mq = 0.f, mk = 0.f;
#pragma unroll 4
        for (int it = 0; it < 64; ++it) {
            const char* rp = base + (size_t)it * 32 * NQKV * 2;
            const v4u qv = *(const v4u*)(rp + vo), kv = *(const v4u*)(rp + vo + 2048 * 2);
            float sq = 0.f, sk = 0.f;
#pragma unroll
            for (int e = 0; e < 4; ++e) { const float a0 = __builtin_bit_cast(float, qv[e] << 16), a1 = __builtin_bit_cast(float, qv[e] & 0xffff0000u), b0 = __builtin_bit_cast(float, kv[e] << 16), b1 = __builtin_bit_cast(float, kv[e] & 0xffff0000u);
                sq += a0 * a0 + a1 * a1; sk += b0 * b0 + b1 * b1; }
#pragma unroll
            for (int of = 1; of < 16; of <<= 1) { sq += __shfl_xor(sq, of); sk += __shfl_xor(sk, of); }
            mq = fmaxf(mq, sq); mk = fmaxf(mk, sk);
        }
        mq = fmaxf(mq, __shfl_xor(mq, 16)); mq = fmaxf(mq, __shfl_xor(mq, 32)); mk = fmaxf(mk, __shfl_xor(mk, 16)); mk = fmaxf(mk, __shfl_xor(mk, 32));
        if ((tid & 63) == 0) { atomicMax(NRM + bh * 2, __float_as_uint(mq)); atomicMax(NRM + bh * 2 + 1, __float_as_uint(mk)); }
    }
}

#define XB_TMO      128
#define XB_XCNT(j)  (256  + 64 * (j))
#define XB_XSUB(j)  (1280 + 64 * (j))
#define XB_XGEN(j)  (2304 + 64 * (j))
#define XB_TOP      3328
#define XB_TOPGEN   3392
#define XCD_BAR_WORDS 3456
#define XB_SPIN_CAP (1u << 18)

__device__ __forceinline__ unsigned xb_ld(unsigned* p)              { return __hip_atomic_load(p, __ATOMIC_RELAXED, __HIP_MEMORY_SCOPE_AGENT); }
__device__ __forceinline__ unsigned xb_add(unsigned* p, unsigned v) { return __hip_atomic_fetch_add(p, v, __ATOMIC_RELAXED, __HIP_MEMORY_SCOPE_AGENT); }
__device__ __forceinline__ unsigned xb_xcc_id() { return (unsigned)__builtin_amdgcn_s_getreg((3 << 11) | 20) & 0xFu; }
#define XB_SPIN(cond, bar) do { unsigned _sp = 0; while (cond) { __builtin_amdgcn_s_sleep(1); \
    if ((++_sp & 255u) == 0u) { if (xb_ld(&(bar)[XB_TMO])) break; if (_sp > XB_SPIN_CAP) { atomicAdd(&(bar)[XB_TMO], 1u); break; } } } } while (0)

struct XcdBarrier {
    unsigned* bar; unsigned x;
    volatile LAS unsigned* st;
};

__device__ __forceinline__ XcdBarrier xcd_barrier_post(unsigned* bar, volatile LAS unsigned* st) {
    XcdBarrier b; b.bar = bar; b.x = xb_xcc_id(); b.st = st;
    if (threadIdx.x == 0) (void)xb_add(&bar[XB_XCNT(b.x)], 1u);
    return b;
}
__device__ __forceinline__ void xcd_barrier_complete(unsigned* bar, unsigned x, unsigned& nloc, unsigned& nx) {
    const unsigned G = gridDim.x * gridDim.y * gridDim.z;
    unsigned sum, cnt, mine, sp = 0u;
    for (;;) {
        sum = 0u; cnt = 0u; mine = 0u;
#pragma unroll
        for (unsigned j = 0; j < 16; ++j) { const unsigned c = xb_ld(&bar[XB_XCNT(j)]); sum += c; cnt += (c > 0u) ? 1u : 0u; mine = (j == x) ? c : mine; }
        if (sum == G) break;
        __builtin_amdgcn_s_sleep(1);
        if ((++sp & 255u) == 0u) { if (xb_ld(&bar[XB_TMO])) break; if (sp > XB_SPIN_CAP) { atomicAdd(&bar[XB_TMO], 1u); break; } }
    }
    nloc = mine > 0u ? mine : 1u; nx = cnt > 0u ? cnt : 1u;
}

__device__ __forceinline__ void xcd_barrier(const XcdBarrier& b) {
    asm volatile("s_waitcnt vmcnt(0)" ::: "memory");
    __syncthreads();
    if (threadIdx.x == 0) {
        unsigned* bar = b.bar;
        __builtin_amdgcn_s_waitcnt(0);
        unsigned nloc = b.st[0], nx = b.st[1];
        if (nloc == 0u) { xcd_barrier_complete(bar, b.x, nloc, nx); b.st[0] = nloc; b.st[1] = nx; }
        const unsigned old = xb_add(&bar[XB_XSUB(b.x)], 1u);
        const unsigned gen = old / nloc;
        if (old + 1u == (gen + 1u) * nloc) {
            __builtin_amdgcn_fence(__ATOMIC_RELEASE, "agent");
            asm volatile("s_waitcnt vmcnt(0)" ::: "memory");
            const unsigned og = xb_add(&bar[XB_TOP], 1u);
            const unsigned tg = og / nx;
            if (og + 1u == (tg + 1u) * nx) xb_add(&bar[XB_TOPGEN], 1u);
            else XB_SPIN(xb_ld(&bar[XB_TOPGEN]) == tg, bar);
            __builtin_amdgcn_fence(__ATOMIC_ACQUIRE, "agent");
            xb_add(&bar[XB_XGEN(b.x)], 1u);
            asm volatile("s_waitcnt vmcnt(0)" ::: "memory");
        } else {
            XB_SPIN(xb_ld(&bar[XB_XGEN(b.x)]) == gen, bar);
            __builtin_amdgcn_fence(__ATOMIC_ACQUIRE, "agent");
            asm volatile("s_waitcnt vmcnt(0)" ::: "memory");
        }
    }
    __syncthreads();
}

struct Args { const float* in[21]; float* out; unsigned char* ws; };
template <int MODE> __device__ __forceinline__ bool attn_item(int i, int G, int bx, int& s, int& x) {
    constexpr int NS = MODE == 0 ? 64 : 32;
    if ((G & 7) == 0) { const int xcd = bx & 7, k = bx >> 3, kpx = G >> 3; const int idx = k + i * kpx; if (idx >= (NS / 8) * 32) return false; s = (idx >> 5) * 8 + xcd; x = idx & 31; return true; }
    const int L = bx + i * G; if (L >= NS * 32) return false; s = L >> 5; x = L & 31; return true;
}
template <int MODE> __device__ __forceinline__ att::BlockRef attn_ref(int s, int qb, int jlo, const bf16* QKV, bf16* Obuf, const float* CB) {
    att::BlockRef r; r.P0 = qb * 256; r.jlo = jlo;
    if (MODE == 0) { const int xcd = s & 7, sl = s >> 3, vh = sl & 1, c = (sl >> 1) & 1, bh = xcd * 2 + ((sl >> 2) & 1), b = bh >> 3, h = bh & 7;
        const bf16* base = QKV + (size_t)b * SEQ * NQKV;
        r.Q = base + (size_t)r.P0 * NQKV + h * 256 + c * 128; r.K = base + 2048 + h * 256 + c * 128; r.V = base + 4096 + h * 256 + vh * 128;
        r.O = Obuf + (size_t)c * TOK * DM + ((size_t)b * SEQ + r.P0) * DM + h * 256 + vh * 128; r.CB = nullptr; r.h = h; }
    else { const int b = s >> 4, h = s & 15; const bf16* base = QKV + (size_t)b * SEQ * NQKV;
        r.Q = base + (size_t)r.P0 * NQKV + h * 128; r.K = base + 2048 + h * 128; r.V = base + 4096 + h * 128;
        r.O = Obuf + ((size_t)b * SEQ + r.P0) * DM + h * 128; r.CB = CB + (size_t)s * SEQ; r.h = 0; }
    return r;
}
template <int MODE> __device__ __forceinline__ void attn_phase(char* lds, const bf16* QKV, bf16* Obuf, const float* CB, const unsigned* NRM, int G, int bx) {
    int* jt = (int*)(lds + att::OFF_TB);
    if (MODE == 1) {
        int tid = threadIdx.x; asm volatile("" : "+v"(tid)); const int w = __builtin_amdgcn_readfirstlane(tid >> 6), lane = tid & 63;
        if (tid < 64) jt[tid] = 0;
        __syncthreads();
        for (int e = w; e < 64; e += 8) { int s, x; if (!attn_item<MODE>(e >> 1, G, bx, s, x)) break;
            const int qb = (e & 1) ? 63 - x : x, jmax = qb * 4; const float* cb = CB + (size_t)s * SEQ;
            const float qn = sqrtf(__uint_as_float(NRM[s * 2])) * 1.01f, kn = sqrtf(__uint_as_float(NRM[s * 2 + 1])) * 1.01f;
            const float thr = cb[qb * 256] - 110.f * 11.313708498984761f - 2.f * qn * kn;
            int need = 0;
            for (int j0 = jmax - 1; j0 >= 0; j0 -= 64) { const int j = j0 - lane; const bool c = (j >= 0) && (cb[(j >= 0 ? j : 0) * 64 + 63] >= thr);
                const unsigned long long m = __ballot(c); const int n = __builtin_popcountll(m); need += n; if (n < 64) break; }
            if (lane == 0) jt[e] = jmax - need; }
        __syncthreads();
    }
    int i = 0, pass = 0, s = 0, x = 0;
    if (!attn_item<MODE>(0, G, bx, s, x)) return;
    att::BlockRef cur = attn_ref<MODE>(s, x, (MODE == 1) ? jt[0] : 0, QKV, Obuf, CB);
    att::Seam S;
    att::attn_prime<MODE>(cur, lds, S);
    for (;;) {
        int sn = s, xn = x, in = i, passn = pass + 1; bool last = false;
        if (pass == 1) { passn = 0; in = i + 1; if (!attn_item<MODE>(in, G, bx, sn, xn)) last = true; }
        const int jl = (MODE == 1 && in < 32) ? jt[in * 2 + passn] : 0;
        const att::BlockRef nxt = last ? cur : attn_ref<MODE>(sn, passn ? 63 - xn : xn, jl, QKV, Obuf, CB);
        att::attn_block<MODE>(cur, nxt, lds, S);
        if (last) break;
        cur = nxt; s = sn; x = xn; i = in; pass = passn;
    }
}

__global__ void __launch_bounds__(NWAVES * 64, 2) yoco_fwd(Args args) {
    extern __shared__ __attribute__((aligned(16))) unsigned char lds[];
    cg::grid_group grid = cg::this_grid();
    LAS unsigned char* ldsl = (LAS unsigned char*)lds;
    const int G = gridDim.x, bx = blockIdx.x, NGW = G * NWAVES;
    int tid, lane, wave, gw;
#define FRESH() do { tid = threadIdx.x; asm volatile("" : "+v"(tid)); lane = tid & 63; wave = __builtin_amdgcn_readfirstlane(tid >> 6); gw = bx * NWAVES + wave; } while (0)
    FRESH();
#define WSP(T, off) ((T*)(launder_p(args.ws) + (off)))
#define Wqkv0 WSP(bf16, WS_WQKV0)
#define Woa WSP(bf16, WS_WOA)
#define Wmi0 WSP(bf16, WS_WMI0)
#define Wmo0 WSP(bf16, WS_WMO0)
#define Wqkv1 WSP(bf16, WS_WQKV1)
#define Wob WSP(bf16, WS_WOB)
#define Wmi1 WSP(bf16, WS_WMI1)
#define Wmo1 WSP(bf16, WS_WMO1)
#define QKV WSP(bf16, WS_QKV)
#define OC WSP(bf16, WS_OC)
#define HID WSP(bf16, WS_HID)
#define XN WSP(bf16, WS_XN)
#define Fb WSP(float, WS_F)
#define CB WSP(float, WS_CB)
#define NRM WSP(unsigned, WS_NRM)
#define RS WSP(float, WS_RS)
#define HB WSP(bf16, WS_HB)
#define out ((float*)launder_p((unsigned char*)args.out))
#define XIN ((const float*)launder_p((unsigned char*)args.in[0]))
    volatile LAS unsigned* xst = (volatile LAS unsigned*)(ldsl + LDS_BYTES - 64);
    if (tid < 2) xst[tid] = 0u;
    __syncthreads();
    const XcdBarrier xbar = xcd_barrier_post(WSP(unsigned, WS_BAR), xst);

    {
        LAS float* scr = (LAS float*)(ldsl + wave * 16384);
        bf16* const wqkv1 = Wqkv1;
        const float* ag = args.in[2]; const float* mg = args.in[3]; const float* kg = args.in[11];
        constexpr int I_QKV = (DM / 64) * (NQKV / 32), I_DD = (DM / 64) * (DM / 32), I_MI = (DM / 64) * (FF / 32), I_MO = (FF / 64) * (DM / 32);
        constexpr int NITEMS = I_QKV + 5 * I_DD + 2 * I_MI + 2 * I_MO;
        for (int it = gw; it < NITEMS; it += NGW) {
            int r = it;
            if (r < I_QKV) { transpose_item(args.in[4], DM, NQKV, Wqkv0, 0, ag, scr, r, lane); continue; } r -= I_QKV;
            if (r < I_DD) { transpose_item(args.in[10], DM, DM, Woa, 0, nullptr, scr, r, lane); continue; } r -= I_DD;
            if (r < I_DD) { transpose_item(args.in[16], DM, DM, wqkv1, 0, ag + DM, scr, r, lane); continue; } r -= I_DD;
            if (r < I_DD) { transpose_item(args.in[12], DM, DM, wqkv1, DM, kg, scr, r, lane); continue; } r -= I_DD;
            if (r < I_DD) { transpose_item(args.in[13], DM, DM, wqkv1, 2 * DM, kg, scr, r, lane); continue; } r -= I_DD;
            if (r < I_DD) { transpose_item(args.in[17], DM, DM, Wob, 0, nullptr, scr, r, lane); continue; } r -= I_DD;
            if (r < I_MI) { transpose_item(args.in[18], DM, FF, Wmi0, 0, mg, scr, r, lane); continue; } r -= I_MI;
            if (r < I_MI) { transpose_item(args.in[18] + (size_t)DM * FF, DM, FF, Wmi1, 0, mg + DM, scr, r, lane); continue; } r -= I_MI;
            if (r < I_MO) { transpose_item(args.in[19], FF, DM, Wmo0, 0, nullptr, scr, r, lane); continue; } r -= I_MO;
            transpose_item(args.in[19] + (size_t)FF * DM, FF, DM, Wmo1, 0, nullptr, scr, r, lane);
        }
        { const float* wf = args.in[14]; const int gt = bx * 512 + tid, NT_ = G * 512;
          for (int e = gt; e < (NQKV1 - NQKV) * DM; e += NT_) { const int n = e / DM, k = e % DM; wqkv1[(size_t)(NQKV + n) * DM + k] = (n < FH) ? (bf16)f2bf(wf[(size_t)k * FH + n] * kg[k]) : (bf16)0; } }
        if (bx == 0 && tid < 64) NRM[tid] = 0u;
        { float* rsz = RS; for (int e = bx * 512 + tid; e < 4 * TOK; e += G * 512) rsz[e] = 0.f; }
        norm_phase(XIN, XN, gw, NGW, lane);
    }
    grid.sync();
#define GSYNC() xcd_barrier(xbar)
#define GEMM_PHASE(EPI, A_, B_, N_, K_, ...) do { pg8::Gemm g{A_, B_, TOK, N_, K_}; pg8::StaticOrder S; S.init(TOK, N_, G, bx); EPI E{__VA_ARGS__}; \
        pg8::gemm_phase<EPI, pg8::StaticOrder, PG8_ALIGN, PG8_SP2>(ldsl, g, S, E); } while (0)
    typedef pg8::EpiX<0, false, false, false> EpiQKV0; typedef pg8::EpiX<3, true, false, false> EpiQKV1; typedef pg8::EpiX<1, true, false, false> EpiMlpIn;
    typedef pg8::EpiX<2, false, true, true> EpiRes; typedef pg8::EpiX<2, false, false, true> EpiResLast;
    GEMM_PHASE(EpiQKV0, XN, Wqkv0, NQKV, DM, QKV, NQKV, nullptr, nullptr, nullptr, nullptr, nullptr);
    GSYNC();
    {
      FRESH(); const float* tab = args.in[1]; float* tb = (float*)(lds + att::OFF_TB);
      for (int idx = tid; idx < 2048; idx += 512) { const int h = idx >> 8, rel = (idx & 255) - 192; const int n = rel < 0 ? -rel : rel;
          int bk = n < 8 ? n : 8 + (n >= 12) + (n >= 16) + (n >= 23) + (n >= 32) + (n >= 46) + (n >= 64) + (n >= 91); if (rel > 0) bk += 16;
          tb[idx] = (tab[bk * 8 + h] - tab[15 * 8 + h]) * 11.313708498984761f; }
      __syncthreads();
      attn_phase<0>((char*)lds, QKV, OC, nullptr, nullptr, G, bx);
    }
    GSYNC();
    FRESH(); combine_phase(OC, XN, args.in[5], args.in[6], args.in[7], args.in[8], args.in[9], gw, NGW, lane);
    GSYNC();
    GEMM_PHASE(EpiRes, XN, Woa, DM, DM, HB, DM, XIN, out, nullptr, nullptr, RS);
    GSYNC();
    GEMM_PHASE(EpiMlpIn, HB, Wmi0, FF, DM, HID, FF, nullptr, nullptr, nullptr, RS, nullptr);
    GSYNC();
    GEMM_PHASE(EpiRes, HID, Wmo0, DM, FF, XN, DM, out, out, nullptr, nullptr, RS + TOK);
    GSYNC();
    GEMM_PHASE(EpiQKV1, XN, Wqkv1, NQKV1, DM, QKV, NQKV, nullptr, nullptr, Fb, RS + TOK, nullptr);
    GSYNC();
    FRESH(); cumsum_phase(Fb, args.in[15], CB, ldsl, bx, G, tid);
    rownorm_phase(QKV, NRM, bx, G, tid);
    GSYNC();
    attn_phase<1>((char*)lds, QKV, XN, CB, NRM, G, bx);
    GSYNC();
    GEMM_PHASE(EpiRes, XN, Wob, DM, DM, HB, DM, out, out, nullptr, nullptr, RS + 2 * TOK);
    GSYNC();
    GEMM_PHASE(EpiMlpIn, HB, Wmi1, FF, DM, HID, FF, nullptr, nullptr, nullptr, RS + 2 * TOK, nullptr);
    GSYNC();
    GEMM_PHASE(EpiResLast, HID, Wmo1, DM, FF, nullptr, DM, out, out, nullptr, nullptr, RS + 3 * TOK);
    GSYNC();
    FRESH(); final_norm_phase(out, args.in[20], RS + 3 * TOK, gw, NGW, lane);
}

#undef out
#undef XIN
extern "C" void kernel_launch(void* const* d_in, const int* in_sizes, int n_in, void* d_out, int out_size, void* d_ws, size_t ws_size, hipStream_t stream) {
    static int grid = 0;
    if (grid == 0) {
        if (n_in != 21 || in_sizes[0] != TOK * DM || out_size != TOK * DM || ws_size < WS_END) { fprintf(stderr, "kernel_launch: unexpected shapes (n_in %d, in0 %d, out %d, ws %zu)\n", n_in, n_in > 0 ? in_sizes[0] : -1, out_size, ws_size); grid = -1; return; }
        int dev = 0, cus = 0, per_cu = 0;
        (void)hipGetDevice(&dev); (void)hipDeviceGetAttribute(&cus, hipDeviceAttributeMultiprocessorCount, dev);
        if (hipFuncSetAttribute((const void*)yoco_fwd, hipFuncAttributeMaxDynamicSharedMemorySize, LDS_BYTES) != hipSuccess) { fprintf(stderr, "kernel_launch: hipFuncSetAttribute failed\n"); grid = -1; return; }
        if (hipOccupancyMaxActiveBlocksPerMultiprocessor(&per_cu, (const void*)yoco_fwd, NWAVES * 64, LDS_BYTES) != hipSuccess || per_cu < 1) { fprintf(stderr, "kernel_launch: occupancy query gives %d\n", per_cu); per_cu = 1; }
        (void)hipGetLastError();
        grid = cus > 0 ? cus : 256;
    }
    if (grid < 0) return;
    if (hipMemsetAsync((char*)d_ws + WS_BAR, 0, 16384, stream) != hipSuccess) { fprintf(stderr, "kernel_launch: hipMemsetAsync failed\n"); return; }
    Args a{};
    for (int i = 0; i < 21; ++i) a.in[i] = (const float*)d_in[i];
    a.out = (float*)d_out; a.ws = (unsigned char*)d_ws;
    void* kargs[] = {&a};
    hipError_t e = hipLaunchCooperativeKernel((const void*)yoco_fwd, dim3(grid), dim3(NWAVES * 64), kargs, LDS_BYTES, stream);
    if (e != hipSuccess) fprintf(stderr, "kernel_launch: cooperative launch failed: %s (grid %d)\n", hipGetErrorString(e), grid);
}
```

```cpp
#include <hip/hip_runtime.h>
#include <hip/hip_cooperative_groups.h>
#include <cstdio>
#include <cstdint>
namespace cg = cooperative_groups;
namespace pg8 {
#define PG8_LAS __attribute__((address_space(3)))
typedef unsigned short bf16_t;
typedef short bf16x8 __attribute__((ext_vector_type(8)));
typedef float f32x4 __attribute__((ext_vector_type(4)));
typedef unsigned u32x4 __attribute__((ext_vector_type(4)));
constexpr int BM = 256, BK = 64, HALF = 128, HTB = HALF * BK * 2  , STAGE_BYTES = 8 * HTB, NXCD = 8, WGM = 8;

__host__ __device__ __forceinline__ int lds_byte(int r, int c) { const int st = (r >> 4) * 2 + (c >> 5), rr = r & 15, cc = c & 31, ob = rr * 64 + cc * 2; return st * 1024 + (ob ^ (((ob >> 9) & 1) << 5)); }
__host__ __device__ __forceinline__ void stage_rc(int b, int& R, int& C) { const int st = b / 1024, sb = b % 1024, swz = sb ^ (((sb >> 9) & 1) << 5); R = (st >> 1) * 16 + swz / 64; C = (st & 1) * 32 + (swz % 64) / 2; }
__host__ __device__ __forceinline__ int perm32(int rho) { const int n = rho >> 4, i = rho & 15; return 8 * (i >> 2) + 4 * n + (i & 3); }

struct Unit { int pm, pn; };
struct Gemm { const bf16_t* A; const bf16_t* Bt; int M, N, K; };

struct StaticOrder {
    int nM, nN, nwg, G, c;
    __host__ __device__ void init(int M, int N, int G_, int c_) { nM = M / BM; nN = N / BM; nwg = nM * nN; G = G_; c = c_; }
    __host__ __device__ bool next(int i, Unit& u) const {
        const long L = (long)i * G + c; if (L >= nwg) return false;
        int wgid = (int)L; { const int q = nwg / NXCD, r = nwg % NXCD, xcd = wgid % NXCD, off = wgid / NXCD; wgid = (xcd < r ? xcd * (q + 1) : r * (q + 1) + (xcd - r) * q) + off; }
        const int nig = WGM * nN, gid = wgid / nig, fm = gid * WGM, gsz = (nM - fm) < WGM ? (nM - fm) : WGM;
        u.pm = fm + ((wgid % nig) % gsz); u.pn = (wgid % nig) / gsz; return true;
    }
    __device__ __forceinline__ void a_ready(const Unit&) const {}
    __device__ __forceinline__ void done(const Unit&) const {}
};

__device__ __forceinline__ unsigned cvt_pk_bf16(float lo, float hi) { unsigned r; asm volatile("v_cvt_pk_bf16_f32 %0, %1, %2" : "=v"(r) : "v"(lo), "v"(hi)); return r; }
typedef float f32x2 __attribute__((ext_vector_type(2)));
template <int MODE, bool RS_IN, bool COPY, bool SUMSQ> struct EpiX {
    static constexpr bool PERM = true, AFTER_DRAIN = false;
    bf16_t* O; int ldc; const float* base; float* out; float* F; const float* rs_in; float* rs_out;
    __device__ __forceinline__ void operator()(const f32x4 (&acc)[2][2][4][2], const Unit& u, int wr, int wc, int fr, int fq) const {
        const int row0 = u.pm * BM + wr * 64 + fr, col0 = u.pn * BM + wc * 32 + 8 * fq;
        const bool ftile = (MODE == 3) && (u.pn * BM >= 6144);
#pragma unroll
        for (int ai = 0; ai < 2; ++ai)
#pragma unroll
            for (int m = 0; m < 4; ++m) { const size_t row = (size_t)(row0 + ai * HALF + m * 16);
                float rs = 1.f; if (RS_IN) rs = 1.f / sqrtf(rs_in[row] * (1.f / 2048.f) + 1e-6f);
                float ss = 0.f;
#pragma unroll
                for (int bj = 0; bj < 2; ++bj) { f32x4 v0 = acc[ai][bj][m][0], v1 = acc[ai][bj][m][1]; const int col = col0 + bj * HALF;
                    if (RS_IN) { v0 = v0 * rs; v1 = v1 * rs; }
                    if (MODE == 2) { const float* bp = base + row * ldc + col; float* op = out + row * ldc + col;
                        const f32x4 b0 = *(const f32x4*)bp, b1 = *(const f32x4*)(bp + 4); v0 = b0 + v0; v1 = b1 + v1; *(f32x4*)op = v0; *(f32x4*)(op + 4) = v1;
                        if (SUMSQ) ss += (v0[0] * v0[0] + v0[1] * v0[1]) + (v0[2] * v0[2] + v0[3] * v0[3]) + (v1[0] * v1[0] + v1[1] * v1[1]) + (v1[2] * v1[2] + v1[3] * v1[3]);
                        if (COPY) { u32x4 w; w.x = cvt_pk_bf16(v0[0], v0[1]); w.y = cvt_pk_bf16(v0[2], v0[3]); w.z = cvt_pk_bf16(v1[0], v1[1]); w.w = cvt_pk_bf16(v1[2], v1[3]); *(u32x4*)(O + row * ldc + col) = w; } }
                    else if (ftile) { if (bj == 0 && wc == 0 && fq < 2) { float* fp = F + row * 16 + 8 * fq; *(f32x4*)fp = v0; *(f32x4*)(fp + 4) = v1; } }
                    else { if (MODE == 1) {
#pragma unroll
                            for (int e = 0; e < 4; ++e) { const float a = fmaxf(v0[e], 0.f), b = fmaxf(v1[e], 0.f); v0[e] = a * a; v1[e] = b * b; } }
                        u32x4 w; w.x = cvt_pk_bf16(v0[0], v0[1]); w.y = cvt_pk_bf16(v0[2], v0[3]); w.z = cvt_pk_bf16(v1[0], v1[1]); w.w = cvt_pk_bf16(v1[2], v1[3]);
                        *(u32x4*)(O + row * ldc + col) = w; } }
                if (SUMSQ) { ss += __shfl_xor(ss, 16); ss += __shfl_xor(ss, 32); if (fq == 0) atomicAdd(rs_out + row, ss); }
                if (MODE == 2) asm volatile("" ::: "memory"); }
    }
};
template <class Epi, class Sched, bool ALIGN_EPI = false, bool SP2 = false>
__device__ __forceinline__ void gemm_phase(PG8_LAS unsigned char* lds, const Gemm g, const Sched& S, const Epi& E) {
    int tid = threadIdx.x; asm volatile("" : "+v"(tid));
    const int wid = __builtin_amdgcn_readfirstlane(tid >> 6), lane = tid & 63, wr = wid >> 2, wc = wid & 3, fr = lane & 15, fq = lane >> 4;
    const int K = g.K, nt = K / BK;
    unsigned voffA[2], voffB[2];
#pragma unroll
    for (int i = 0; i < 2; ++i) { int R, C; stage_rc(tid * 16 + i * 8192, R, C); const int Rb = Epi::PERM ? ((R & ~31) + perm32(R & 31)) : R;
        voffA[i] = (unsigned)(R * K + C) * 2u; voffB[i] = (unsigned)(Rb * K + C) * 2u; }
    const size_t kstep = (size_t)(BK * 2);
    const size_t hstep = (size_t)HALF * K * 2;
    const size_t tstep = 2 * hstep;
    const unsigned ldsw = (unsigned)wid * 1024u;
    const int aoff = lds_byte(wr * 64 + fr, fq * 8), boff = lds_byte(wc * 32 + fr, fq * 8);
#define PG8_SA(b, h) (((b) * 2 + (h)) * HTB)
#define PG8_SB(b, h) ((4 + (b) * 2 + (h)) * HTB)
#define PG8_STAGE(bufoff, gbase, voff) do { _Pragma("unroll") for (int _i = 0; _i < 2; ++_i) \
        __builtin_amdgcn_global_load_lds((const unsigned*)((const char*)(gbase) + (voff)[_i]), (PG8_LAS unsigned*)(lds + (bufoff) + ldsw + _i * 8192), 16, 0, 0); } while (0)
#define PG8_LDA(dst, b, h) do { _Pragma("unroll") for (int m = 0; m < 4; ++m) _Pragma("unroll") for (int k = 0; k < 2; ++k) dst[m][k] = *(const PG8_LAS bf16x8*)(lds + PG8_SA(b, h) + aoff + m * 2048 + k * 1024); } while (0)
#define PG8_LDB(dst, b, h) do { _Pragma("unroll") for (int n = 0; n < 2; ++n) _Pragma("unroll") for (int k = 0; k < 2; ++k) dst[n][k] = *(const PG8_LAS bf16x8*)(lds + PG8_SB(b, h) + boff + n * 2048 + k * 1024); } while (0)
#define PG8_MMA(ai, bj, At, Bt) do { __builtin_amdgcn_s_setprio(1); _Pragma("unroll") for (int m = 0; m < 4; ++m) _Pragma("unroll") for (int n = 0; n < 2; ++n) _Pragma("unroll") for (int k = 0; k < 2; ++k) \
        acc[ai][bj][m][n] = __builtin_amdgcn_mfma_f32_16x16x32_bf16(Bt[n][k], At[m][k], acc[ai][bj][m][n], 0, 0, 0); __builtin_amdgcn_s_setprio(0); } while (0)
#define PG8_WAIT_V(n) asm volatile("s_waitcnt vmcnt(" #n ")" ::: "memory")
#define PG8_WAIT_L(n) asm volatile("s_waitcnt lgkmcnt(" #n ")" ::: "memory")
#define PG8_BAR __builtin_amdgcn_s_barrier()
#define PG8_SCHED __builtin_amdgcn_sched_barrier(0)
    Unit cur, nxt; int ui = 0;
    if (!S.next(0, cur)) return;
    f32x4 acc[2][2][4][2];
#pragma unroll
    for (int a = 0; a < 2; ++a)
#pragma unroll
        for (int b = 0; b < 2; ++b)
#pragma unroll
            for (int m = 0; m < 4; ++m)
#pragma unroll
                for (int n = 0; n < 2; ++n) acc[a][b][m][n] = (f32x4){0.f, 0.f, 0.f, 0.f};
    bf16x8 At[4][2], B0[2][2], B1[2][2];
    const char* cA = (const char*)g.A + (size_t)cur.pm * tstep; const char* cB = (const char*)g.Bt + (size_t)cur.pn * tstep;
    S.a_ready(cur);
    if constexpr (SP2) {
        PG8_STAGE(PG8_SB(0, 0), cB, voffB); PG8_STAGE(PG8_SB(0, 1), cB + hstep, voffB); PG8_STAGE(PG8_SA(0, 0), cA, voffA); PG8_STAGE(PG8_SA(0, 1), cA + hstep, voffA);
        if (wr == 1) PG8_BAR;
        PG8_WAIT_V(2); PG8_BAR;
        PG8_STAGE(PG8_SB(1, 0), cB + kstep, voffB); PG8_STAGE(PG8_SA(1, 0), cA + kstep, voffA); PG8_STAGE(PG8_SB(1, 1), cB + hstep + kstep, voffB);
        PG8_WAIT_V(6); PG8_BAR;
    } else {
        PG8_STAGE(PG8_SB(0, 0), cB, voffB); PG8_STAGE(PG8_SA(0, 0), cA, voffA); PG8_STAGE(PG8_SB(0, 1), cB + hstep, voffB); PG8_STAGE(PG8_SA(0, 1), cA + hstep, voffA);
        if (wr == 1) PG8_BAR;
        PG8_WAIT_V(4); PG8_BAR;
        PG8_STAGE(PG8_SB(1, 0), cB + kstep, voffB); PG8_STAGE(PG8_SA(1, 0), cA + kstep, voffA); PG8_STAGE(PG8_SB(1, 1), cB + hstep + kstep, voffB);
        PG8_WAIT_V(6); PG8_BAR;
    }
    for (;;) {
        const bool has_next = S.next(ui + 1, nxt);
        const char* nA = has_next ? (const char*)g.A + (size_t)nxt.pm * tstep : cA; const char* nB = has_next ? (const char*)g.Bt + (size_t)nxt.pn * tstep : cB;
        for (int t = 0; t < nt; t += 2) {
            const bool last = (t == nt - 2);
            const char* a1 = cA + (size_t)(t + 1) * kstep;
            const char* a2 = last ? nA : cA + (size_t)(t + 2) * kstep; const char* b2 = last ? nB : cB + (size_t)(t + 2) * kstep;
            const char* a3 = a2 + kstep; const char* b3 = b2 + kstep;
            if (last && has_next) S.a_ready(nxt);
            if constexpr (SP2) {
            PG8_LDB(B0, 0, 0); PG8_LDB(B1, 0, 1); PG8_SCHED; PG8_LDA(At, 0, 0); PG8_STAGE(PG8_SA(1, 1), a1 + hstep, voffA);
            PG8_WAIT_V(8); PG8_WAIT_L(0); PG8_BAR; PG8_MMA(0, 0, At, B0); PG8_MMA(0, 1, At, B1); PG8_BAR; PG8_SCHED;
            PG8_LDA(At, 0, 1); PG8_STAGE(PG8_SB(0, 0), b2, voffB); PG8_STAGE(PG8_SB(0, 1), b2 + hstep, voffB); PG8_STAGE(PG8_SA(0, 0), a2, voffA);
            PG8_WAIT_V(8); PG8_WAIT_L(0); PG8_BAR; PG8_MMA(1, 0, At, B0); PG8_MMA(1, 1, At, B1); PG8_BAR; PG8_SCHED;
            PG8_LDB(B0, 1, 0); PG8_LDB(B1, 1, 1); PG8_SCHED; PG8_LDA(At, 1, 0); PG8_STAGE(PG8_SA(0, 1), a2 + hstep, voffA);
            PG8_WAIT_V(8); PG8_WAIT_L(0); PG8_BAR; PG8_MMA(0, 0, At, B0); PG8_MMA(0, 1, At, B1); PG8_BAR; PG8_SCHED;
            PG8_LDA(At, 1, 1); PG8_STAGE(PG8_SB(1, 0), b3, voffB); PG8_STAGE(PG8_SB(1, 1), b3 + hstep, voffB); PG8_STAGE(PG8_SA(1, 0), a3, voffA);
            PG8_WAIT_V(8); PG8_WAIT_L(0); PG8_BAR; PG8_MMA(1, 0, At, B0); PG8_MMA(1, 1, At, B1); PG8_BAR; PG8_SCHED;
            } else {
            PG8_LDB(B0, 0, 0); PG8_SCHED; PG8_LDA(At, 0, 0); PG8_STAGE(PG8_SA(1, 1), a1 + hstep, voffA);
            PG8_WAIT_L(8); PG8_BAR; PG8_WAIT_L(0); PG8_MMA(0, 0, At, B0); PG8_BAR; PG8_SCHED;
            PG8_LDB(B1, 0, 1); PG8_STAGE(PG8_SB(0, 0), b2, voffB);
            PG8_BAR; PG8_WAIT_L(0); PG8_MMA(0, 1, At, B1); PG8_BAR;
            PG8_LDA(At, 0, 1); PG8_STAGE(PG8_SA(0, 0), a2, voffA);
            PG8_BAR; PG8_WAIT_L(0); PG8_MMA(1, 0, At, B0); PG8_BAR; PG8_SCHED;
            PG8_STAGE(PG8_SB(0, 1), b2 + hstep, voffB);
            PG8_WAIT_V(6); PG8_BAR; PG8_MMA(1, 1, At, B1); PG8_BAR;
            PG8_LDB(B0, 1, 0); PG8_SCHED; PG8_LDA(At, 1, 0); PG8_STAGE(PG8_SA(0, 1), a2 + hstep, voffA);
            PG8_WAIT_L(8); PG8_BAR; PG8_WAIT_L(0); PG8_MMA(0, 0, At, B0); PG8_BAR; PG8_SCHED;
            PG8_LDB(B1, 1, 1); PG8_STAGE(PG8_SB(1, 0), b3, voffB);
            PG8_BAR; PG8_WAIT_L(0); PG8_MMA(0, 1, At, B1); PG8_BAR;
            PG8_LDA(At, 1, 1); PG8_STAGE(PG8_SA(1, 0), a3, voffA);
            PG8_BAR; PG8_WAIT_L(0); PG8_MMA(1, 0, At, B0); PG8_BAR; PG8_SCHED;
            PG8_STAGE(PG8_SB(1, 1), b3 + hstep, voffB);
            PG8_WAIT_V(6); PG8_BAR; PG8_MMA(1, 1, At, B1); PG8_BAR;
            }
        }
        if constexpr (ALIGN_EPI) { if (wr == 0) PG8_BAR; }
        if constexpr (!Epi::AFTER_DRAIN) { E(acc, cur, wr, wc, fr, fq); S.done(cur); }
        if (!has_next) break;
#pragma unroll
        for (int a = 0; a < 2; ++a)
#pragma unroll
            for (int b = 0; b < 2; ++b)
#pragma unroll
                for (int m = 0; m < 4; ++m)
#pragma unroll
                    for (int n = 0; n < 2; ++n) acc[a][b][m][n] = (f32x4){0.f, 0.f, 0.f, 0.f};
        cur = nxt; cA = nA; cB = nB; ++ui;
        if constexpr (ALIGN_EPI) { if (wr == 1) PG8_BAR; }
    }
    PG8_WAIT_V(0);
    if constexpr (!ALIGN_EPI) { if (wr == 0) PG8_BAR; }
    PG8_BAR;
    if constexpr (Epi::AFTER_DRAIN) { E.fused(acc, cur, wr, wc, fr, fq, lds, wid, lane); S.done(cur); }
#undef PG8_SA
#undef PG8_SB
#undef PG8_STAGE
#undef PG8_LDA
#undef PG8_LDB
#undef PG8_MMA
#undef PG8_WAIT_V
#undef PG8_WAIT_L
#undef PG8_BAR
#undef PG8_SCHED
}
}
#ifndef PG8_SP2
#define PG8_SP2 true
#endif
#ifndef PG8_ALIGN
#define PG8_ALIGN true
#endif
namespace att {
typedef unsigned short bf16;
typedef short bf16x8 __attribute__((ext_vector_type(8)));
typedef short s16x4 __attribute__((ext_vector_type(4)));
typedef float f32x16 __attribute__((ext_vector_type(16)));
typedef float f32x4 __attribute__((ext_vector_type(4)));
typedef unsigned u32x4 __attribute__((ext_vector_type(4)));
constexpr int D = 128, NW = 8, QBLK = 32, KVBLK = 64, QB = NW * QBLK, LDQ = 6144, LDO = 2048;
constexpr float SCALE = 0.08838834764831845f, THR = 8.f;
constexpr int SHM_V = KVBLK * D * 2, SHM_K = KVBLK * D * 2, NSLOT = 3;
constexpr int OFF_V = 0, OFF_K = NSLOT * SHM_V, OFF_WS = OFF_K + NSLOT * SHM_K, OFF_CL = OFF_WS + NW * 64 * 4, OFF_TB = OFF_CL + NSLOT * 256, LDS_BYTES = OFF_TB + 8192;
#define KSWZ(row, colB) ((row) * 256 + ((colB) ^ (((row) & 7) << 4)))
#define SBAR() __builtin_amdgcn_sched_barrier(0)
__device__ __forceinline__ int v_st(int k, int c) { const int kk = (k & ~0xC) | ((k & 4) << 1) | ((k & 8) >> 1); return ((kk >> 3) * 4 + (c >> 5)) * 512 + ((kk & 7) * 32 + (c & 31)) * 2; }
__device__ __forceinline__ int v_rd_base(int lane) { return ((lane & 3) << 3) | (((lane >> 2) & 3) << 6) | (((lane >> 4) & 1) << 5) | (((lane >> 5) & 1) << 8); }
constexpr int v_rd_off(int d0, int ks, int half) { return d0 * 512 + ks * 4096 + half * 2048; }
__device__ __forceinline__ int crow(int r, int hi) { return (r & 3) + 8 * (r >> 2) + 4 * hi; }
__device__ __forceinline__ unsigned cvtpk(float lo, float hi) { unsigned r; asm volatile("v_cvt_pk_bf16_f32 %0, %1, %2" : "=v"(r) : "v"(lo), "v"(hi)); return r; }
__device__ __forceinline__ void mask_tile(f32x16& p0, f32x16& p1, int dq, unsigned W) {
    const float NEG = -__builtin_inff();
#pragma unroll
    for (int r = 0; r < 16; ++r) { const int c = (r & 3) + 8 * (r >> 2);
        if ((unsigned)(dq - c) >= W) p0[r] = NEG;
        if ((unsigned)(dq - c - 32) >= W) p1[r] = NEG; }
}
__device__ __forceinline__ void add_bias(f32x16& p0, f32x16& p1, const float* tb, int relbase) {
    const float* t = tb + relbase;
#pragma unroll
    for (int r = 0; r < 16; ++r) { const int c = (r & 3) + 8 * (r >> 2); p0[r] += t[c]; p1[r] += t[c + 32]; }
}
__device__ __forceinline__ void partialSM(f32x16& p0, f32x16& p1, float& m_reg, float& mn, float& alpha) {
    float pmax = p0[0]; for (int r = 1; r < 16; ++r) pmax = fmaxf(pmax, p0[r]); for (int r = 0; r < 16; ++r) pmax = fmaxf(pmax, p1[r]);
    { auto rr = __builtin_amdgcn_permlane32_swap(__float_as_uint(pmax), __float_as_uint(pmax), false, false);
      pmax = fmaxf(__uint_as_float(rr[0]), __uint_as_float(rr[1])); }
    constexpr float C2 = 1.4426950408889634f * SCALE;
    if (__builtin_expect(__all((pmax - m_reg) * SCALE <= THR), 1)) { mn = m_reg; alpha = 1.f; }
    else { mn = fmaxf(m_reg, pmax); alpha = __builtin_amdgcn_exp2f((m_reg - mn) * C2); m_reg = mn; }
    const float mnL = -mn * C2;
    for (int r = 0; r < 16; ++r) p0[r] = fmaf(p0[r], C2, mnL); for (int r = 0; r < 16; ++r) p1[r] = fmaf(p1[r], C2, mnL);
    for (int r = 0; r < 16; ++r) p0[r] = __builtin_amdgcn_exp2f(p0[r]);
}
__device__ __forceinline__ void finishSM(f32x16& p0, f32x16& p1, float alpha, float& l_reg, bf16x8& pa0, bf16x8& pa1, bf16x8& pa2, bf16x8& pa3) {
    for (int r = 0; r < 16; ++r) p1[r] = __builtin_amdgcn_exp2f(p1[r]);
    float ps = 0; for (int r = 0; r < 16; ++r) ps += p0[r]; for (int r = 0; r < 16; ++r) ps += p1[r];
    { auto rr = __builtin_amdgcn_permlane32_swap(__float_as_uint(ps), __float_as_uint(ps), false, false);
      ps = __uint_as_float(rr[0]) + __uint_as_float(rr[1]); }
    l_reg = l_reg * alpha + ps;
#define PK4(P, B_, OUT) do { unsigned a0 = cvtpk(P[B_+0], P[B_+1]), a1 = cvtpk(P[B_+2], P[B_+3]);                          \
        unsigned b0 = cvtpk(P[B_+4], P[B_+5]), b1 = cvtpk(P[B_+6], P[B_+7]);                                             \
        auto r0 = __builtin_amdgcn_permlane32_swap(a0, b0, false, false); auto r1 = __builtin_amdgcn_permlane32_swap(a1, b1, false, false); \
        u32x4 w = {r0[0], r1[0], r0[1], r1[1]}; OUT = *reinterpret_cast<bf16x8*>(&w); } while (0)
    PK4(p0, 0, pa0); PK4(p0, 8, pa1); PK4(p1, 0, pa2); PK4(p1, 8, pa3);
#undef PK4
}
template <bool SK, int MODE>
__device__ __forceinline__ void qkt(f32x16& p0, f32x16& p1, const char* lds, int kslot  , int cslot  , int r32, int hi, const bf16x8* qr, bool act) {
    if (SK && !act) { const float NEG = -__builtin_inff();
#pragma unroll
        for (int r = 0; r < 16; ++r) { p0[r] = NEG; p1[r] = NEG; } return; }
    if (MODE == 1) { const float* cl = (const float*)(lds + OFF_CL) + cslot + 4 * hi;
#pragma unroll
        for (int g = 0; g < 4; ++g) { const f32x4 a = *(const f32x4*)(cl + 8 * g), b = *(const f32x4*)(cl + 32 + 8 * g);
            p0[4 * g] = a[0]; p0[4 * g + 1] = a[1]; p0[4 * g + 2] = a[2]; p0[4 * g + 3] = a[3];
            p1[4 * g] = b[0]; p1[4 * g + 1] = b[1]; p1[4 * g + 2] = b[2]; p1[4 * g + 3] = b[3]; } }
    else { p0 = f32x16{}; p1 = f32x16{}; }
    const char* K_lds = lds + OFF_K + kslot;
    const char* kb[4];
#pragma unroll
    for (int dd = 0; dd < 4; ++dd) kb[dd] = K_lds + KSWZ(r32, (dd * 16 + hi * 8) * 2);
#pragma unroll
    for (int d0 = 0; d0 < 8; ++d0) { const char* a = kb[d0 & 3] + (d0 >> 2) * 128;
        bf16x8 b0 = *reinterpret_cast<const bf16x8*>(a);
        bf16x8 b1 = *reinterpret_cast<const bf16x8*>(a + 32 * 256);
        p0 = __builtin_amdgcn_mfma_f32_32x32x16_bf16(b0, qr[d0], p0, 0, 0, 0);
        p1 = __builtin_amdgcn_mfma_f32_32x32x16_bf16(b1, qr[d0], p1, 0, 0, 0); }
}
template <bool SK>
__device__ __forceinline__ void pv_tile(f32x16* o, int vb0  , bf16x8 pa0, bf16x8 pa1, bf16x8 pa2, bf16x8 pa3, bool act) {
    if (SK && !act) return;
#define TRRD(dst, off) asm volatile("ds_read_b64_tr_b16 %0, %1 offset:%2" : "=&v"(dst) : "v"(vb0), "i"(off) : "memory")
#define PV_D0(d0) do { s16x4 l0, l1, l2, l3, h0, h1, h2, h3; constexpr int b_ = v_rd_off(d0, 0, 0); \
        TRRD(l0, b_); TRRD(h0, b_ + 2048); TRRD(l1, b_ + 4096); TRRD(h1, b_ + 6144); TRRD(l2, b_ + 8192); TRRD(h2, b_ + 10240); TRRD(l3, b_ + 12288); TRRD(h3, b_ + 14336); \
        asm volatile("s_waitcnt lgkmcnt(0)" ::: "memory"); SBAR(); \
        o[d0] = __builtin_amdgcn_mfma_f32_32x32x16_bf16(pa0, (bf16x8){l0[0], l0[1], l0[2], l0[3], h0[0], h0[1], h0[2], h0[3]}, o[d0], 0, 0, 0);   \
        o[d0] = __builtin_amdgcn_mfma_f32_32x32x16_bf16(pa1, (bf16x8){l1[0], l1[1], l1[2], l1[3], h1[0], h1[1], h1[2], h1[3]}, o[d0], 0, 0, 0);   \
        o[d0] = __builtin_amdgcn_mfma_f32_32x32x16_bf16(pa2, (bf16x8){l2[0], l2[1], l2[2], l2[3], h2[0], h2[1], h2[2], h2[3]}, o[d0], 0, 0, 0);   \
        o[d0] = __builtin_amdgcn_mfma_f32_32x32x16_bf16(pa3, (bf16x8){l3[0], l3[1], l3[2], l3[3], h3[0], h3[1], h3[2], h3[3]}, o[d0], 0, 0, 0); } while (0)
    PV_D0(0); PV_D0(1); PV_D0(2); PV_D0(3);
#undef PV_D0
#undef TRRD
}
struct BlockRef { const bf16* Q; const bf16* K; const bf16* V; bf16* O; const float* CB; int P0, jlo, h; };
__device__ __forceinline__ void glds16(const void* sbase, unsigned voff, unsigned lds_dst) { unsigned keep;
    asm volatile("s_mov_b32 %0, m0\n\ts_mov_b32 m0, %3\n\ts_nop 0\n\tglobal_load_lds_dwordx4 %1, %2\n\ts_mov_b32 m0, %0" : "=&s"(keep) : "v"(voff), "s"(sbase), "s"(lds_dst) : "memory"); }
__device__ __forceinline__ void glds4(const void* sbase, unsigned voff, unsigned lds_dst) { unsigned keep;
    asm volatile("s_mov_b32 %0, m0\n\ts_mov_b32 m0, %3\n\ts_nop 0\n\tglobal_load_lds_dword %1, %2\n\ts_mov_b32 m0, %0" : "=&s"(keep) : "v"(voff), "s"(sbase), "s"(lds_dst) : "memory"); }
#define WAIT_BAR(N) asm volatile("s_waitcnt vmcnt(" #N ") lgkmcnt(0)\n\ts_barrier" ::: "memory")
#define LD8(p) (*reinterpret_cast<const bf16x8*>(p))
template <int MODE>
__device__ __forceinline__ void attn_block(const BlockRef& cur, char* lds) {
    constexpr bool SK = (MODE == 0);
    constexpr int NDMA = (MODE == 1) ? 5 : 4;
    int tid = threadIdx.x; asm volatile("" : "+v"(tid));
    const int wid = __builtin_amdgcn_readfirstlane(tid >> 6), lane = tid & 63, r32 = lane & 31, hi = lane >> 5;
    const int j_lo = cur.jlo, NT = cur.P0 / KVBLK + QB / KVBLK - j_lo;
    const int qlo = cur.P0 + wid * QBLK, qm = qlo + r32 - 4 * hi;
    float* ws = (float*)(lds + OFF_WS) + wid * 64; float* li_l = ws, * al_l = ws + 32;
    const float* tbh = (const float*)(lds + OFF_TB) + cur.h * 256;
    float m_reg = -1e30f, l_reg = 0; f32x16 o[4] = {};
    const unsigned lds0 = (unsigned)(uintptr_t)lds;
    const int vb0 = (int)lds0 + OFF_V + v_rd_base(lane);
    unsigned koff0, koff1, voff0, voff1;
    { const int pc = wid * 2; int row = pc * 4 + (lane >> 4), c = (lane & 15) ^ (row & 7); koff0 = (unsigned)((row * LDQ + c * 8) * 2);
      row += 4; c = (lane & 15) ^ (row & 7); koff1 = (unsigned)((row * LDQ + c * 8) * 2);
      int st = 2 * pc + (lane >> 5), kk = ((st >> 2) << 3) | ((lane & 31) >> 2), k = (kk & ~0xC) | ((kk & 4) << 1) | ((kk & 8) >> 1); voff0 = (unsigned)((k * LDQ + (st & 3) * 32 + (lane & 3) * 8) * 2);
      st += 2; kk = ((st >> 2) << 3) | ((lane & 31) >> 2); k = (kk & ~0xC) | ((kk & 4) << 1) | ((kk & 8) >> 1); voff1 = (unsigned)((k * LDQ + (st & 3) * 32 + (lane & 3) * 8) * 2); }
    const unsigned kdst = lds0 + OFF_K + wid * 2048, vdst = lds0 + OFF_V + wid * 2048, cdst = lds0 + OFF_CL, lane4 = (unsigned)lane * 4u;
#define TILEB(t) ((size_t)(j_lo + (t)) * (KVBLK * LDQ * 2))
#define DMA_K(t, slot) do { const char* g_ = (const char*)cur.K + TILEB(t); glds16(g_, koff0, kdst + (slot)); glds16(g_, koff1, kdst + (slot) + 1024); \
                            if (MODE == 1) glds4(cur.CB + (size_t)(j_lo + (t)) * KVBLK, lane4, cdst + ((slot) >> 6)); } while (0)
#define DMA_V(t, slot) do { const char* g_ = (const char*)cur.V + TILEB(t); glds16(g_, voff0, vdst + (slot)); glds16(g_, voff1, vdst + (slot) + 1024); } while (0)
#define RESC(a) do { if (__any((a) < 1.f)) { if (hi == 0) al_l[r32] = (a); asm volatile("s_waitcnt lgkmcnt(0)" ::: "memory");              \
                     for (int d_ = 0; d_ < 4; ++d_) for (int r = 0; r < 16; ++r) o[d_][r] *= al_l[crow(r, hi)]; } } while (0)
#define KBASE(t) ((j_lo + (t)) * KVBLK)
#define ACT(t) (MODE == 0 ? (KBASE(t) <= qlo) : true)
#define MASKT(P0_, P1_, t) do { const int kb_ = KBASE(t);                                                                              \
        if (MODE == 1) { if (kb_ + KVBLK - 1 > qlo) mask_tile(P0_, P1_, qm - kb_, 0x40000000u); }                                       \
        else { if (kb_ <= qlo && kb_ + KVBLK - 1 - qlo >= -90) add_bias(P0_, P1_, tbh, kb_ - qm + 192); } } while (0)
    DMA_K(0, 0); DMA_V(0, 0); DMA_K(1, SHM_K);
    bf16x8 qr[8];
    { const unsigned qo = (unsigned)(((wid * QBLK + r32) * LDQ + hi * 8) * 2);
#pragma unroll
      for (int d0 = 0; d0 < 8; ++d0) qr[d0] = LD8((const char*)cur.Q + qo + d0 * 32); }
    WAIT_BAR(0);
    int sl_prev = 2 * SHM_K, sl_cur = 0, sl_nxt = SHM_K;
#define ROT() do { const int t_ = sl_prev; sl_prev = sl_cur; sl_cur = sl_nxt; sl_nxt = t_; } while (0)
    f32x16 pA0, pA1, pB0, pB1; float mnA, mnB, alA, alB; bf16x8 pa0, pa1, pa2, pa3;
    DMA_K(2, sl_prev); DMA_V(1, sl_nxt);
    SBAR(); qkt<SK, MODE>(pA0, pA1, lds, sl_cur, sl_cur >> 8, r32, hi, qr, ACT(0));
    MASKT(pA0, pA1, 0); partialSM(pA0, pA1, m_reg, mnA, alA);
    if (2 < NT) { if (MODE == 1) WAIT_BAR(5); else WAIT_BAR(4); } else WAIT_BAR(0);
    ROT();
#define STEP(PL, PX0, PX1, mnX, alX, PY0, PY1, alY, s) do {                                                                    \
        if ((PL) || (s) + 2 < NT) DMA_K((s) + 2, sl_prev);                                                                     \
        if ((PL) || (s) + 1 < NT) DMA_V((s) + 1, sl_nxt);                                                                      \
        SBAR(); qkt<(SK && !(PL)), MODE>(PX0, PX1, lds, sl_cur, sl_cur >> 8, r32, hi, qr, ACT(s));                             \
        finishSM(PY0, PY1, alY, l_reg, pa0, pa1, pa2, pa3); SBAR();                                                            \
        pv_tile<(SK && !(PL))>(o, vb0 + sl_prev, pa0, pa1, pa2, pa3, ACT((s) - 1)); if (!(PL)) MASKT(PX0, PX1, (s)); partialSM(PX0, PX1, m_reg, mnX, alX); \
        RESC(alX);                                                                                                             \
        if ((PL) || (s) + 2 < NT) { if (MODE == 1) WAIT_BAR(5); else WAIT_BAR(4); } else WAIT_BAR(0);                          \
        ROT(); } while (0)
    int s = 1;
    { const int NH = NT - (MODE == 0 ? 6 : 4) - 2;
      for (; s + 1 < NH; s += 2) {
        STEP(true, pB0, pB1, mnB, alB, pA0, pA1, alA, s);
        STEP(true, pA0, pA1, mnA, alA, pB0, pB1, alB, s + 1);
      } }
    for (; s + 1 < NT; s += 2) {
        STEP(false, pB0, pB1, mnB, alB, pA0, pA1, alA, s);
        STEP(false, pA0, pA1, mnA, alA, pB0, pB1, alB, s + 1);
    }
    if (s < NT) {
        STEP(false, pB0, pB1, mnB, alB, pA0, pA1, alA, s);
        finishSM(pB0, pB1, alB, l_reg, pa0, pa1, pa2, pa3); SBAR(); pv_tile<SK>(o, vb0 + sl_prev, pa0, pa1, pa2, pa3, ACT(NT - 1));
    } else {
        finishSM(pA0, pA1, alA, l_reg, pa0, pa1, pa2, pa3); SBAR(); pv_tile<SK>(o, vb0 + sl_prev, pa0, pa1, pa2, pa3, ACT(NT - 1));
    }
    if (hi == 0) li_l[r32] = l_reg; asm volatile("s_waitcnt lgkmcnt(0)" ::: "memory");
    float rli[16];
#pragma unroll
    for (int r = 0; r < 16; ++r) rli[r] = __builtin_amdgcn_rcpf(li_l[crow(r, hi)]);
    char* Ow = (char*)cur.O; const unsigned oo = (unsigned)(((wid * QBLK + 4 * hi) * LDO + r32) * 2);
#pragma unroll
    for (int r = 0; r < 16; ++r) { const unsigned orow = (unsigned)(((r & 3) + 8 * (r >> 2)) * LDO * 2);
#pragma unroll
        for (int d0 = 0; d0 < 4; ++d0) { const float v = o[d0][r] * rli[r];
            const float vn = __shfl_xor(v, 1);
            if ((r32 & 1) == 0) *(unsigned*)(Ow + (oo + orow + d0 * 64)) = cvtpk(v, vn); } }
    asm volatile("s_waitcnt lgkmcnt(0)\n\ts_barrier" ::: "memory");
#undef TILEB
#undef DMA_K
#undef DMA_V
#undef RESC
#undef KBASE
#undef ACT
#undef MASKT
#undef ROT
#undef STEP
}
#undef WAIT_BAR
#undef LD8
#undef SBAR
#undef KSWZ
}
#define GAS __attribute__((address_space(1)))
#define LAS __attribute__((address_space(3)))
typedef unsigned short bf16;
typedef unsigned v4u __attribute__((ext_vector_type(4)));
typedef unsigned v2u __attribute__((ext_vector_type(2)));
typedef float f32x4 __attribute__((ext_vector_type(4)));
constexpr int NWAVES = 8;
constexpr int BATCH = 2, SEQ = 16384, DM = 2048, TOK = BATCH * SEQ, FF = 8192, NQKV = 6144, NQKV1 = 6400, FH = 16;
constexpr float NORM_EPS = 1e-6f, SUBLN_EPS = 1e-5f, LAMBDA_INIT = 0.2f;
constexpr size_t MiB = 1u << 20;
constexpr size_t WS_F = 0, WS_CB = 2 * MiB;
constexpr size_t WS_WQKV0 = 4 * MiB, WS_WOA = 28 * MiB, WS_WMI0 = 36 * MiB, WS_WMO0 = 68 * MiB, WS_WQKV1 = 100 * MiB, WS_WOB = 126 * MiB, WS_WMI1 = 134 * MiB, WS_WMO1 = 166 * MiB;
constexpr size_t WS_NRM = 198 * MiB;
constexpr size_t WS_RS = 198 * MiB + 65536;
constexpr size_t WS_BAR = 199 * MiB;
constexpr size_t WS_HB = 712 * MiB;
constexpr size_t WS_QKV = 200 * MiB;
constexpr size_t WS_OC = 584 * MiB;
constexpr size_t WS_HID = 200 * MiB;
constexpr size_t WS_XN = 840 * MiB;
constexpr size_t WS_END = 968 * MiB;
constexpr int LDS_BYTES = 147456;

__device__ __forceinline__ unsigned char* launder_p(unsigned char* p) { asm volatile("" : "+s"(p)); return p; }
__device__ __forceinline__ unsigned f2bf(float f) { unsigned u = __builtin_bit_cast(unsigned, f); return (u + 0x7fffu + ((u >> 16) & 1u)) >> 16; }
__device__ __forceinline__ unsigned pk2(float lo, float hi) { return f2bf(lo) | (f2bf(hi) << 16); }
__device__ __forceinline__ float bf2f(unsigned short b) { return __builtin_bit_cast(float, (unsigned)b << 16); }
__device__ __forceinline__ float wave_sum(float v) {
#pragma unroll
    for (int o = 1; o < 64; o <<= 1) v += __shfl_xor(v, o);
    return v;
}
__device__ __forceinline__ void transpose_item(const float* W, int K, int N, bf16* WT, int row_off, const float* g, LAS float* scr, int item, int lane) {
    const int nblk = N / 32, kb = item / nblk, nb = item % nblk, k0 = 64 * kb, n0 = 32 * nb;
#pragma unroll 8
    for (int i = 0; i < 32; ++i) { const int kk = 2 * i + (lane >> 5); float v = W[(size_t)(k0 + kk) * N + n0 + (lane & 31)]; if (g) v *= g[k0 + kk]; scr[kk * 33 + (lane & 31)] = v; }
    asm volatile("s_waitcnt lgkmcnt(0)" ::: "memory");
    const int c = lane & 7;
#pragma unroll
    for (int j = 0; j < 4; ++j) { const int n = (lane >> 3) + 8 * j; const LAS float* s = scr + (8 * c) * 33 + n;
        v4u o; o.x = pk2(s[0 * 33], s[1 * 33]); o.y = pk2(s[2 * 33], s[3 * 33]); o.z = pk2(s[4 * 33], s[5 * 33]); o.w = pk2(s[6 * 33], s[7 * 33]);
        *(v4u*)(WT + (size_t)(row_off + n0 + n) * K + k0 + 8 * c) = o; }
    asm volatile("s_waitcnt lgkmcnt(0)" ::: "memory");
}
__device__ __forceinline__ void norm_row_to_bf16(const float* xrow, bf16* orow, int lane) {
    const f32x4* xr = (const f32x4*)xrow + lane;
    f32x4 v[8]; float s = 0.f;
#pragma unroll
    for (int j = 0; j < 8; ++j) { v[j] = xr[64 * j]; s += (v[j].x * v[j].x + v[j].y * v[j].y) + (v[j].z * v[j].z + v[j].w * v[j].w); }
    const float rstd = 1.f / sqrtf(wave_sum(s) * (1.f / DM) + NORM_EPS);
    v2u* o8 = (v2u*)orow + lane;
#pragma unroll
    for (int j = 0; j < 8; ++j) { v2u w; w.x = pk2(v[j].x * rstd, v[j].y * rstd); w.y = pk2(v[j].z * rstd, v[j].w * rstd); o8[64 * j] = w; }
}
__device__ __forceinline__ void norm_phase(const float* src, bf16* dst, int gw, int NGW, int lane) {
    for (int m = gw; m < TOK; m += NGW) norm_row_to_bf16(src + (size_t)m * DM, dst + (size_t)m * DM, lane);
}
__device__ __forceinline__ void final_norm_phase(float* io, const float* g, const float* rs, int gw, int NGW, int lane) {
    for (int m = gw; m < TOK; m += NGW) {
        f32x4* xr = (f32x4*)(io + (size_t)m * DM) + lane; const f32x4* gr = (const f32x4*)g + lane;
        const float rstd = 1.f / sqrtf(rs[m] * (1.f / DM) + NORM_EPS);
#pragma unroll
        for (int j = 0; j < 8; ++j) xr[64 * j] = xr[64 * j] * rstd * gr[64 * j];
    }
}
__device__ __forceinline__ void combine_phase(const bf16* OC, bf16* O, const float* lq1, const float* lk1, const float* lq2, const float* lk2, const float* sg, int gw, int NGW, int lane) {
    const float s1 = wave_sum(lq1[lane] * lk1[lane] + lq1[lane + 64] * lk1[lane + 64]), s2 = wave_sum(lq2[lane] * lk2[lane] + lq2[lane + 64] * lk2[lane + 64]);
    const float lam = expf(s1) - expf(s2) + LAMBDA_INIT;
    float gs[8];
#pragma unroll
    for (int e = 0; e < 8; ++e) gs[e] = sg[(lane & 31) * 8 + e] * (1.f - LAMBDA_INIT);
    for (int m = gw; m < TOK; m += NGW) {
        const v4u* a = (const v4u*)(OC + (size_t)m * DM) + lane; const v4u* b = (const v4u*)(OC + (size_t)TOK * DM + (size_t)m * DM) + lane; v4u* o = (v4u*)(O + (size_t)m * DM) + lane;
#pragma unroll
        for (int st = 0; st < 4; ++st) { const v4u av = a[64 * st], bv = b[64 * st]; float d[8]; float ss = 0.f;
#pragma unroll
            for (int e = 0; e < 4; ++e) { const unsigned aw = av[e], bw = bv[e];
                d[2 * e] = __builtin_bit_cast(float, aw << 16) - lam * __builtin_bit_cast(float, bw << 16);
                d[2 * e + 1] = __builtin_bit_cast(float, aw & 0xffff0000u) - lam * __builtin_bit_cast(float, bw & 0xffff0000u);
                ss += d[2 * e] * d[2 * e] + d[2 * e + 1] * d[2 * e + 1]; }
#pragma unroll
            for (int of = 1; of < 32; of <<= 1) ss += __shfl_xor(ss, of);
            const float rstd = 1.f / sqrtf(ss * (1.f / 256.f) + SUBLN_EPS);
            v4u w; w.x = pk2(d[0] * rstd * gs[0], d[1] * rstd * gs[1]); w.y = pk2(d[2] * rstd * gs[2], d[3] * rstd * gs[3]);
            w.z = pk2(d[4] * rstd * gs[4], d[5] * rstd * gs[5]); w.w = pk2(d[6] * rstd * gs[6], d[7] * rstd * gs[7]); o[64 * st] = w; }
    }
}
__device__ __forceinline__ void cumsum_phase(const float* F, const float* bfb, float* CB, LAS unsigned char* lds, int bx, int G, int tid) {
    LAS double* sc = (LAS double*)lds;
    for (int bh = bx; bh < BATCH * FH; bh += G) {
        const int b = bh / FH, h = bh % FH; const float bias = bfb[h];
        const float* fp = F + ((size_t)b * SEQ + (size_t)tid * 32) * FH + h;
        float ls[32]; double run = 0.0;
#pragma unroll
        for (int i = 0; i < 32; ++i) { const float x = fp[(size_t)i * FH] + bias; ls[i] = fminf(x, 0.f) - log1pf(expf(-fabsf(x))); run += (double)ls[i]; }
        sc[tid] = run; __syncthreads();
        int cur = 0;
        for (int of = 1; of < 512; of <<= 1) { double v = sc[cur * 512 + tid]; if (tid >= of) v += sc[cur * 512 + tid - of]; sc[(cur ^ 1) * 512 + tid] = v; cur ^= 1; __syncthreads(); }
        double acc = sc[cur * 512 + tid] - run;
        float* op = CB + (size_t)bh * SEQ + (size_t)tid * 32;
#pragma unroll
        for (int i = 0; i < 32; ++i) { acc += (double)ls[i]; op[i] = (float)(-acc * 11.313708498984761); }
        __syncthreads();
    }
}

__device__ __forceinline__ void rownorm_phase(const bf16* QKV, unsigned* NRM, int bx, int G, int tid) {
    for (int vw = bx; vw < 256; vw += G) {
        const int bh = vw >> 3, part = vw & 7, b = bh >> 4, h = bh & 15;
        const char* base = (const char*)(QKV + ((size_t)b * SEQ + (size_t)part * 2048) * NQKV + h * 128);
        const unsigned vo = (unsigned)(((tid >> 4) * NQKV + (tid & 15) * 8) * 2);
        float mq = 0.f, mk = 0.f;
#pragma unroll 4
        for (int it = 0; it < 64; ++it) {
            const char* rp = base + (size_t)it * 32 * NQKV * 2;
            const v4u qv = *(const v4u*)(rp + vo), kv = *(const v4u*)(rp + vo + 2048 * 2);
            float sq = 0.f, sk = 0.f;
#pragma unroll
            for (int e = 0; e < 4; ++e) { const float a0 = __builtin_bit_cast(float, qv[e] << 16), a1 = __builtin_bit_cast(float, qv[e] & 0xffff0000u), b0 = __builtin_bit_cast(float, kv[e] << 16), b1 = __builtin_bit_cast(float, kv[e] & 0xffff0000u);
                sq += a0 * a0 + a1 * a1; sk += b0 * b0 + b1 * b1; }
#pragma unroll
            for (int of = 1; of < 16; of <<= 1) { sq += __shfl_xor(sq, of); sk += __shfl_xor(sk, of); }
            mq = fmaxf(mq, sq); mk = fmaxf(mk, sk);
        }
        mq = fmaxf(mq, __shfl_xor(mq, 16)); mq = fmaxf(mq, __shfl_xor(mq, 32)); mk = fmaxf(mk, __shfl_xor(mk, 16)); mk = fmaxf(mk, __shfl_xor(mk, 32));
        if ((tid & 63) == 0) { atomicMax(NRM + bh * 2, __float_as_uint(mq)); atomicMax(NRM + bh * 2 + 1, __float_as_uint(mk)); }
    }
}

#define XB_TMO      128
#define XB_XCNT(j)  (256  + 64 * (j))
#define XB_XSUB(j)  (1280 + 64 * (j))
#define XB_XGEN(j)  (2304 + 64 * (j))
#define XB_TOP      3328
#define XB_TOPGEN   3392
#define XCD_BAR_WORDS 3456
#define XB_SPIN_CAP (1u << 18)

__device__ __forceinline__ unsigned xb_ld(unsigned* p)              { return __hip_atomic_load(p, __ATOMIC_RELAXED, __HIP_MEMORY_SCOPE_AGENT); }
__device__ __forceinline__ unsigned xb_add(unsigned* p, unsigned v) { return __hip_atomic_fetch_add(p, v, __ATOMIC_RELAXED, __HIP_MEMORY_SCOPE_AGENT); }
__device__ __forceinline__ unsigned xb_xcc_id() { return (unsigned)__builtin_amdgcn_s_getreg((3 << 11) | 20) & 0xFu; }
#define XB_SPIN(cond, bar) do { unsigned _sp = 0; while (cond) { __builtin_amdgcn_s_sleep(1); \
    if ((++_sp & 255u) == 0u) { if (xb_ld(&(bar)[XB_TMO])) break; if (_sp > XB_SPIN_CAP) { atomicAdd(&(bar)[XB_TMO], 1u); break; } } } } while (0)

struct XcdBarrier {
    unsigned* bar; unsigned x;
    volatile LAS unsigned* st;
};

__device__ __forceinline__ XcdBarrier xcd_barrier_post(unsigned* bar, volatile LAS unsigned* st) {
    XcdBarrier b; b.bar = bar; b.x = xb_xcc_id(); b.st = st;
    if (threadIdx.x == 0) (void)xb_add(&bar[XB_XCNT(b.x)], 1u);
    return b;
}
__device__ __forceinline__ void xcd_barrier_complete(unsigned* bar, unsigned x, unsigned& nloc, unsigned& nx) {
    const unsigned G = gridDim.x * gridDim.y * gridDim.z;
    unsigned sum, cnt, mine, sp = 0u;
    for (;;) {
        sum = 0u; cnt = 0u; mine = 0u;
#pragma unroll
        for (unsigned j = 0; j < 16; ++j) { const unsigned c = xb_ld(&bar[XB_XCNT(j)]); sum += c; cnt += (c > 0u) ? 1u : 0u; mine = (j == x) ? c : mine; }
        if (sum == G) break;
        __builtin_amdgcn_s_sleep(1);
        if ((++sp & 255u) == 0u) { if (xb_ld(&bar[XB_TMO])) break; if (sp > XB_SPIN_CAP) { atomicAdd(&bar[XB_TMO], 1u); break; } }
    }
    nloc = mine > 0u ? mine : 1u; nx = cnt > 0u ? cnt : 1u;
}

__device__ __forceinline__ void xcd_barrier(const XcdBarrier& b) {
    asm volatile("s_waitcnt vmcnt(0)" ::: "memory");
    __syncthreads();
    if (threadIdx.x == 0) {
        unsigned* bar = b.bar;
        __builtin_amdgcn_s_waitcnt(0);
        unsigned nloc = b.st[0], nx = b.st[1];
        if (nloc == 0u) { xcd_barrier_complete(bar, b.x, nloc, nx); b.st[0] = nloc; b.st[1] = nx; }
        const unsigned old = xb_add(&bar[XB_XSUB(b.x)], 1u);
        const unsigned gen = old / nloc;
        if (old + 1u == (gen + 1u) * nloc) {
            __builtin_amdgcn_fence(__ATOMIC_RELEASE, "agent");
            asm volatile("s_waitcnt vmcnt(0)" ::: "memory");
            const unsigned og = xb_add(&bar[XB_TOP], 1u);
            const unsigned tg = og / nx;
            if (og + 1u == (tg + 1u) * nx) xb_add(&bar[XB_TOPGEN], 1u);
            else XB_SPIN(xb_ld(&bar[XB_TOPGEN]) == tg, bar);
            __builtin_amdgcn_fence(__ATOMIC_ACQUIRE, "agent");
            xb_add(&bar[XB_XGEN(b.x)], 1u);
            asm volatile("s_waitcnt vmcnt(0)" ::: "memory");
        } else {
            XB_SPIN(xb_ld(&bar[XB_XGEN(b.x)]) == gen, bar);
            __builtin_amdgcn_fence(__ATOMIC_ACQUIRE, "agent");
            asm volatile("s_waitcnt vmcnt(0)" ::: "memory");
        }
    }
    __syncthreads();
}

struct Args { const float* in[21]; float* out; unsigned char* ws; };
template <int MODE> __device__ __forceinline__ bool attn_item(int i, int G, int bx, int& s, int& x) {
    constexpr int NS = MODE == 0 ? 64 : 32;
    if ((G & 7) == 0) { const int xcd = bx & 7, k = bx >> 3, kpx = G >> 3; const int idx = k + i * kpx; if (idx >= (NS / 8) * 32) return false; s = (idx >> 5) * 8 + xcd; x = idx & 31; return true; }
    const int L = bx + i * G; if (L >= NS * 32) return false; s = L >> 5; x = L & 31; return true;
}
template <int MODE> __device__ __forceinline__ att::BlockRef attn_ref(int s, int qb, int jlo, const bf16* QKV, bf16* Obuf, const float* CB) {
    att::BlockRef r; r.P0 = qb * 256; r.jlo = jlo;
    if (MODE == 0) { const int xcd = s & 7, sl = s >> 3, vh = sl & 1, c = (sl >> 1) & 1, bh = xcd * 2 + ((sl >> 2) & 1), b = bh >> 3, h = bh & 7;
        const bf16* base = QKV + (size_t)b * SEQ * NQKV;
        r.Q = base + (size_t)r.P0 * NQKV + h * 256 + c * 128; r.K = base + 2048 + h * 256 + c * 128; r.V = base + 4096 + h * 256 + vh * 128;
        r.O = Obuf + (size_t)c * TOK * DM + ((size_t)b * SEQ + r.P0) * DM + h * 256 + vh * 128; r.CB = nullptr; r.h = h; }
    else { const int b = s >> 4, h = s & 15; const bf16* base = QKV + (size_t)b * SEQ * NQKV;
        r.Q = base + (size_t)r.P0 * NQKV + h * 128; r.K = base + 2048 + h * 128; r.V = base + 4096 + h * 128;
        r.O = Obuf + ((size_t)b * SEQ + r.P0) * DM + h * 128; r.CB = CB + (size_t)s * SEQ; r.h = 0; }
    return r;
}
template <int MODE> __device__ __forceinline__ void attn_phase(char* lds, const bf16* QKV, bf16* Obuf, const float* CB, const unsigned* NRM, int G, int bx) {
    int* jt = (int*)(lds + att::OFF_TB);
    if (MODE == 1) {
        int tid = threadIdx.x; asm volatile("" : "+v"(tid)); const int w = __builtin_amdgcn_readfirstlane(tid >> 6), lane = tid & 63;
        if (tid < 64) jt[tid] = 0;
        __syncthreads();
        for (int e = w; e < 64; e += 8) { int s, x; if (!attn_item<MODE>(e >> 1, G, bx, s, x)) break;
            const int qb = (e & 1) ? 63 - x : x, jmax = qb * 4; const float* cb = CB + (size_t)s * SEQ;
            const float qn = sqrtf(__uint_as_float(NRM[s * 2])) * 1.01f, kn = sqrtf(__uint_as_float(NRM[s * 2 + 1])) * 1.01f;
            const float thr = cb[qb * 256] - 110.f * 11.313708498984761f - 2.f * qn * kn;
            int need = 0;
            for (int j0 = jmax - 1; j0 >= 0; j0 -= 64) { const int j = j0 - lane; const bool c = (j >= 0) && (cb[(j >= 0 ? j : 0) * 64 + 63] >= thr);
                const unsigned long long m = __ballot(c); const int n = __builtin_popcountll(m); need += n; if (n < 64) break; }
            if (lane == 0) jt[e] = jmax - need; }
        __syncthreads();
    }
    for (int i = 0; ; ++i) { int s, x; if (!attn_item<MODE>(i, G, bx, s, x)) break;
        for (int pass = 0; pass < 2; ++pass) {
            const int jl = (MODE == 1 && i < 32) ? jt[i * 2 + pass] : 0;
            const att::BlockRef cur = attn_ref<MODE>(s, pass ? 63 - x : x, jl, QKV, Obuf, CB);
            att::attn_block<MODE>(cur, lds); } }
}

__global__ void __launch_bounds__(NWAVES * 64, 2) yoco_fwd(Args args) {
    extern __shared__ __attribute__((aligned(16))) unsigned char lds[];
    cg::grid_group grid = cg::this_grid();
    LAS unsigned char* ldsl = (LAS unsigned char*)lds;
    const int G = gridDim.x, bx = blockIdx.x, NGW = G * NWAVES;
    int tid, lane, wave, gw;
#define FRESH() do { tid = threadIdx.x; asm volatile("" : "+v"(tid)); lane = tid & 63; wave = __builtin_amdgcn_readfirstlane(tid >> 6); gw = bx * NWAVES + wave; } while (0)
    FRESH();
#define WSP(T, off) ((T*)(launder_p(args.ws) + (off)))
#define Wqkv0 WSP(bf16, WS_WQKV0)
#define Woa WSP(bf16, WS_WOA)
#define Wmi0 WSP(bf16, WS_WMI0)
#define Wmo0 WSP(bf16, WS_WMO0)
#define Wqkv1 WSP(bf16, WS_WQKV1)
#define Wob WSP(bf16, WS_WOB)
#define Wmi1 WSP(bf16, WS_WMI1)
#define Wmo1 WSP(bf16, WS_WMO1)
#define QKV WSP(bf16, WS_QKV)
#define OC WSP(bf16, WS_OC)
#define HID WSP(bf16, WS_HID)
#define XN WSP(bf16, WS_XN)
#define Fb WSP(float, WS_F)
#define CB WSP(float, WS_CB)
#define NRM WSP(unsigned, WS_NRM)
#define RS WSP(float, WS_RS)
#define HB WSP(bf16, WS_HB)
#define out ((float*)launder_p((unsigned char*)args.out))
#define XIN ((const float*)launder_p((unsigned char*)args.in[0]))
    volatile LAS unsigned* xst = (volatile LAS unsigned*)(ldsl + LDS_BYTES - 64);
    if (tid < 2) xst[tid] = 0u;
    __syncthreads();
    const XcdBarrier xbar = xcd_barrier_post(WSP(unsigned, WS_BAR), xst);

    {
        LAS float* scr = (LAS float*)(ldsl + wave * 16384);
        bf16* const wqkv1 = Wqkv1;
        const float* ag = args.in[2]; const float* mg = args.in[3]; const float* kg = args.in[11];
        constexpr int I_QKV = (DM / 64) * (NQKV / 32), I_DD = (DM / 64) * (DM / 32), I_MI = (DM / 64) * (FF / 32), I_MO = (FF / 64) * (DM / 32);
        constexpr int NITEMS = I_QKV + 5 * I_DD + 2 * I_MI + 2 * I_MO;
        for (int it = gw; it < NITEMS; it += NGW) {
            int r = it;
            if (r < I_QKV) { transpose_item(args.in[4], DM, NQKV, Wqkv0, 0, ag, scr, r, lane); continue; } r -= I_QKV;
            if (r < I_DD) { transpose_item(args.in[10], DM, DM, Woa, 0, nullptr, scr, r, lane); continue; } r -= I_DD;
            if (r < I_DD) { transpose_item(args.in[16], DM, DM, wqkv1, 0, ag + DM, scr, r, lane); continue; } r -= I_DD;
            if (r < I_DD) { transpose_item(args.in[12], DM, DM, wqkv1, DM, kg, scr, r, lane); continue; } r -= I_DD;
            if (r < I_DD) { transpose_item(args.in[13], DM, DM, wqkv1, 2 * DM, kg, scr, r, lane); continue; } r -= I_DD;
            if (r < I_DD) { transpose_item(args.in[17], DM, DM, Wob, 0, nullptr, scr, r, lane); continue; } r -= I_DD;
            if (r < I_MI) { transpose_item(args.in[18], DM, FF, Wmi0, 0, mg, scr, r, lane); continue; } r -= I_MI;
            if (r < I_MI) { transpose_item(args.in[18] + (size_t)DM * FF, DM, FF, Wmi1, 0, mg + DM, scr, r, lane); continue; } r -= I_MI;
            if (r < I_MO) { transpose_item(args.in[19], FF, DM, Wmo0, 0, nullptr, scr, r, lane); continue; } r -= I_MO;
            transpose_item(args.in[19] + (size_t)FF * DM, FF, DM, Wmo1, 0, nullptr, scr, r, lane);
        }
        { const float* wf = args.in[14]; const int gt = bx * 512 + tid, NT_ = G * 512;
          for (int e = gt; e < (NQKV1 - NQKV) * DM; e += NT_) { const int n = e / DM, k = e % DM; wqkv1[(size_t)(NQKV + n) * DM + k] = (n < FH) ? (bf16)f2bf(wf[(size_t)k * FH + n] * kg[k]) : (bf16)0; } }
        if (bx == 0 && tid < 64) NRM[tid] = 0u;
        { float* rsz = RS; for (int e = bx * 512 + tid; e < 4 * TOK; e += G * 512) rsz[e] = 0.f; }
        norm_phase(XIN, XN, gw, NGW, lane);
    }
    grid.sync();
#define GSYNC() xcd_barrier(xbar)
#define GEMM_PHASE(EPI, A_, B_, N_, K_, ...) do { pg8::Gemm g{A_, B_, TOK, N_, K_}; pg8::StaticOrder S; S.init(TOK, N_, G, bx); EPI E{__VA_ARGS__}; \
        pg8::gemm_phase<EPI, pg8::StaticOrder, PG8_ALIGN, PG8_SP2>(ldsl, g, S, E); } while (0)
    typedef pg8::EpiX<0, false, false, false> EpiQKV0; typedef pg8::EpiX<3, true, false, false> EpiQKV1; typedef pg8::EpiX<1, true, false, false> EpiMlpIn;
    typedef pg8::EpiX<2, false, true, true> EpiRes; typedef pg8::EpiX<2, false, false, true> EpiResLast;
    GEMM_PHASE(EpiQKV0, XN, Wqkv0, NQKV, DM, QKV, NQKV, nullptr, nullptr, nullptr, nullptr, nullptr);
    GSYNC();
    {
      FRESH(); const float* tab = args.in[1]; float* tb = (float*)(lds + att::OFF_TB);
      for (int idx = tid; idx < 2048; idx += 512) { const int h = idx >> 8, rel = (idx & 255) - 192; const int n = rel < 0 ? -rel : rel;
          int bk = n < 8 ? n : 8 + (n >= 12) + (n >= 16) + (n >= 23) + (n >= 32) + (n >= 46) + (n >= 64) + (n >= 91); if (rel > 0) bk += 16;
          tb[idx] = (tab[bk * 8 + h] - tab[15 * 8 + h]) * 11.313708498984761f; }
      __syncthreads();
      attn_phase<0>((char*)lds, QKV, OC, nullptr, nullptr, G, bx);
    }
    GSYNC();
    FRESH(); combine_phase(OC, XN, args.in[5], args.in[6], args.in[7], args.in[8], args.in[9], gw, NGW, lane);
    GSYNC();
    GEMM_PHASE(EpiRes, XN, Woa, DM, DM, HB, DM, XIN, out, nullptr, nullptr, RS);
    GSYNC();
    GEMM_PHASE(EpiMlpIn, HB, Wmi0, FF, DM, HID, FF, nullptr, nullptr, nullptr, RS, nullptr);
    GSYNC();
    GEMM_PHASE(EpiRes, HID, Wmo0, DM, FF, XN, DM, out, out, nullptr, nullptr, RS + TOK);
    GSYNC();
    GEMM_PHASE(EpiQKV1, XN, Wqkv1, NQKV1, DM, QKV, NQKV, nullptr, nullptr, Fb, RS + TOK, nullptr);
    GSYNC();
    FRESH(); cumsum_phase(Fb, args.in[15], CB, ldsl, bx, G, tid);
    rownorm_phase(QKV, NRM, bx, G, tid);
    GSYNC();
    attn_phase<1>((char*)lds, QKV, XN, CB, NRM, G, bx);
    GSYNC();
    GEMM_PHASE(EpiRes, XN, Wob, DM, DM, HB, DM, out, out, nullptr, nullptr, RS + 2 * TOK);
    GSYNC();
    GEMM_PHASE(EpiMlpIn, HB, Wmi1, FF, DM, HID, FF, nullptr, nullptr, nullptr, RS + 2 * TOK, nullptr);
    GSYNC();
    GEMM_PHASE(EpiResLast, HID, Wmo1, DM, FF, nullptr, DM, out, out, nullptr, nullptr, RS + 3 * TOK);
    GSYNC();
    FRESH(); final_norm_phase(out, args.in[20], RS + 3 * TOK, gw, NGW, lane);
}

#undef out
#undef XIN
extern "C" void kernel_launch(void* const* d_in, const int* in_sizes, int n_in, void* d_out, int out_size, void* d_ws, size_t ws_size, hipStream_t stream) {
    static int grid = 0;
    if (grid == 0) {
        if (n_in != 21 || in_sizes[0] != TOK * DM || out_size != TOK * DM || ws_size < WS_END) { fprintf(stderr, "kernel_launch: unexpected shapes (n_in %d, in0 %d, out %d, ws %zu)\n", n_in, n_in > 0 ? in_sizes[0] : -1, out_size, ws_size); grid = -1; return; }
        int dev = 0, cus = 0, per_cu = 0;
        (void)hipGetDevice(&dev); (void)hipDeviceGetAttribute(&cus, hipDeviceAttributeMultiprocessorCount, dev);
        if (hipFuncSetAttribute((const void*)yoco_fwd, hipFuncAttributeMaxDynamicSharedMemorySize, LDS_BYTES) != hipSuccess) { fprintf(stderr, "kernel_launch: hipFuncSetAttribute failed\n"); grid = -1; return; }
        if (hipOccupancyMaxActiveBlocksPerMultiprocessor(&per_cu, (const void*)yoco_fwd, NWAVES * 64, LDS_BYTES) != hipSuccess || per_cu < 1) { fprintf(stderr, "kernel_launch: occupancy query gives %d\n", per_cu); per_cu = 1; }
        (void)hipGetLastError();
        grid = cus > 0 ? cus : 256;
    }
    if (grid < 0) return;
    if (hipMemsetAsync((char*)d_ws + WS_BAR, 0, 16384, stream) != hipSuccess) { fprintf(stderr, "kernel_launch: hipMemsetAsync failed\n"); return; }
    Args a{};
    for (int i = 0; i < 21; ++i) a.in[i] = (const float*)d_in[i];
    a.out = (float*)d_out; a.ws = (unsigned char*)d_ws;
    void* kargs[] = {&a};
    hipError_t e = hipLaunchCooperativeKernel((const void*)yoco_fwd, dim3(grid), dim3(NWAVES * 64), kargs, LDS_BYTES, stream);
    if (e != hipSuccess) fprintf(stderr, "kernel_launch: cooperative launch failed: %s (grid %d)\n", hipGetErrorString(e), grid);
}
```

```cpp
#include <hip/hip_runtime.h>
#include <hip/hip_cooperative_groups.h>
#include <cstdio>
#include <cstdint>
namespace cg = cooperative_groups;
namespace pg8 {
#define PG8_LAS __attribute__((address_space(3)))
typedef unsigned short bf16_t;
typedef short bf16x8 __attribute__((ext_vector_type(8)));
typedef float f32x4 __attribute__((ext_vector_type(4)));
typedef unsigned u32x4 __attribute__((ext_vector_type(4)));
constexpr int BM = 256, BK = 64, HALF = 128, HTB = HALF * BK * 2  , STAGE_BYTES = 8 * HTB, NXCD = 8, WGM = 8;

__host__ __device__ __forceinline__ int lds_byte(int r, int c) { const int st = (r >> 4) * 2 + (c >> 5), rr = r & 15, cc = c & 31, ob = rr * 64 + cc * 2; return st * 1024 + (ob ^ (((ob >> 9) & 1) << 5)); }
__host__ __device__ __forceinline__ void stage_rc(int b, int& R, int& C) { const int st = b / 1024, sb = b % 1024, swz = sb ^ (((sb >> 9) & 1) << 5); R = (st >> 1) * 16 + swz / 64; C = (st & 1) * 32 + (swz % 64) / 2; }
__host__ __device__ __forceinline__ int perm32(int rho) { const int n = rho >> 4, i = rho & 15; return 8 * (i >> 2) + 4 * n + (i & 3); }

struct Unit { int pm, pn; };
struct Gemm { const bf16_t* A; const bf16_t* Bt; int M, N, K; };

struct StaticOrder {
    int nM, nN, nwg, G, c;
    __host__ __device__ void init(int M, int N, int G_, int c_) { nM = M / BM; nN = N / BM; nwg = nM * nN; G = G_; c = c_; }
    __host__ __device__ bool next(int i, Unit& u) const {
        const long L = (long)i * G + c; if (L >= nwg) return false;
        int wgid = (int)L; { const int q = nwg / NXCD, r = nwg % NXCD, xcd = wgid % NXCD, off = wgid / NXCD; wgid = (xcd < r ? xcd * (q + 1) : r * (q + 1) + (xcd - r) * q) + off; }
        const int nig = WGM * nN, gid = wgid / nig, fm = gid * WGM, gsz = (nM - fm) < WGM ? (nM - fm) : WGM;
        u.pm = fm + ((wgid % nig) % gsz); u.pn = (wgid % nig) / gsz; return true;
    }
    __device__ __forceinline__ void a_ready(const Unit&) const {}
    __device__ __forceinline__ void done(const Unit&) const {}
};

__device__ __forceinline__ unsigned cvt_pk_bf16(float lo, float hi) { unsigned r; asm volatile("v_cvt_pk_bf16_f32 %0, %1, %2" : "=v"(r) : "v"(lo), "v"(hi)); return r; }
typedef float f32x2 __attribute__((ext_vector_type(2)));
template <int MODE, bool RS_IN, bool COPY, bool SUMSQ> struct EpiX {
    static constexpr bool PERM = true, AFTER_DRAIN = false;
    bf16_t* O; int ldc; const float* base; float* out; float* F; const float* rs_in; float* rs_out;
    __device__ __forceinline__ void operator()(const f32x4 (&acc)[2][2][4][2], const Unit& u, int wr, int wc, int fr, int fq) const {
        const int row0 = u.pm * BM + wr * 64 + fr, col0 = u.pn * BM + wc * 32 + 8 * fq;
        const bool ftile = (MODE == 3) && (u.pn * BM >= 6144);
#pragma unroll
        for (int ai = 0; ai < 2; ++ai)
#pragma unroll
            for (int m = 0; m < 4; ++m) { const size_t row = (size_t)(row0 + ai * HALF + m * 16);
                float rs = 1.f; if (RS_IN) rs = 1.f / sqrtf(rs_in[row] * (1.f / 2048.f) + 1e-6f);
                float ss = 0.f;
#pragma unroll
                for (int bj = 0; bj < 2; ++bj) { f32x4 v0 = acc[ai][bj][m][0], v1 = acc[ai][bj][m][1]; const int col = col0 + bj * HALF;
                    if (RS_IN) { v0 = v0 * rs; v1 = v1 * rs; }
                    if (MODE == 2) { const float* bp = base + row * ldc + col; float* op = out + row * ldc + col;
                        const f32x4 b0 = *(const f32x4*)bp, b1 = *(const f32x4*)(bp + 4); v0 = b0 + v0; v1 = b1 + v1; *(f32x4*)op = v0; *(f32x4*)(op + 4) = v1;
                        if (SUMSQ) ss += (v0[0] * v0[0] + v0[1] * v0[1]) + (v0[2] * v0[2] + v0[3] * v0[3]) + (v1[0] * v1[0] + v1[1] * v1[1]) + (v1[2] * v1[2] + v1[3] * v1[3]);
                        if (COPY) { u32x4 w; w.x = cvt_pk_bf16(v0[0], v0[1]); w.y = cvt_pk_bf16(v0[2], v0[3]); w.z = cvt_pk_bf16(v1[0], v1[1]); w.w = cvt_pk_bf16(v1[2], v1[3]); *(u32x4*)(O + row * ldc + col) = w; } }
                    else if (ftile) { if (bj == 0 && wc == 0 && fq < 2) { float* fp = F + row * 16 + 8 * fq; *(f32x4*)fp = v0; *(f32x4*)(fp + 4) = v1; } }
                    else { if (MODE == 1) {
#pragma unroll
                            for (int e = 0; e < 4; ++e) { const float a = fmaxf(v0[e], 0.f), b = fmaxf(v1[e], 0.f); v0[e] = a * a; v1[e] = b * b; } }
                        u32x4 w; w.x = cvt_pk_bf16(v0[0], v0[1]); w.y = cvt_pk_bf16(v0[2], v0[3]); w.z = cvt_pk_bf16(v1[0], v1[1]); w.w = cvt_pk_bf16(v1[2], v1[3]);
                        *(u32x4*)(O + row * ldc + col) = w; } }
                if (SUMSQ) { ss += __shfl_xor(ss, 16); ss += __shfl_xor(ss, 32); if (fq == 0) atomicAdd(rs_out + row, ss); }
                if (MODE == 2) asm volatile("" ::: "memory"); }
    }
};
template <class Epi, class Sched, bool ALIGN_EPI = false, bool SP2 = false>
__device__ __forceinline__ void gemm_phase(PG8_LAS unsigned char* lds, const Gemm g, const Sched& S, const Epi& E) {
    int tid = threadIdx.x; asm volatile("" : "+v"(tid));
    const int wid = __builtin_amdgcn_readfirstlane(tid >> 6), lane = tid & 63, wr = wid >> 2, wc = wid & 3, fr = lane & 15, fq = lane >> 4;
    const int K = g.K, nt = K / BK;
    unsigned voffA[2], voffB[2];
#pragma unroll
    for (int i = 0; i < 2; ++i) { int R, C; stage_rc(tid * 16 + i * 8192, R, C); const int Rb = Epi::PERM ? ((R & ~31) + perm32(R & 31)) : R;
        voffA[i] = (unsigned)(R * K + C) * 2u; voffB[i] = (unsigned)(Rb * K + C) * 2u; }
    const size_t kstep = (size_t)(BK * 2);
    const size_t hstep = (size_t)HALF * K * 2;
    const size_t tstep = 2 * hstep;
    const unsigned ldsw = (unsigned)wid * 1024u;
    const int aoff = lds_byte(wr * 64 + fr, fq * 8), boff = lds_byte(wc * 32 + fr, fq * 8);
#define PG8_SA(b, h) (((b) * 2 + (h)) * HTB)
#define PG8_SB(b, h) ((4 + (b) * 2 + (h)) * HTB)
#define PG8_STAGE(bufoff, gbase, voff) do { _Pragma("unroll") for (int _i = 0; _i < 2; ++_i) \
        __builtin_amdgcn_global_load_lds((const unsigned*)((const char*)(gbase) + (voff)[_i]), (PG8_LAS unsigned*)(lds + (bufoff) + ldsw + _i * 8192), 16, 0, 0); } while (0)
#define PG8_LDA(dst, b, h) do { _Pragma("unroll") for (int m = 0; m < 4; ++m) _Pragma("unroll") for (int k = 0; k < 2; ++k) dst[m][k] = *(const PG8_LAS bf16x8*)(lds + PG8_SA(b, h) + aoff + m * 2048 + k * 1024); } while (0)
#define PG8_LDB(dst, b, h) do { _Pragma("unroll") for (int n = 0; n < 2; ++n) _Pragma("unroll") for (int k = 0; k < 2; ++k) dst[n][k] = *(const PG8_LAS bf16x8*)(lds + PG8_SB(b, h) + boff + n * 2048 + k * 1024); } while (0)
#define PG8_MMA(ai, bj, At, Bt) do { __builtin_amdgcn_s_setprio(1); _Pragma("unroll") for (int m = 0; m < 4; ++m) _Pragma("unroll") for (int n = 0; n < 2; ++n) _Pragma("unroll") for (int k = 0; k < 2; ++k) \
        acc[ai][bj][m][n] = __builtin_amdgcn_mfma_f32_16x16x32_bf16(Bt[n][k], At[m][k], acc[ai][bj][m][n], 0, 0, 0); __builtin_amdgcn_s_setprio(0); } while (0)
#define PG8_WAIT_V(n) asm volatile("s_waitcnt vmcnt(" #n ")" ::: "memory")
#define PG8_WAIT_L(n) asm volatile("s_waitcnt lgkmcnt(" #n ")" ::: "memory")
#define PG8_BAR __builtin_amdgcn_s_barrier()
#define PG8_SCHED __builtin_amdgcn_sched_barrier(0)
    Unit cur, nxt; int ui = 0;
    if (!S.next(0, cur)) return;
    f32x4 acc[2][2][4][2];
#pragma unroll
    for (int a = 0; a < 2; ++a)
#pragma unroll
        for (int b = 0; b < 2; ++b)
#pragma unroll
            for (int m = 0; m < 4; ++m)
#pragma unroll
                for (int n = 0; n < 2; ++n) acc[a][b][m][n] = (f32x4){0.f, 0.f, 0.f, 0.f};
    bf16x8 At[4][2], B0[2][2], B1[2][2];
    const char* cA = (const char*)g.A + (size_t)cur.pm * tstep; const char* cB = (const char*)g.Bt + (size_t)cur.pn * tstep;
    S.a_ready(cur);
    if constexpr (SP2) {
        PG8_STAGE(PG8_SB(0, 0), cB, voffB); PG8_STAGE(PG8_SB(0, 1), cB + hstep, voffB); PG8_STAGE(PG8_SA(0, 0), cA, voffA); PG8_STAGE(PG8_SA(0, 1), cA + hstep, voffA);
        if (wr == 1) PG8_BAR;
        PG8_WAIT_V(2); PG8_BAR;
        PG8_STAGE(PG8_SB(1, 0), cB + kstep, voffB); PG8_STAGE(PG8_SA(1, 0), cA + kstep, voffA); PG8_STAGE(PG8_SB(1, 1), cB + hstep + kstep, voffB);
        PG8_WAIT_V(6); PG8_BAR;
    } else {
        PG8_STAGE(PG8_SB(0, 0), cB, voffB); PG8_STAGE(PG8_SA(0, 0), cA, voffA); PG8_STAGE(PG8_SB(0, 1), cB + hstep, voffB); PG8_STAGE(PG8_SA(0, 1), cA + hstep, voffA);
        if (wr == 1) PG8_BAR;
        PG8_WAIT_V(4); PG8_BAR;
        PG8_STAGE(PG8_SB(1, 0), cB + kstep, voffB); PG8_STAGE(PG8_SA(1, 0), cA + kstep, voffA); PG8_STAGE(PG8_SB(1, 1), cB + hstep + kstep, voffB);
        PG8_WAIT_V(6); PG8_BAR;
    }
    for (;;) {
        const bool has_next = S.next(ui + 1, nxt);
        const char* nA = has_next ? (const char*)g.A + (size_t)nxt.pm * tstep : cA; const char* nB = has_next ? (const char*)g.Bt + (size_t)nxt.pn * tstep : cB;
        for (int t = 0; t < nt; t += 2) {
            const bool last = (t == nt - 2);
            const char* a1 = cA + (size_t)(t + 1) * kstep;
            const char* a2 = last ? nA : cA + (size_t)(t + 2) * kstep; const char* b2 = last ? nB : cB + (size_t)(t + 2) * kstep;
            const char* a3 = a2 + kstep; const char* b3 = b2 + kstep;
            if (last && has_next) S.a_ready(nxt);
            if constexpr (SP2) {
            PG8_LDB(B0, 0, 0); PG8_LDB(B1, 0, 1); PG8_SCHED; PG8_LDA(At, 0, 0); PG8_STAGE(PG8_SA(1, 1), a1 + hstep, voffA);
            PG8_WAIT_V(8); PG8_WAIT_L(0); PG8_BAR; PG8_MMA(0, 0, At, B0); PG8_MMA(0, 1, At, B1); PG8_BAR; PG8_SCHED;
            PG8_LDA(At, 0, 1); PG8_STAGE(PG8_SB(0, 0), b2, voffB); PG8_STAGE(PG8_SB(0, 1), b2 + hstep, voffB); PG8_STAGE(PG8_SA(0, 0), a2, voffA);
            PG8_WAIT_V(8); PG8_WAIT_L(0); PG8_BAR; PG8_MMA(1, 0, At, B0); PG8_MMA(1, 1, At, B1); PG8_BAR; PG8_SCHED;
            PG8_LDB(B0, 1, 0); PG8_LDB(B1, 1, 1); PG8_SCHED; PG8_LDA(At, 1, 0); PG8_STAGE(PG8_SA(0, 1), a2 + hstep, voffA);
            PG8_WAIT_V(8); PG8_WAIT_L(0); PG8_BAR; PG8_MMA(0, 0, At, B0); PG8_MMA(0, 1, At, B1); PG8_BAR; PG8_SCHED;
            PG8_LDA(At, 1, 1); PG8_STAGE(PG8_SB(1, 0), b3, voffB); PG8_STAGE(PG8_SB(1, 1), b3 + hstep, voffB); PG8_STAGE(PG8_SA(1, 0), a3, voffA);
            PG8_WAIT_V(8); PG8_WAIT_L(0); PG8_BAR; PG8_MMA(1, 0, At, B0); PG8_MMA(1, 1, At, B1); PG8_BAR; PG8_SCHED;
            } else {
            PG8_LDB(B0, 0, 0); PG8_SCHED; PG8_LDA(At, 0, 0); PG8_STAGE(PG8_SA(1, 1), a1 + hstep, voffA);
            PG8_WAIT_L(8); PG8_BAR; PG8_WAIT_L(0); PG8_MMA(0, 0, At, B0); PG8_BAR; PG8_SCHED;
            PG8_LDB(B1, 0, 1); PG8_STAGE(PG8_SB(0, 0), b2, voffB);
            PG8_BAR; PG8_WAIT_L(0); PG8_MMA(0, 1, At, B1); PG8_BAR;
            PG8_LDA(At, 0, 1); PG8_STAGE(PG8_SA(0, 0), a2, voffA);
            PG8_BAR; PG8_WAIT_L(0); PG8_MMA(1, 0, At, B0); PG8_BAR; PG8_SCHED;
            PG8_STAGE(PG8_SB(0, 1), b2 + hstep, voffB);
            PG8_WAIT_V(6); PG8_BAR; PG8_MMA(1, 1, At, B1); PG8_BAR;
            PG8_LDB(B0, 1, 0); PG8_SCHED; PG8_LDA(At, 1, 0); PG8_STAGE(PG8_SA(0, 1), a2 + hstep, voffA);
            PG8_WAIT_L(8); PG8_BAR; PG8_WAIT_L(0); PG8_MMA(0, 0, At, B0); PG8_BAR; PG8_SCHED;
            PG8_LDB(B1, 1, 1); PG8_STAGE(PG8_SB(1, 0), b3, voffB);
            PG8_BAR; PG8_WAIT_L(0); PG8_MMA(0, 1, At, B1); PG8_BAR;
            PG8_LDA(At, 1, 1); PG8_STAGE(PG8_SA(1, 0), a3, voffA);
            PG8_BAR; PG8_WAIT_L(0); PG8_MMA(1, 0, At, B0); PG8_BAR; PG8_SCHED;
            PG8_STAGE(PG8_SB(1, 1), b3 + hstep, voffB);
            PG8_WAIT_V(6); PG8_BAR; PG8_MMA(1, 1, At, B1); PG8_BAR;
            }
        }
        if constexpr (ALIGN_EPI) { if (wr == 0) PG8_BAR; }
        if constexpr (!Epi::AFTER_DRAIN) { E(acc, cur, wr, wc, fr, fq); S.done(cur); }
        if (!has_next) break;
#pragma unroll
        for (int a = 0; a < 2; ++a)
#pragma unroll
            for (int b = 0; b < 2; ++b)
#pragma unroll
                for (int m = 0; m < 4; ++m)
#pragma unroll
                    for (int n = 0; n < 2; ++n) acc[a][b][m][n] = (f32x4){0.f, 0.f, 0.f, 0.f};
        cur = nxt; cA = nA; cB = nB; ++ui;
        if constexpr (ALIGN_EPI) { if (wr == 1) PG8_BAR; }
    }
    PG8_WAIT_V(0);
    if constexpr (!ALIGN_EPI) { if (wr == 0) PG8_BAR; }
    PG8_BAR;
    if constexpr (Epi::AFTER_DRAIN) { E.fused(acc, cur, wr, wc, fr, fq, lds, wid, lane); S.done(cur); }
#undef PG8_SA
#undef PG8_SB
#undef PG8_STAGE
#undef PG8_LDA
#undef PG8_LDB
#undef PG8_MMA
#undef PG8_WAIT_V
#undef PG8_WAIT_L
#undef PG8_BAR
#undef PG8_SCHED
}
}
#ifndef PG8_SP2
#define PG8_SP2 true
#endif
#ifndef PG8_ALIGN
#define PG8_ALIGN true
#endif
namespace att {
typedef unsigned short bf16;
typedef short bf16x8 __attribute__((ext_vector_type(8)));
typedef short s16x4 __attribute__((ext_vector_type(4)));
typedef float f32x16 __attribute__((ext_vector_type(16)));
typedef float f32x4 __attribute__((ext_vector_type(4)));
typedef unsigned u32x4 __attribute__((ext_vector_type(4)));
constexpr int D = 128, NW = 8, QBLK = 32, KVBLK = 64, QB = NW * QBLK, LDQ = 6144, LDO = 2048;
constexpr float SCALE = 0.08838834764831845f, THR = 8.f;
constexpr int SHM_V = KVBLK * D * 2, SHM_K = KVBLK * D * 2, NSLOT = 3;
constexpr int OFF_V = 0, OFF_K = NSLOT * SHM_V, OFF_WS = OFF_K + NSLOT * SHM_K, OFF_CL = OFF_WS + NW * 64 * 4, OFF_TB = OFF_CL + NSLOT * 256, LDS_BYTES = OFF_TB + 8192;
#define KSWZ(row, colB) ((row) * 256 + ((colB) ^ (((row) & 7) << 4)))
#define SBAR() __builtin_amdgcn_sched_barrier(0)
__device__ __forceinline__ int v_st(int k, int c) { const int kk = (k & ~0xC) | ((k & 4) << 1) | ((k & 8) >> 1); return ((kk >> 3) * 4 + (c >> 5)) * 512 + ((kk & 7) * 32 + (c & 31)) * 2; }
__device__ __forceinline__ int v_rd_base(int lane) { return ((lane & 3) << 3) | (((lane >> 2) & 3) << 6) | (((lane >> 4) & 1) << 5) | (((lane >> 5) & 1) << 8); }
constexpr int v_rd_off(int d0, int ks, int half) { return d0 * 512 + ks * 4096 + half * 2048; }
__device__ __forceinline__ int crow(int r, int hi) { return (r & 3) + 8 * (r >> 2) + 4 * hi; }
__device__ __forceinline__ unsigned cvtpk(float lo, float hi) { unsigned r; asm volatile("v_cvt_pk_bf16_f32 %0, %1, %2" : "=v"(r) : "v"(lo), "v"(hi)); return r; }
__device__ __forceinline__ void mask_tile(f32x16& p0, f32x16& p1, int dq, unsigned W) {
    const float NEG = -__builtin_inff();
#pragma unroll
    for (int r = 0; r < 16; ++r) { const int c = (r & 3) + 8 * (r >> 2);
        if ((unsigned)(dq - c) >= W) p0[r] = NEG;
        if ((unsigned)(dq - c - 32) >= W) p1[r] = NEG; }
}
__device__ __forceinline__ void add_bias(f32x16& p0, f32x16& p1, const float* tb, int relbase) {
    const float* t = tb + relbase;
#pragma unroll
    for (int r = 0; r < 16; ++r) { const int c = (r & 3) + 8 * (r >> 2); p0[r] += t[c]; p1[r] += t[c + 32]; }
}
__device__ __forceinline__ void partialSM(f32x16& p0, f32x16& p1, float& m_reg, float& mn, float& alpha) {
    float pmax = p0[0]; for (int r = 1; r < 16; ++r) pmax = fmaxf(pmax, p0[r]); for (int r = 0; r < 16; ++r) pmax = fmaxf(pmax, p1[r]);
    { auto rr = __builtin_amdgcn_permlane32_swap(__float_as_uint(pmax), __float_as_uint(pmax), false, false);
      pmax = fmaxf(__uint_as_float(rr[0]), __uint_as_float(rr[1])); }
    constexpr float C2 = 1.4426950408889634f * SCALE;
    if (__builtin_expect(__all((pmax - m_reg) * SCALE <= THR), 1)) { mn = m_reg; alpha = 1.f; }
    else { mn = fmaxf(m_reg, pmax); alpha = __builtin_amdgcn_exp2f((m_reg - mn) * C2); m_reg = mn; }
    const float mnL = -mn * C2;
    for (int r = 0; r < 16; ++r) p0[r] = fmaf(p0[r], C2, mnL); for (int r = 0; r < 16; ++r) p1[r] = fmaf(p1[r], C2, mnL);
    for (int r = 0; r < 16; ++r) p0[r] = __builtin_amdgcn_exp2f(p0[r]);
}
__device__ __forceinline__ void finishSM(f32x16& p0, f32x16& p1, float alpha, float& l_reg, bf16x8& pa0, bf16x8& pa1, bf16x8& pa2, bf16x8& pa3) {
    for (int r = 0; r < 16; ++r) p1[r] = __builtin_amdgcn_exp2f(p1[r]);
    float ps = 0; for (int r = 0; r < 16; ++r) ps += p0[r]; for (int r = 0; r < 16; ++r) ps += p1[r];
    { auto rr = __builtin_amdgcn_permlane32_swap(__float_as_uint(ps), __float_as_uint(ps), false, false);
      ps = __uint_as_float(rr[0]) + __uint_as_float(rr[1]); }
    l_reg = l_reg * alpha + ps;
#define PK4(P, B_, OUT) do { unsigned a0 = cvtpk(P[B_+0], P[B_+1]), a1 = cvtpk(P[B_+2], P[B_+3]);                          \
        unsigned b0 = cvtpk(P[B_+4], P[B_+5]), b1 = cvtpk(P[B_+6], P[B_+7]);                                             \
        auto r0 = __builtin_amdgcn_permlane32_swap(a0, b0, false, false); auto r1 = __builtin_amdgcn_permlane32_swap(a1, b1, false, false); \
        u32x4 w = {r0[0], r1[0], r0[1], r1[1]}; OUT = *reinterpret_cast<bf16x8*>(&w); } while (0)
    PK4(p0, 0, pa0); PK4(p0, 8, pa1); PK4(p1, 0, pa2); PK4(p1, 8, pa3);
#undef PK4
}
template <bool SK, int MODE>
__device__ __forceinline__ void qkt(f32x16& p0, f32x16& p1, const char* lds, int kslot  , int cslot  , int r32, int hi, const bf16x8* qr, bool act) {
    if (SK && !act) { const float NEG = -__builtin_inff();
#pragma unroll
        for (int r = 0; r < 16; ++r) { p0[r] = NEG; p1[r] = NEG; } return; }
    if (MODE == 1) { const float* cl = (const float*)(lds + OFF_CL) + cslot + 4 * hi;
#pragma unroll
        for (int g = 0; g < 4; ++g) { const f32x4 a = *(const f32x4*)(cl + 8 * g), b = *(const f32x4*)(cl + 32 + 8 * g);
            p0[4 * g] = a[0]; p0[4 * g + 1] = a[1]; p0[4 * g + 2] = a[2]; p0[4 * g + 3] = a[3];
            p1[4 * g] = b[0]; p1[4 * g + 1] = b[1]; p1[4 * g + 2] = b[2]; p1[4 * g + 3] = b[3]; } }
    else { p0 = f32x16{}; p1 = f32x16{}; }
    const char* K_lds = lds + OFF_K + kslot;
    const char* kb[4];
#pragma unroll
    for (int dd = 0; dd < 4; ++dd) kb[dd] = K_lds + KSWZ(r32, (dd * 16 + hi * 8) * 2);
#pragma unroll
    for (int d0 = 0; d0 < 8; ++d0) { const char* a = kb[d0 & 3] + (d0 >> 2) * 128;
        bf16x8 b0 = *reinterpret_cast<const bf16x8*>(a);
        bf16x8 b1 = *reinterpret_cast<const bf16x8*>(a + 32 * 256);
        p0 = __builtin_amdgcn_mfma_f32_32x32x16_bf16(b0, qr[d0], p0, 0, 0, 0);
        p1 = __builtin_amdgcn_mfma_f32_32x32x16_bf16(b1, qr[d0], p1, 0, 0, 0); }
}
template <bool SK>
__device__ __forceinline__ void pv_tile(f32x16* o, int vb0  , bf16x8 pa0, bf16x8 pa1, bf16x8 pa2, bf16x8 pa3, bool act) {
    if (SK && !act) return;
#define TRRD(dst, off) asm volatile("ds_read_b64_tr_b16 %0, %1 offset:%2" : "=&v"(dst) : "v"(vb0), "i"(off) : "memory")
#define RD_D0(d0, L0, H0, L1, H1, L2, H2, L3, H3) do { constexpr int b_ = v_rd_off(d0, 0, 0); \
        TRRD(L0, b_); TRRD(H0, b_ + 2048); TRRD(L1, b_ + 4096); TRRD(H1, b_ + 6144); TRRD(L2, b_ + 8192); TRRD(H2, b_ + 10240); TRRD(L3, b_ + 12288); TRRD(H3, b_ + 14336); } while (0)
#define MM_D0(d0, L0, H0, L1, H1, L2, H2, L3, H3) do { \
        o[d0] = __builtin_amdgcn_mfma_f32_32x32x16_bf16(pa0, (bf16x8){L0[0], L0[1], L0[2], L0[3], H0[0], H0[1], H0[2], H0[3]}, o[d0], 0, 0, 0);   \
        o[d0] = __builtin_amdgcn_mfma_f32_32x32x16_bf16(pa1, (bf16x8){L1[0], L1[1], L1[2], L1[3], H1[0], H1[1], H1[2], H1[3]}, o[d0], 0, 0, 0);   \
        o[d0] = __builtin_amdgcn_mfma_f32_32x32x16_bf16(pa2, (bf16x8){L2[0], L2[1], L2[2], L2[3], H2[0], H2[1], H2[2], H2[3]}, o[d0], 0, 0, 0);   \
        o[d0] = __builtin_amdgcn_mfma_f32_32x32x16_bf16(pa3, (bf16x8){L3[0], L3[1], L3[2], L3[3], H3[0], H3[1], H3[2], H3[3]}, o[d0], 0, 0, 0); } while (0)
    s16x4 al0, ah0, al1, ah1, al2, ah2, al3, ah3, bl0, bh0, bl1, bh1, bl2, bh2, bl3, bh3;
    SBAR();
    RD_D0(0, al0, ah0, al1, ah1, al2, ah2, al3, ah3);
    RD_D0(1, bl0, bh0, bl1, bh1, bl2, bh2, bl3, bh3);
    asm volatile("s_waitcnt lgkmcnt(8)" ::: "memory"); SBAR();
    MM_D0(0, al0, ah0, al1, ah1, al2, ah2, al3, ah3); SBAR();
    RD_D0(2, al0, ah0, al1, ah1, al2, ah2, al3, ah3);
    asm volatile("s_waitcnt lgkmcnt(8)" ::: "memory"); SBAR();
    MM_D0(1, bl0, bh0, bl1, bh1, bl2, bh2, bl3, bh3); SBAR();
    RD_D0(3, bl0, bh0, bl1, bh1, bl2, bh2, bl3, bh3);
    asm volatile("s_waitcnt lgkmcnt(8)" ::: "memory"); SBAR();
    MM_D0(2, al0, ah0, al1, ah1, al2, ah2, al3, ah3); SBAR();
    asm volatile("s_waitcnt lgkmcnt(0)" ::: "memory"); SBAR();
    MM_D0(3, bl0, bh0, bl1, bh1, bl2, bh2, bl3, bh3);
#undef MM_D0
#undef RD_D0
#undef TRRD
}
struct BlockRef { const bf16* Q; const bf16* K; const bf16* V; bf16* O; const float* CB; int P0, jlo, h; };
__device__ __forceinline__ void glds16(const void* sbase, unsigned voff, unsigned lds_dst) { unsigned keep;
    asm volatile("s_mov_b32 %0, m0\n\ts_mov_b32 m0, %3\n\ts_nop 0\n\tglobal_load_lds_dwordx4 %1, %2\n\ts_mov_b32 m0, %0" : "=&s"(keep) : "v"(voff), "s"(sbase), "s"(lds_dst) : "memory"); }
__device__ __forceinline__ void glds4(const void* sbase, unsigned voff, unsigned lds_dst) { unsigned keep;
    asm volatile("s_mov_b32 %0, m0\n\ts_mov_b32 m0, %3\n\ts_nop 0\n\tglobal_load_lds_dword %1, %2\n\ts_mov_b32 m0, %0" : "=&s"(keep) : "v"(voff), "s"(sbase), "s"(lds_dst) : "memory"); }
#define WAIT_BAR(N) asm volatile("s_waitcnt vmcnt(" #N ") lgkmcnt(0)\n\ts_barrier" ::: "memory")
#define LD8(p) (*reinterpret_cast<const bf16x8*>(p))
template <int MODE>
__device__ __forceinline__ void attn_block(const BlockRef& cur, char* lds) {
    constexpr bool SK = (MODE == 0);
    constexpr int NDMA = (MODE == 1) ? 5 : 4;
    int tid = threadIdx.x; asm volatile("" : "+v"(tid));
    const int wid = __builtin_amdgcn_readfirstlane(tid >> 6), lane = tid & 63, r32 = lane & 31, hi = lane >> 5;
    const int j_lo = cur.jlo, NT = cur.P0 / KVBLK + QB / KVBLK - j_lo;
    const int qlo = cur.P0 + wid * QBLK, qm = qlo + r32 - 4 * hi;
    float* ws = (float*)(lds + OFF_WS) + wid * 64; float* li_l = ws, * al_l = ws + 32;
    const float* tbh = (const float*)(lds + OFF_TB) + cur.h * 256;
    float m_reg = -1e30f, l_reg = 0; f32x16 o[4] = {};
    const unsigned lds0 = (unsigned)(uintptr_t)lds;
    const int vb0 = (int)lds0 + OFF_V + v_rd_base(lane);
    unsigned koff0, koff1, voff0, voff1;
    { const int pc = wid * 2; int row = pc * 4 + (lane >> 4), c = (lane & 15) ^ (row & 7); koff0 = (unsigned)((row * LDQ + c * 8) * 2);
      row += 4; c = (lane & 15) ^ (row & 7); koff1 = (unsigned)((row * LDQ + c * 8) * 2);
      int st = 2 * pc + (lane >> 5), kk = ((st >> 2) << 3) | ((lane & 31) >> 2), k = (kk & ~0xC) | ((kk & 4) << 1) | ((kk & 8) >> 1); voff0 = (unsigned)((k * LDQ + (st & 3) * 32 + (lane & 3) * 8) * 2);
      st += 2; kk = ((st >> 2) << 3) | ((lane & 31) >> 2); k = (kk & ~0xC) | ((kk & 4) << 1) | ((kk & 8) >> 1); voff1 = (unsigned)((k * LDQ + (st & 3) * 32 + (lane & 3) * 8) * 2); }
    const unsigned kdst = lds0 + OFF_K + wid * 2048, vdst = lds0 + OFF_V + wid * 2048, cdst = lds0 + OFF_CL, lane4 = (unsigned)lane * 4u;
#define TILEB(t) ((size_t)(j_lo + (t)) * (KVBLK * LDQ * 2))
#define DMA_K(t, slot) do { const char* g_ = (const char*)cur.K + TILEB(t); glds16(g_, koff0, kdst + (slot)); glds16(g_, koff1, kdst + (slot) + 1024); \
                            if (MODE == 1) glds4(cur.CB + (size_t)(j_lo + (t)) * KVBLK, lane4, cdst + ((slot) >> 6)); } while (0)
#define DMA_V(t, slot) do { const char* g_ = (const char*)cur.V + TILEB(t); glds16(g_, voff0, vdst + (slot)); glds16(g_, voff1, vdst + (slot) + 1024); } while (0)
#define RESC(a) do { if (__any((a) < 1.f)) { if (hi == 0) al_l[r32] = (a); asm volatile("s_waitcnt lgkmcnt(0)" ::: "memory");              \
                     for (int d_ = 0; d_ < 4; ++d_) for (int r = 0; r < 16; ++r) o[d_][r] *= al_l[crow(r, hi)]; } } while (0)
#define KBASE(t) ((j_lo + (t)) * KVBLK)
#define ACT(t) (MODE == 0 ? (KBASE(t) <= qlo) : true)
#define MASKT(P0_, P1_, t) do { const int kb_ = KBASE(t);                                                                              \
        if (MODE == 1) { if (kb_ + KVBLK - 1 > qlo) mask_tile(P0_, P1_, qm - kb_, 0x40000000u); }                                       \
        else { if (kb_ <= qlo && kb_ + KVBLK - 1 - qlo >= -90) add_bias(P0_, P1_, tbh, kb_ - qm + 192); } } while (0)
    DMA_K(0, 0); DMA_V(0, 0); DMA_K(1, SHM_K);
    bf16x8 qr[8];
    { const unsigned qo = (unsigned)(((wid * QBLK + r32) * LDQ + hi * 8) * 2);
#pragma unroll
      for (int d0 = 0; d0 < 8; ++d0) qr[d0] = LD8((const char*)cur.Q + qo + d0 * 32); }
    WAIT_BAR(0);
    int sl_prev = 2 * SHM_K, sl_cur = 0, sl_nxt = SHM_K;
#define ROT() do { const int t_ = sl_prev; sl_prev = sl_cur; sl_cur = sl_nxt; sl_nxt = t_; } while (0)
    f32x16 pA0, pA1, pB0, pB1; float mnA, mnB, alA, alB; bf16x8 pa0, pa1, pa2, pa3;
    DMA_K(2, sl_prev); DMA_V(1, sl_nxt);
    SBAR(); qkt<SK, MODE>(pA0, pA1, lds, sl_cur, sl_cur >> 8, r32, hi, qr, ACT(0));
    MASKT(pA0, pA1, 0); partialSM(pA0, pA1, m_reg, mnA, alA);
    if (2 < NT) { if (MODE == 1) WAIT_BAR(5); else WAIT_BAR(4); } else WAIT_BAR(0);
    ROT();
#define STEP(PL, PX0, PX1, mnX, alX, PY0, PY1, alY, s) do {                                                                    \
        if ((PL) || (s) + 2 < NT) DMA_K((s) + 2, sl_prev);                                                                     \
        if ((PL) || (s) + 1 < NT) DMA_V((s) + 1, sl_nxt);                                                                      \
        SBAR(); qkt<(SK && !(PL)), MODE>(PX0, PX1, lds, sl_cur, sl_cur >> 8, r32, hi, qr, ACT(s));                             \
        finishSM(PY0, PY1, alY, l_reg, pa0, pa1, pa2, pa3); SBAR();                                                            \
        pv_tile<(SK && !(PL))>(o, vb0 + sl_prev, pa0, pa1, pa2, pa3, ACT((s) - 1)); if (!(PL)) MASKT(PX0, PX1, (s)); partialSM(PX0, PX1, m_reg, mnX, alX); \
        RESC(alX);                                                                                                             \
        if ((PL) || (s) + 2 < NT) { if (MODE == 1) WAIT_BAR(5); else WAIT_BAR(4); } else WAIT_BAR(0);                          \
        ROT(); } while (0)
    int s = 1;
    { const int NH = NT - (MODE == 0 ? 6 : 4) - 2;
      for (; s + 1 < NH; s += 2) {
        STEP(true, pB0, pB1, mnB, alB, pA0, pA1, alA, s);
        STEP(true, pA0, pA1, mnA, alA, pB0, pB1, alB, s + 1);
      } }
    for (; s + 1 < NT; s += 2) {
        STEP(false, pB0, pB1, mnB, alB, pA0, pA1, alA, s);
        STEP(false, pA0, pA1, mnA, alA, pB0, pB1, alB, s + 1);
    }
    if (s < NT) {
        STEP(false, pB0, pB1, mnB, alB, pA0, pA1, alA, s);
        finishSM(pB0, pB1, alB, l_reg, pa0, pa1, pa2, pa3); SBAR(); pv_tile<SK>(o, vb0 + sl_prev, pa0, pa1, pa2, pa3, ACT(NT - 1));
    } else {
        finishSM(pA0, pA1, alA, l_reg, pa0, pa1, pa2, pa3); SBAR(); pv_tile<SK>(o, vb0 + sl_prev, pa0, pa1, pa2, pa3, ACT(NT - 1));
    }
    if (hi == 0) li_l[r32] = l_reg; asm volatile("s_waitcnt lgkmcnt(0)" ::: "memory");
    float rli[16];
#pragma unroll
    for (int r = 0; r < 16; ++r) rli[r] = __builtin_amdgcn_rcpf(li_l[crow(r, hi)]);
    char* Ow = (char*)cur.O; const unsigned oo = (unsigned)(((wid * QBLK + 4 * hi) * LDO + r32) * 2);
#pragma unroll
    for (int r = 0; r < 16; ++r) { const unsigned orow = (unsigned)(((r & 3) + 8 * (r >> 2)) * LDO * 2);
#pragma unroll
        for (int d0 = 0; d0 < 4; ++d0) { const float v = o[d0][r] * rli[r];
            const float vn = __shfl_xor(v, 1);
            if ((r32 & 1) == 0) *(unsigned*)(Ow + (oo + orow + d0 * 64)) = cvtpk(v, vn); } }
    asm volatile("s_waitcnt lgkmcnt(0)\n\ts_barrier" ::: "memory");
#undef TILEB
#undef DMA_K
#undef DMA_V
#undef RESC
#undef KBASE
#undef ACT
#undef MASKT
#undef ROT
#undef STEP
}
#undef WAIT_BAR
#undef LD8
#undef SBAR
#undef KSWZ
}
#define GAS __attribute__((address_space(1)))
#define LAS __attribute__((address_space(3)))
typedef unsigned short bf16;
typedef unsigned v4u __attribute__((ext_vector_type(4)));
typedef unsigned v2u __attribute__((ext_vector_type(2)));
typedef float f32x4 __attribute__((ext_vector_type(4)));
constexpr int NWAVES = 8;
constexpr int BATCH = 2, SEQ = 16384, DM = 2048, TOK = BATCH * SEQ, FF = 8192, NQKV = 6144, NQKV1 = 6400, FH = 16;
constexpr float NORM_EPS = 1e-6f, SUBLN_EPS = 1e-5f, LAMBDA_INIT = 0.2f;
constexpr size_t MiB = 1u << 20;
constexpr size_t WS_F = 0, WS_CB = 2 * MiB;
constexpr size_t WS_WQKV0 = 4 * MiB, WS_WOA = 28 * MiB, WS_WMI0 = 36 * MiB, WS_WMO0 = 68 * MiB, WS_WQKV1 = 100 * MiB, WS_WOB = 126 * MiB, WS_WMI1 = 134 * MiB, WS_WMO1 = 166 * MiB;
constexpr size_t WS_NRM = 198 * MiB;
constexpr size_t WS_RS = 198 * MiB + 65536;
constexpr size_t WS_BAR = 199 * MiB;
constexpr size_t WS_HB = 712 * MiB;
constexpr size_t WS_QKV = 200 * MiB;
constexpr size_t WS_OC = 584 * MiB;
constexpr size_t WS_HID = 200 * MiB;
constexpr size_t WS_XN = 840 * MiB;
constexpr size_t WS_END = 968 * MiB;
constexpr int LDS_BYTES = 147456;

__device__ __forceinline__ unsigned char* launder_p(unsigned char* p) { asm volatile("" : "+s"(p)); return p; }
__device__ __forceinline__ unsigned f2bf(float f) { unsigned u = __builtin_bit_cast(unsigned, f); return (u + 0x7fffu + ((u >> 16) & 1u)) >> 16; }
__device__ __forceinline__ unsigned pk2(float lo, float hi) { return f2bf(lo) | (f2bf(hi) << 16); }
__device__ __forceinline__ float bf2f(unsigned short b) { return __builtin_bit_cast(float, (unsigned)b << 16); }
__device__ __forceinline__ float wave_sum(float v) {
#pragma unroll
    for (int o = 1; o < 64; o <<= 1) v += __shfl_xor(v, o);
    return v;
}
__device__ __forceinline__ void transpose_item(const float* W, int K, int N, bf16* WT, int row_off, const float* g, LAS float* scr, int item, int lane) {
    const int nblk = N / 64, kb = item / nblk, nb = item % nblk, k0 = 64 * kb, n0 = 64 * nb, kr = lane >> 4, nq = lane & 15;
    f32x4 v[16];
#pragma unroll
    for (int i = 0; i < 16; ++i) v[i] = *(const f32x4*)(W + (size_t)(k0 + 4 * i + kr) * N + n0 + 4 * nq);
#pragma unroll
    for (int i = 0; i < 16; ++i) { const int kk = 4 * i + kr; f32x4 t = v[i]; if (g) t = t * g[k0 + kk];
        scr[(4 * nq + 0) * 65 + kk] = t[0]; scr[(4 * nq + 1) * 65 + kk] = t[1]; scr[(4 * nq + 2) * 65 + kk] = t[2]; scr[(4 * nq + 3) * 65 + kk] = t[3]; }
    asm volatile("s_waitcnt lgkmcnt(0)" ::: "memory");
    const int c = lane & 7;
#pragma unroll
    for (int j = 0; j < 8; ++j) { const int n = (lane >> 3) + 8 * j; const LAS float* sp = scr + n * 65 + 8 * c;
        v4u o; o.x = pk2(sp[0], sp[1]); o.y = pk2(sp[2], sp[3]); o.z = pk2(sp[4], sp[5]); o.w = pk2(sp[6], sp[7]);
        *(v4u*)(WT + (size_t)(row_off + n0 + n) * K + k0 + 8 * c) = o; }
    asm volatile("s_waitcnt lgkmcnt(0)" ::: "memory");
}
__device__ __forceinline__ void norm_row_to_bf16(const float* xrow, bf16* orow, int lane) {
    const f32x4* xr = (const f32x4*)xrow + lane;
    f32x4 v[8]; float s = 0.f;
#pragma unroll
    for (int j = 0; j < 8; ++j) { v[j] = xr[64 * j]; s += (v[j].x * v[j].x + v[j].y * v[j].y) + (v[j].z * v[j].z + v[j].w * v[j].w); }
    const float rstd = 1.f / sqrtf(wave_sum(s) * (1.f / DM) + NORM_EPS);
    v2u* o8 = (v2u*)orow + lane;
#pragma unroll
    for (int j = 0; j < 8; ++j) { v2u w; w.x = pk2(v[j].x * rstd, v[j].y * rstd); w.y = pk2(v[j].z * rstd, v[j].w * rstd); o8[64 * j] = w; }
}
__device__ __forceinline__ void norm_phase(const float* src, bf16* dst, int gw, int NGW, int lane) {
    for (int m = gw; m < TOK; m += NGW) norm_row_to_bf16(src + (size_t)m * DM, dst + (size_t)m * DM, lane);
}
__device__ __forceinline__ void final_norm_phase(float* io, const float* g, const float* rs, int gw, int NGW, int lane) {
    for (int m = gw; m < TOK; m += NGW) {
        f32x4* xr = (f32x4*)(io + (size_t)m * DM) + lane; const f32x4* gr = (const f32x4*)g + lane;
        const float rstd = 1.f / sqrtf(rs[m] * (1.f / DM) + NORM_EPS);
#pragma unroll
        for (int j = 0; j < 8; ++j) xr[64 * j] = xr[64 * j] * rstd * gr[64 * j];
    }
}
__device__ __forceinline__ void combine_phase(const bf16* OC, bf16* O, const float* lq1, const float* lk1, const float* lq2, const float* lk2, const float* sg, int gw, int NGW, int lane) {
    const float s1 = wave_sum(lq1[lane] * lk1[lane] + lq1[lane + 64] * lk1[lane + 64]), s2 = wave_sum(lq2[lane] * lk2[lane] + lq2[lane + 64] * lk2[lane + 64]);
    const float lam = expf(s1) - expf(s2) + LAMBDA_INIT;
    float gs[8];
#pragma unroll
    for (int e = 0; e < 8; ++e) gs[e] = sg[(lane & 31) * 8 + e] * (1.f - LAMBDA_INIT);
    for (int m = gw; m < TOK; m += NGW) {
        const v4u* a = (const v4u*)(OC + (size_t)m * DM) + lane; const v4u* b = (const v4u*)(OC + (size_t)TOK * DM + (size_t)m * DM) + lane; v4u* o = (v4u*)(O + (size_t)m * DM) + lane;
#pragma unroll
        for (int st = 0; st < 4; ++st) { const v4u av = a[64 * st], bv = b[64 * st]; float d[8]; float ss = 0.f;
#pragma unroll
            for (int e = 0; e < 4; ++e) { const unsigned aw = av[e], bw = bv[e];
                d[2 * e] = __builtin_bit_cast(float, aw << 16) - lam * __builtin_bit_cast(float, bw << 16);
                d[2 * e + 1] = __builtin_bit_cast(float, aw & 0xffff0000u) - lam * __builtin_bit_cast(float, bw & 0xffff0000u);
                ss += d[2 * e] * d[2 * e] + d[2 * e + 1] * d[2 * e + 1]; }
#pragma unroll
            for (int of = 1; of < 32; of <<= 1) ss += __shfl_xor(ss, of);
            const float rstd = 1.f / sqrtf(ss * (1.f / 256.f) + SUBLN_EPS);
            v4u w; w.x = pk2(d[0] * rstd * gs[0], d[1] * rstd * gs[1]); w.y = pk2(d[2] * rstd * gs[2], d[3] * rstd * gs[3]);
            w.z = pk2(d[4] * rstd * gs[4], d[5] * rstd * gs[5]); w.w = pk2(d[6] * rstd * gs[6], d[7] * rstd * gs[7]); o[64 * st] = w; }
    }
}
__device__ __forceinline__ void cumsum_phase(const float* F, const float* bfb, float* CB, LAS unsigned char* lds, int bx, int G, int tid) {
    LAS double* sc = (LAS double*)lds;
    for (int bh = bx; bh < BATCH * FH; bh += G) {
        const int b = bh / FH, h = bh % FH; const float bias = bfb[h];
        const float* fp = F + ((size_t)b * SEQ + (size_t)tid * 32) * FH + h;
        float ls[32]; double run = 0.0;
#pragma unroll
        for (int i = 0; i < 32; ++i) { const float x = fp[(size_t)i * FH] + bias; ls[i] = fminf(x, 0.f) - log1pf(expf(-fabsf(x))); run += (double)ls[i]; }
        sc[tid] = run; __syncthreads();
        int cur = 0;
        for (int of = 1; of < 512; of <<= 1) { double v = sc[cur * 512 + tid]; if (tid >= of) v += sc[cur * 512 + tid - of]; sc[(cur ^ 1) * 512 + tid] = v; cur ^= 1; __syncthreads(); }
        double acc = sc[cur * 512 + tid] - run;
        float* op = CB + (size_t)bh * SEQ + (size_t)tid * 32;
#pragma unroll
        for (int i = 0; i < 32; ++i) { acc += (double)ls[i]; op[i] = (float)(-acc * 11.313708498984761); }
        __syncthreads();
    }
}

__device__ __forceinline__ void rownorm_phase(const bf16* QKV, unsigned* NRM, int bx, int G, int tid) {
    for (int vw = bx; vw < 256; vw += G) {
        const int bh = vw >> 3, part = vw & 7, b = bh >> 4, h = bh & 15;
        const char* base = (const char*)(QKV + ((size_t)b * SEQ + (size_t)part * 2048) * NQKV + h * 128);
        const unsigned vo = (unsigned)(((tid >> 4) * NQKV + (tid & 15) * 8) * 2);
        float mq = 0.f, mk = 0.f;
#pragma unroll 4
        for (int it = 0; it < 64; ++it) {
            const char* rp = base + (size_t)it * 32 * NQKV * 2;
            const v4u qv = *(const v4u*)(rp + vo), kv = *(const v4u*)(rp + vo + 2048 * 2);
            float sq = 0.f, sk = 0.f;
#pragma unroll
            for (int e = 0; e < 4; ++e) { const float a0 = __builtin_bit_cast(float, qv[e] << 16), a1 = __builtin_bit_cast(float, qv[e] & 0xffff0000u), b0 = __builtin_bit_cast(float, kv[e] << 16), b1 = __builtin_bit_cast(float, kv[e] & 0xffff0000u);
                sq += a0 * a0 + a1 * a1; sk += b0 * b0 + b1 * b1; }
#pragma unroll
            for (int of = 1; of < 16; of <<= 1) { sq += __shfl_xor(sq, of); sk += __shfl_xor(sk, of); }
            mq = fmaxf(mq, sq); mk = fmaxf(mk, sk);
        }
        mq = fmaxf(mq, __shfl_xor(mq, 16)); mq = fmaxf(mq, __shfl_xor(mq, 32)); mk = fmaxf(mk, __shfl_xor(mk, 16)); mk = fmaxf(mk, __shfl_xor(mk, 32));
        if ((tid & 63) == 0) { atomicMax(NRM + bh * 2, __float_as_uint(mq)); atomicMax(NRM + bh * 2 + 1, __float_as_uint(mk)); }
    }
}

#define XB_TMO      128
#define XB_XCNT(j)  (256  + 64 * (j))
#define XB_XSUB(j)  (1280 + 64 * (j))
#define XB_XGEN(j)  (2304 + 64 * (j))
#define XB_TOP      3328
#define XB_TOPGEN   3392
#define XCD_BAR_WORDS 3456
#define XB_SPIN_CAP (1u << 18)

__device__ __forceinline__ unsigned xb_ld(unsigned* p)              { return __hip_atomic_load(p, __ATOMIC_RELAXED, __HIP_MEMORY_SCOPE_AGENT); }
__device__ __forceinline__ unsigned xb_add(unsigned* p, unsigned v) { return __hip_atomic_fetch_add(p, v, __ATOMIC_RELAXED, __HIP_MEMORY_SCOPE_AGENT); }
__device__ __forceinline__ unsigned xb_xcc_id() { return (unsigned)__builtin_amdgcn_s_getreg((3 << 11) | 20) & 0xFu; }
#define XB_SPIN(cond, bar) do { unsigned _sp = 0; while (cond) { __builtin_amdgcn_s_sleep(1); \
    if ((++_sp & 255u) == 0u) { if (xb_ld(&(bar)[XB_TMO])) break; if (_sp > XB_SPIN_CAP) { atomicAdd(&(bar)[XB_TMO], 1u); break; } } } } while (0)

struct XcdBarrier {
    unsigned* bar; unsigned x;
    volatile LAS unsigned* st;
};

__device__ __forceinline__ XcdBarrier xcd_barrier_post(unsigned* bar, volatile LAS unsigned* st) {
    XcdBarrier b; b.bar = bar; b.x = xb_xcc_id(); b.st = st;
    if (threadIdx.x == 0) (void)xb_add(&bar[XB_XCNT(b.x)], 1u);
    return b;
}
__device__ __forceinline__ void xcd_barrier_complete(unsigned* bar, unsigned x, unsigned& nloc, unsigned& nx) {
    const unsigned G = gridDim.x * gridDim.y * gridDim.z;
    unsigned sum, cnt, mine, sp = 0u;
    for (;;) {
        sum = 0u; cnt = 0u; mine = 0u;
#pragma unroll
        for (unsigned j = 0; j < 16; ++j) { const unsigned c = xb_ld(&bar[XB_XCNT(j)]); sum += c; cnt += (c > 0u) ? 1u : 0u; mine = (j == x) ? c : mine; }
        if (sum == G) break;
        __builtin_amdgcn_s_sleep(1);
        if ((++sp & 255u) == 0u) { if (xb_ld(&bar[XB_TMO])) break; if (sp > XB_SPIN_CAP) { atomicAdd(&bar[XB_TMO], 1u); break; } }
    }
    nloc = mine > 0u ? mine : 1u; nx = cnt > 0u ? cnt : 1u;
}

__device__ __forceinline__ void xcd_barrier(const XcdBarrier& b) {
    asm volatile("s_waitcnt vmcnt(0)" ::: "memory");
    __syncthreads();
    if (threadIdx.x == 0) {
        unsigned* bar = b.bar;
        __builtin_amdgcn_s_waitcnt(0);
        unsigned nloc = b.st[0], nx = b.st[1];
        if (nloc == 0u) { xcd_barrier_complete(bar, b.x, nloc, nx); b.st[0] = nloc; b.st[1] = nx; }
        const unsigned old = xb_add(&bar[XB_XSUB(b.x)], 1u);
        const unsigned gen = old / nloc;
        if (old + 1u == (gen + 1u) * nloc) {
            __builtin_amdgcn_fence(__ATOMIC_RELEASE, "agent");
            asm volatile("s_waitcnt vmcnt(0)" ::: "memory");
            const unsigned og = xb_add(&bar[XB_TOP], 1u);
            const unsigned tg = og / nx;
            if (og + 1u == (tg + 1u) * nx) xb_add(&bar[XB_TOPGEN], 1u);
            else XB_SPIN(xb_ld(&bar[XB_TOPGEN]) == tg, bar);
            __builtin_amdgcn_fence(__ATOMIC_ACQUIRE, "agent");
            xb_add(&bar[XB_XGEN(b.x)], 1u);
            asm volatile("s_waitcnt vmcnt(0)" ::: "memory");
        } else {
            XB_SPIN(xb_ld(&bar[XB_XGEN(b.x)]) == gen, bar);
            __builtin_amdgcn_fence(__ATOMIC_ACQUIRE, "agent");
            asm volatile("s_waitcnt vmcnt(0)" ::: "memory");
        }
    }
    __syncthreads();
}

struct Args { const float* in[21]; float* out; unsigned char* ws; };
template <int MODE> __device__ __forceinline__ bool attn_item(int i, int G, int bx, int& s, int& x) {
    constexpr int NS = MODE == 0 ? 64 : 32;
    if ((G & 7) == 0) { const int xcd = bx & 7, k = bx >> 3, kpx = G >> 3; const int idx = k + i * kpx; if (idx >= (NS / 8) * 32) return false; s = (idx >> 5) * 8 + xcd; x = idx & 31; return true; }
    const int L = bx + i * G; if (L >= NS * 32) return false; s = L >> 5; x = L & 31; return true;
}
template <int MODE> __device__ __forceinline__ att::BlockRef attn_ref(int s, int qb, int jlo, const bf16* QKV, bf16* Obuf, const float* CB) {
    att::BlockRef r; r.P0 = qb * 256; r.jlo = jlo;
    if (MODE == 0) { const int xcd = s & 7, sl = s >> 3, vh = sl & 1, c = (sl >> 1) & 1, bh = xcd * 2 + ((sl >> 2) & 1), b = bh >> 3, h = bh & 7;
        const bf16* base = QKV + (size_t)b * SEQ * NQKV;
        r.Q = base + (size_t)r.P0 * NQKV + h * 256 + c * 128; r.K = base + 2048 + h * 256 + c * 128; r.V = base + 4096 + h * 256 + vh * 128;
        r.O = Obuf + (size_t)c * TOK * DM + ((size_t)b * SEQ + r.P0) * DM + h * 256 + vh * 128; r.CB = nullptr; r.h = h; }
    else { const int b = s >> 4, h = s & 15; const bf16* base = QKV + (size_t)b * SEQ * NQKV;
        r.Q = base + (size_t)r.P0 * NQKV + h * 128; r.K = base + 2048 + h * 128; r.V = base + 4096 + h * 128;
        r.O = Obuf + ((size_t)b * SEQ + r.P0) * DM + h * 128; r.CB = CB + (size_t)s * SEQ; r.h = 0; }
    return r;
}
template <int MODE> __device__ __forceinline__ void attn_phase(char* lds, const bf16* QKV, bf16* Obuf, const float* CB, const unsigned* NRM, int G, int bx) {
    int* jt = (int*)(lds + att::OFF_TB);
    if (MODE == 1) {
        int tid = threadIdx.x; asm volatile("" : "+v"(tid)); const int w = __builtin_amdgcn_readfirstlane(tid >> 6), lane = tid & 63;
        if (tid < 64) jt[tid] = 0;
        __syncthreads();
        for (int e = w; e < 64; e += 8) { int s, x; if (!attn_item<MODE>(e >> 1, G, bx, s, x)) break;
            const int qb = (e & 1) ? 63 - x : x, jmax = qb * 4; const float* cb = CB + (size_t)s * SEQ;
            const float qn = sqrtf(__uint_as_float(NRM[s * 2])) * 1.01f, kn = sqrtf(__uint_as_float(NRM[s * 2 + 1])) * 1.01f;
            const float thr = cb[qb * 256] - 110.f * 11.313708498984761f - 2.f * qn * kn;
            int need = 0;
            for (int j0 = jmax - 1; j0 >= 0; j0 -= 64) { const int j = j0 - lane; const bool c = (j >= 0) && (cb[(j >= 0 ? j : 0) * 64 + 63] >= thr);
                const unsigned long long m = __ballot(c); const int n = __builtin_popcountll(m); need += n; if (n < 64) break; }
            if (lane == 0) jt[e] = jmax - need; }
        __syncthreads();
    }
    for (int i = 0; ; ++i) { int s, x; if (!attn_item<MODE>(i, G, bx, s, x)) break;
        for (int pass = 0; pass < 2; ++pass) {
            const int jl = (MODE == 1 && i < 32) ? jt[i * 2 + pass] : 0;
            const att::BlockRef cur = attn_ref<MODE>(s, pass ? 63 - x : x, jl, QKV, Obuf, CB);
            att::attn_block<MODE>(cur, lds); } }
}

__global__ void __launch_bounds__(NWAVES * 64, 2) yoco_fwd(Args args) {
    extern __shared__ __attribute__((aligned(16))) unsigned char lds[];
    cg::grid_group grid = cg::this_grid();
    LAS unsigned char* ldsl = (LAS unsigned char*)lds;
    const int G = gridDim.x, bx = blockIdx.x, NGW = G * NWAVES;
    int tid, lane, wave, gw;
#define FRESH() do { tid = threadIdx.x; asm volatile("" : "+v"(tid)); lane = tid & 63; wave = __builtin_amdgcn_readfirstlane(tid >> 6); gw = bx * NWAVES + wave; } while (0)
    FRESH();
#define WSP(T, off) ((T*)(launder_p(args.ws) + (off)))
#define Wqkv0 WSP(bf16, WS_WQKV0)
#define Woa WSP(bf16, WS_WOA)
#define Wmi0 WSP(bf16, WS_WMI0)
#define Wmo0 WSP(bf16, WS_WMO0)
#define Wqkv1 WSP(bf16, WS_WQKV1)
#define Wob WSP(bf16, WS_WOB)
#define Wmi1 WSP(bf16, WS_WMI1)
#define Wmo1 WSP(bf16, WS_WMO1)
#define QKV WSP(bf16, WS_QKV)
#define OC WSP(bf16, WS_OC)
#define HID WSP(bf16, WS_HID)
#define XN WSP(bf16, WS_XN)
#define Fb WSP(float, WS_F)
#define CB WSP(float, WS_CB)
#define NRM WSP(unsigned, WS_NRM)
#define RS WSP(float, WS_RS)
#define HB WSP(bf16, WS_HB)
#define out ((float*)launder_p((unsigned char*)args.out))
#define XIN ((const float*)launder_p((unsigned char*)args.in[0]))
    volatile LAS unsigned* xst = (volatile LAS unsigned*)(ldsl + LDS_BYTES - 64);
    if (tid < 2) xst[tid] = 0u;
    __syncthreads();
    const XcdBarrier xbar = xcd_barrier_post(WSP(unsigned, WS_BAR), xst);

    {
        LAS float* scr = (LAS float*)(ldsl + wave * 16640);
        bf16* const wqkv1 = Wqkv1;
        const float* ag = args.in[2]; const float* mg = args.in[3]; const float* kg = args.in[11];
        constexpr int I_QKV = (DM / 64) * (NQKV / 64), I_DD = (DM / 64) * (DM / 64), I_MI = (DM / 64) * (FF / 64), I_MO = (FF / 64) * (DM / 64);
        constexpr int NITEMS = I_QKV + 5 * I_DD + 2 * I_MI + 2 * I_MO;
        for (int it = gw; it < NITEMS; it += NGW) {
            int r = it;
            if (r < I_QKV) { transpose_item(args.in[4], DM, NQKV, Wqkv0, 0, ag, scr, r, lane); continue; } r -= I_QKV;
            if (r < I_DD) { transpose_item(args.in[10], DM, DM, Woa, 0, nullptr, scr, r, lane); continue; } r -= I_DD;
            if (r < I_DD) { transpose_item(args.in[16], DM, DM, wqkv1, 0, ag + DM, scr, r, lane); continue; } r -= I_DD;
            if (r < I_DD) { transpose_item(args.in[12], DM, DM, wqkv1, DM, kg, scr, r, lane); continue; } r -= I_DD;
            if (r < I_DD) { transpose_item(args.in[13], DM, DM, wqkv1, 2 * DM, kg, scr, r, lane); continue; } r -= I_DD;
            if (r < I_DD) { transpose_item(args.in[17], DM, DM, Wob, 0, nullptr, scr, r, lane); continue; } r -= I_DD;
            if (r < I_MI) { transpose_item(args.in[18], DM, FF, Wmi0, 0, mg, scr, r, lane); continue; } r -= I_MI;
            if (r < I_MI) { transpose_item(args.in[18] + (size_t)DM * FF, DM, FF, Wmi1, 0, mg + DM, scr, r, lane); continue; } r -= I_MI;
            if (r < I_MO) { transpose_item(args.in[19], FF, DM, Wmo0, 0, nullptr, scr, r, lane); continue; } r -= I_MO;
            transpose_item(args.in[19] + (size_t)FF * DM, FF, DM, Wmo1, 0, nullptr, scr, r, lane);
        }
        { const float* wf = args.in[14]; const int gt = bx * 512 + tid, NT_ = G * 512;
          for (int e = gt; e < (NQKV1 - NQKV) * DM; e += NT_) { const int n = e / DM, k = e % DM; wqkv1[(size_t)(NQKV + n) * DM + k] = (n < FH) ? (bf16)f2bf(wf[(size_t)k * FH + n] * kg[k]) : (bf16)0; } }
        if (bx == 0 && tid < 64) NRM[tid] = 0u;
        { float* rsz = RS; for (int e = bx * 512 + tid; e < 4 * TOK; e += G * 512) rsz[e] = 0.f; }
        norm_phase(XIN, XN, gw, NGW, lane);
    }
    grid.sync();
#define GSYNC() xcd_barrier(xbar)
#define GEMM_PHASE(EPI, A_, B_, N_, K_, ...) do { pg8::Gemm g{A_, B_, TOK, N_, K_}; pg8::StaticOrder S; S.init(TOK, N_, G, bx); EPI E{__VA_ARGS__}; \
        pg8::gemm_phase<EPI, pg8::StaticOrder, PG8_ALIGN, PG8_SP2>(ldsl, g, S, E); } while (0)
    typedef pg8::EpiX<0, false, false, false> EpiQKV0; typedef pg8::EpiX<3, true, false, false> EpiQKV1; typedef pg8::EpiX<1, true, false, false> EpiMlpIn;
    typedef pg8::EpiX<2, false, true, true> EpiRes; typedef pg8::EpiX<2, false, false, true> EpiResLast;
    GEMM_PHASE(EpiQKV0, XN, Wqkv0, NQKV, DM, QKV, NQKV, nullptr, nullptr, nullptr, nullptr, nullptr);
    GSYNC();
    {
      FRESH(); const float* tab = args.in[1]; float* tb = (float*)(lds + att::OFF_TB);
      for (int idx = tid; idx < 2048; idx += 512) { const int h = idx >> 8, rel = (idx & 255) - 192; const int n = rel < 0 ? -rel : rel;
          int bk = n < 8 ? n : 8 + (n >= 12) + (n >= 16) + (n >= 23) + (n >= 32) + (n >= 46) + (n >= 64) + (n >= 91); if (rel > 0) bk += 16;
          tb[idx] = (tab[bk * 8 + h] - tab[15 * 8 + h]) * 11.313708498984761f; }
      __syncthreads();
      attn_phase<0>((char*)lds, QKV, OC, nullptr, nullptr, G, bx);
    }
    GSYNC();
    FRESH(); combine_phase(OC, XN, args.in[5], args.in[6], args.in[7], args.in[8], args.in[9], gw, NGW, lane);
    GSYNC();
    GEMM_PHASE(EpiRes, XN, Woa, DM, DM, HB, DM, XIN, out, nullptr, nullptr, RS);
    GSYNC();
    GEMM_PHASE(EpiMlpIn, HB, Wmi0, FF, DM, HID, FF, nullptr, nullptr, nullptr, RS, nullptr);
    GSYNC();
    GEMM_PHASE(EpiRes, HID, Wmo0, DM, FF, XN, DM, out, out, nullptr, nullptr, RS + TOK);
    GSYNC();
    GEMM_PHASE(EpiQKV1, XN, Wqkv1, NQKV1, DM, QKV, NQKV, nullptr, nullptr, Fb, RS + TOK, nullptr);
    GSYNC();
    FRESH(); cumsum_phase(Fb, args.in[15], CB, ldsl, bx, G, tid);
    rownorm_phase(QKV, NRM, bx, G, tid);
    GSYNC();
    attn_phase<1>((char*)lds, QKV, XN, CB, NRM, G, bx);
    GSYNC();
    GEMM_PHASE(EpiRes, XN, Wob, DM, DM, HB, DM, out, out, nullptr, nullptr, RS + 2 * TOK);
    GSYNC();
    GEMM_PHASE(EpiMlpIn, HB, Wmi1, FF, DM, HID, FF, nullptr, nullptr, nullptr, RS + 2 * TOK, nullptr);
    GSYNC();
    GEMM_PHASE(EpiResLast, HID, Wmo1, DM, FF, nullptr, DM, out, out, nullptr, nullptr, RS + 3 * TOK);
    GSYNC();
    FRESH(); final_norm_phase(out, args.in[20], RS + 3 * TOK, gw, NGW, lane);
}

#undef out
#undef XIN
extern "C" void kernel_launch(void* const* d_in, const int* in_sizes, int n_in, void* d_out, int out_size, void* d_ws, size_t ws_size, hipStream_t stream) {
    static int grid = 0;
    if (grid == 0) {
        if (n_in != 21 || in_sizes[0] != TOK * DM || out_size != TOK * DM || ws_size < WS_END) { fprintf(stderr, "kernel_launch: unexpected shapes (n_in %d, in0 %d, out %d, ws %zu)\n", n_in, n_in > 0 ? in_sizes[0] : -1, out_size, ws_size); grid = -1; return; }
        int dev = 0, cus = 0, per_cu = 0;
        (void)hipGetDevice(&dev); (void)hipDeviceGetAttribute(&cus, hipDeviceAttributeMultiprocessorCount, dev);
        if (hipFuncSetAttribute((const void*)yoco_fwd, hipFuncAttributeMaxDynamicSharedMemorySize, LDS_BYTES) != hipSuccess) { fprintf(stderr, "kernel_launch: hipFuncSetAttribute failed\n"); grid = -1; return; }
        if (hipOccupancyMaxActiveBlocksPerMultiprocessor(&per_cu, (const void*)yoco_fwd, NWAVES * 64, LDS_BYTES) != hipSuccess || per_cu < 1) { fprintf(stderr, "kernel_launch: occupancy query gives %d\n", per_cu); per_cu = 1; }
        (void)hipGetLastError();
        grid = cus > 0 ? cus : 256;
    }
    if (grid < 0) return;
    if (hipMemsetAsync((char*)d_ws + WS_BAR, 0, 16384, stream) != hipSuccess) { fprintf(stderr, "kernel_launch: hipMemsetAsync failed\n"); return; }
    Args a{};
    for (int i = 0; i < 21; ++i) a.in[i] = (const float*)d_in[i];
    a.out = (float*)d_out; a.ws = (unsigned char*)d_ws;
    void* kargs[] = {&a};
    hipError_t e = hipLaunchCooperativeKernel((const void*)yoco_fwd, dim3(grid), dim3(NWAVES * 64), kargs, LDS_BYTES, stream);
    if (e != hipSuccess) fprintf(stderr, "kernel_launch: cooperative launch failed: %s (grid %d)\n", hipGetErrorString(e), grid);
}
```

```cpp
#include <hip/hip_runtime.h>
#include <hip/hip_cooperative_groups.h>
#include <cstdio>
#include <cstdint>
namespace cg = cooperative_groups;
namespace pg8 {
#define PG8_LAS __attribute__((address_space(3)))
typedef unsigned short bf16_t;
typedef short bf16x8 __attribute__((ext_vector_type(8)));
typedef float f32x4 __attribute__((ext_vector_type(4)));
typedef unsigned u32x4 __attribute__((ext_vector_type(4)));
constexpr int BM = 256, BK = 64, HALF = 128, HTB = HALF * BK * 2  , STAGE_BYTES = 8 * HTB, NXCD = 8, WGM = 8;

__host__ __device__ __forceinline__ int lds_byte(int r, int c) { const int st = (r >> 4) * 2 + (c >> 5), rr = r & 15, cc = c & 31, ob = rr * 64 + cc * 2; return st * 1024 + (ob ^ (((ob >> 9) & 1) << 5)); }
__host__ __device__ __forceinline__ void stage_rc(int b, int& R, int& C) { const int st = b / 1024, sb = b % 1024, swz = sb ^ (((sb >> 9) & 1) << 5); R = (st >> 1) * 16 + swz / 64; C = (st & 1) * 32 + (swz % 64) / 2; }
__host__ __device__ __forceinline__ int perm32(int rho) { const int n = rho >> 4, i = rho & 15; return 8 * (i >> 2) + 4 * n + (i & 3); }

struct Unit { int pm, pn; };
struct Gemm { const bf16_t* A; const bf16_t* Bt; int M, N, K; };

struct StaticOrder {
    int nM, nN, nwg, G, c;
    __host__ __device__ void init(int M, int N, int G_, int c_) { nM = M / BM; nN = N / BM; nwg = nM * nN; G = G_; c = c_; }
    __host__ __device__ bool next(int i, Unit& u) const {
        const long L = (long)i * G + c; if (L >= nwg) return false;
        int wgid = (int)L; { const int q = nwg / NXCD, r = nwg % NXCD, xcd = wgid % NXCD, off = wgid / NXCD; wgid = (xcd < r ? xcd * (q + 1) : r * (q + 1) + (xcd - r) * q) + off; }
        const int nig = WGM * nN, gid = wgid / nig, fm = gid * WGM, gsz = (nM - fm) < WGM ? (nM - fm) : WGM;
        u.pm = fm + ((wgid % nig) % gsz); u.pn = (wgid % nig) / gsz; return true;
    }
    __device__ __forceinline__ void a_ready(const Unit&) const {}
    __device__ __forceinline__ void done(const Unit&) const {}
};

__device__ __forceinline__ unsigned cvt_pk_bf16(float lo, float hi) { unsigned r; asm volatile("v_cvt_pk_bf16_f32 %0, %1, %2" : "=v"(r) : "v"(lo), "v"(hi)); return r; }
typedef float f32x2 __attribute__((ext_vector_type(2)));
template <int MODE, bool RS_IN, bool COPY, bool SUMSQ> struct EpiX {
    static constexpr bool PERM = true, AFTER_DRAIN = false;
    bf16_t* O; int ldc; const float* base; float* out; float* F; const float* rs_in; float* rs_out;
    __device__ __forceinline__ void operator()(const f32x4 (&acc)[2][2][4][2], const Unit& u, int wr, int wc, int fr, int fq) const {
        const int row0 = u.pm * BM + wr * 64 + fr, col0 = u.pn * BM + wc * 32 + 8 * fq;
        const bool ftile = (MODE == 3) && (u.pn * BM >= 6144);
#pragma unroll
        for (int ai = 0; ai < 2; ++ai)
#pragma unroll
            for (int m = 0; m < 4; ++m) { const size_t row = (size_t)(row0 + ai * HALF + m * 16);
                float rs = 1.f; if (RS_IN) rs = 1.f / sqrtf(rs_in[row] * (1.f / 2048.f) + 1e-6f);
                float ss = 0.f;
#pragma unroll
                for (int bj = 0; bj < 2; ++bj) { f32x4 v0 = acc[ai][bj][m][0], v1 = acc[ai][bj][m][1]; const int col = col0 + bj * HALF;
                    if (RS_IN) { v0 = v0 * rs; v1 = v1 * rs; }
                    if (MODE == 2) { const float* bp = base + row * ldc + col; float* op = out + row * ldc + col;
                        const f32x4 b0 = *(const f32x4*)bp, b1 = *(const f32x4*)(bp + 4); v0 = b0 + v0; v1 = b1 + v1; *(f32x4*)op = v0; *(f32x4*)(op + 4) = v1;
                        if (SUMSQ) ss += (v0[0] * v0[0] + v0[1] * v0[1]) + (v0[2] * v0[2] + v0[3] * v0[3]) + (v1[0] * v1[0] + v1[1] * v1[1]) + (v1[2] * v1[2] + v1[3] * v1[3]);
                        if (COPY) { u32x4 w; w.x = cvt_pk_bf16(v0[0], v0[1]); w.y = cvt_pk_bf16(v0[2], v0[3]); w.z = cvt_pk_bf16(v1[0], v1[1]); w.w = cvt_pk_bf16(v1[2], v1[3]); *(u32x4*)(O + row * ldc + col) = w; } }
                    else if (ftile) { if (bj == 0 && wc == 0 && fq < 2) { float* fp = F + row * 16 + 8 * fq; *(f32x4*)fp = v0; *(f32x4*)(fp + 4) = v1; } }
                    else { if (MODE == 1) {
#pragma unroll
                            for (int e = 0; e < 4; ++e) { const float a = fmaxf(v0[e], 0.f), b = fmaxf(v1[e], 0.f); v0[e] = a * a; v1[e] = b * b; } }
                        u32x4 w; w.x = cvt_pk_bf16(v0[0], v0[1]); w.y = cvt_pk_bf16(v0[2], v0[3]); w.z = cvt_pk_bf16(v1[0], v1[1]); w.w = cvt_pk_bf16(v1[2], v1[3]);
                        *(u32x4*)(O + row * ldc + col) = w; } }
                if (SUMSQ) { ss += __shfl_xor(ss, 16); ss += __shfl_xor(ss, 32); if (fq == 0) atomicAdd(rs_out + row, ss); }
                if (MODE == 2) asm volatile("" ::: "memory"); }
    }
};
template <class Epi, class Sched, bool ALIGN_EPI = false, bool SP2 = false>
__device__ __forceinline__ void gemm_phase(PG8_LAS unsigned char* lds, const Gemm g, const Sched& S, const Epi& E) {
    int tid = threadIdx.x; asm volatile("" : "+v"(tid));
    const int wid = __builtin_amdgcn_readfirstlane(tid >> 6), lane = tid & 63, wr = wid >> 2, wc = wid & 3, fr = lane & 15, fq = lane >> 4;
    const int K = g.K, nt = K / BK;
    unsigned voffA[2], voffB[2];
#pragma unroll
    for (int i = 0; i < 2; ++i) { int R, C; stage_rc(tid * 16 + i * 8192, R, C); const int Rb = Epi::PERM ? ((R & ~31) + perm32(R & 31)) : R;
        voffA[i] = (unsigned)(R * K + C) * 2u; voffB[i] = (unsigned)(Rb * K + C) * 2u; }
    const size_t kstep = (size_t)(BK * 2);
    const size_t hstep = (size_t)HALF * K * 2;
    const size_t tstep = 2 * hstep;
    const unsigned ldsw = (unsigned)wid * 1024u;
    const int aoff = lds_byte(wr * 64 + fr, fq * 8), boff = lds_byte(wc * 32 + fr, fq * 8);
#define PG8_SA(b, h) (((b) * 2 + (h)) * HTB)
#define PG8_SB(b, h) ((4 + (b) * 2 + (h)) * HTB)
#define PG8_STAGE(bufoff, gbase, voff) do { _Pragma("unroll") for (int _i = 0; _i < 2; ++_i) \
        __builtin_amdgcn_global_load_lds((const unsigned*)((const char*)(gbase) + (voff)[_i]), (PG8_LAS unsigned*)(lds + (bufoff) + ldsw + _i * 8192), 16, 0, 0); } while (0)
#define PG8_LDA(dst, b, h) do { _Pragma("unroll") for (int m = 0; m < 4; ++m) _Pragma("unroll") for (int k = 0; k < 2; ++k) dst[m][k] = *(const PG8_LAS bf16x8*)(lds + PG8_SA(b, h) + aoff + m * 2048 + k * 1024); } while (0)
#define PG8_LDB(dst, b, h) do { _Pragma("unroll") for (int n = 0; n < 2; ++n) _Pragma("unroll") for (int k = 0; k < 2; ++k) dst[n][k] = *(const PG8_LAS bf16x8*)(lds + PG8_SB(b, h) + boff + n * 2048 + k * 1024); } while (0)
#define PG8_MMA(ai, bj, At, Bt) do { __builtin_amdgcn_s_setprio(1); _Pragma("unroll") for (int m = 0; m < 4; ++m) _Pragma("unroll") for (int n = 0; n < 2; ++n) _Pragma("unroll") for (int k = 0; k < 2; ++k) \
        acc[ai][bj][m][n] = __builtin_amdgcn_mfma_f32_16x16x32_bf16(Bt[n][k], At[m][k], acc[ai][bj][m][n], 0, 0, 0); __builtin_amdgcn_s_setprio(0); } while (0)
#define PG8_WAIT_V(n) asm volatile("s_waitcnt vmcnt(" #n ")" ::: "memory")
#define PG8_WAIT_L(n) asm volatile("s_waitcnt lgkmcnt(" #n ")" ::: "memory")
#define PG8_BAR __builtin_amdgcn_s_barrier()
#define PG8_SCHED __builtin_amdgcn_sched_barrier(0)
    Unit cur, nxt; int ui = 0;
    if (!S.next(0, cur)) return;
    f32x4 acc[2][2][4][2];
#pragma unroll
    for (int a = 0; a < 2; ++a)
#pragma unroll
        for (int b = 0; b < 2; ++b)
#pragma unroll
            for (int m = 0; m < 4; ++m)
#pragma unroll
                for (int n = 0; n < 2; ++n) acc[a][b][m][n] = (f32x4){0.f, 0.f, 0.f, 0.f};
    bf16x8 At[4][2], B0[2][2], B1[2][2];
    const char* cA = (const char*)g.A + (size_t)cur.pm * tstep; const char* cB = (const char*)g.Bt + (size_t)cur.pn * tstep;
    S.a_ready(cur);
    if constexpr (SP2) {
        PG8_STAGE(PG8_SB(0, 0), cB, voffB); PG8_STAGE(PG8_SB(0, 1), cB + hstep, voffB); PG8_STAGE(PG8_SA(0, 0), cA, voffA); PG8_STAGE(PG8_SA(0, 1), cA + hstep, voffA);
        if (wr == 1) PG8_BAR;
        PG8_WAIT_V(2); PG8_BAR;
        PG8_STAGE(PG8_SB(1, 0), cB + kstep, voffB); PG8_STAGE(PG8_SA(1, 0), cA + kstep, voffA); PG8_STAGE(PG8_SB(1, 1), cB + hstep + kstep, voffB);
        PG8_WAIT_V(6); PG8_BAR;
    } else {
        PG8_STAGE(PG8_SB(0, 0), cB, voffB); PG8_STAGE(PG8_SA(0, 0), cA, voffA); PG8_STAGE(PG8_SB(0, 1), cB + hstep, voffB); PG8_STAGE(PG8_SA(0, 1), cA + hstep, voffA);
        if (wr == 1) PG8_BAR;
        PG8_WAIT_V(4); PG8_BAR;
        PG8_STAGE(PG8_SB(1, 0), cB + kstep, voffB); PG8_STAGE(PG8_SA(1, 0), cA + kstep, voffA); PG8_STAGE(PG8_SB(1, 1), cB + hstep + kstep, voffB);
        PG8_WAIT_V(6); PG8_BAR;
    }
    for (;;) {
        const bool has_next = S.next(ui + 1, nxt);
        const char* nA = has_next ? (const char*)g.A + (size_t)nxt.pm * tstep : cA; const char* nB = has_next ? (const char*)g.Bt + (size_t)nxt.pn * tstep : cB;
        for (int t = 0; t < nt; t += 2) {
            const bool last = (t == nt - 2);
            const char* a1 = cA + (size_t)(t + 1) * kstep;
            const char* a2 = last ? nA : cA + (size_t)(t + 2) * kstep; const char* b2 = last ? nB : cB + (size_t)(t + 2) * kstep;
            const char* a3 = a2 + kstep; const char* b3 = b2 + kstep;
            if (last && has_next) S.a_ready(nxt);
            if constexpr (SP2) {
            PG8_LDB(B0, 0, 0); PG8_LDB(B1, 0, 1); PG8_SCHED; PG8_LDA(At, 0, 0); PG8_STAGE(PG8_SA(1, 1), a1 + hstep, voffA);
            PG8_WAIT_V(8); PG8_WAIT_L(0); PG8_BAR; PG8_MMA(0, 0, At, B0); PG8_MMA(0, 1, At, B1); PG8_BAR; PG8_SCHED;
            PG8_LDA(At, 0, 1); PG8_STAGE(PG8_SB(0, 0), b2, voffB); PG8_STAGE(PG8_SB(0, 1), b2 + hstep, voffB); PG8_STAGE(PG8_SA(0, 0), a2, voffA);
            PG8_WAIT_V(8); PG8_WAIT_L(0); PG8_BAR; PG8_MMA(1, 0, At, B0); PG8_MMA(1, 1, At, B1); PG8_BAR; PG8_SCHED;
            PG8_LDB(B0, 1, 0); PG8_LDB(B1, 1, 1); PG8_SCHED; PG8_LDA(At, 1, 0); PG8_STAGE(PG8_SA(0, 1), a2 + hstep, voffA);
            PG8_WAIT_V(8); PG8_WAIT_L(0); PG8_BAR; PG8_MMA(0, 0, At, B0); PG8_MMA(0, 1, At, B1); PG8_BAR; PG8_SCHED;
            PG8_LDA(At, 1, 1); PG8_STAGE(PG8_SB(1, 0), b3, voffB); PG8_STAGE(PG8_SB(1, 1), b3 + hstep, voffB); PG8_STAGE(PG8_SA(1, 0), a3, voffA);
            PG8_WAIT_V(8); PG8_WAIT_L(0); PG8_BAR; PG8_MMA(1, 0, At, B0); PG8_MMA(1, 1, At, B1); PG8_BAR; PG8_SCHED;
            } else {
            PG8_LDB(B0, 0, 0); PG8_SCHED; PG8_LDA(At, 0, 0); PG8_STAGE(PG8_SA(1, 1), a1 + hstep, voffA);
            PG8_WAIT_L(8); PG8_BAR; PG8_WAIT_L(0); PG8_MMA(0, 0, At, B0); PG8_BAR; PG8_SCHED;
            PG8_LDB(B1, 0, 1); PG8_STAGE(PG8_SB(0, 0), b2, voffB);
            PG8_BAR; PG8_WAIT_L(0); PG8_MMA(0, 1, At, B1); PG8_BAR;
            PG8_LDA(At, 0, 1); PG8_STAGE(PG8_SA(0, 0), a2, voffA);
            PG8_BAR; PG8_WAIT_L(0); PG8_MMA(1, 0, At, B0); PG8_BAR; PG8_SCHED;
            PG8_STAGE(PG8_SB(0, 1), b2 + hstep, voffB);
            PG8_WAIT_V(6); PG8_BAR; PG8_MMA(1, 1, At, B1); PG8_BAR;
            PG8_LDB(B0, 1, 0); PG8_SCHED; PG8_LDA(At, 1, 0); PG8_STAGE(PG8_SA(0, 1), a2 + hstep, voffA);
            PG8_WAIT_L(8); PG8_BAR; PG8_WAIT_L(0); PG8_MMA(0, 0, At, B0); PG8_BAR; PG8_SCHED;
            PG8_LDB(B1, 1, 1); PG8_STAGE(PG8_SB(1, 0), b3, voffB);
            PG8_BAR; PG8_WAIT_L(0); PG8_MMA(0, 1, At, B1); PG8_BAR;
            PG8_LDA(At, 1, 1); PG8_STAGE(PG8_SA(1, 0), a3, voffA);
            PG8_BAR; PG8_WAIT_L(0); PG8_MMA(1, 0, At, B0); PG8_BAR; PG8_SCHED;
            PG8_STAGE(PG8_SB(1, 1), b3 + hstep, voffB);
            PG8_WAIT_V(6); PG8_BAR; PG8_MMA(1, 1, At, B1); PG8_BAR;
            }
        }
        if constexpr (ALIGN_EPI) { if (wr == 0) PG8_BAR; }
        if constexpr (!Epi::AFTER_DRAIN) { E(acc, cur, wr, wc, fr, fq); S.done(cur); }
        if (!has_next) break;
#pragma unroll
        for (int a = 0; a < 2; ++a)
#pragma unroll
            for (int b = 0; b < 2; ++b)
#pragma unroll
                for (int m = 0; m < 4; ++m)
#pragma unroll
                    for (int n = 0; n < 2; ++n) acc[a][b][m][n] = (f32x4){0.f, 0.f, 0.f, 0.f};
        cur = nxt; cA = nA; cB = nB; ++ui;
        if constexpr (ALIGN_EPI) { if (wr == 1) PG8_BAR; }
    }
    PG8_WAIT_V(0);
    if constexpr (!ALIGN_EPI) { if (wr == 0) PG8_BAR; }
    PG8_BAR;
    if constexpr (Epi::AFTER_DRAIN) { E.fused(acc, cur, wr, wc, fr, fq, lds, wid, lane); S.done(cur); }
#undef PG8_SA
#undef PG8_SB
#undef PG8_STAGE
#undef PG8_LDA
#undef PG8_LDB
#undef PG8_MMA
#undef PG8_WAIT_V
#undef PG8_WAIT_L
#undef PG8_BAR
#undef PG8_SCHED
}
}
#ifndef PG8_SP2
#define PG8_SP2 true
#endif
#ifndef PG8_ALIGN
#define PG8_ALIGN true
#endif
namespace att {
typedef unsigned short bf16;
typedef short bf16x8 __attribute__((ext_vector_type(8)));
typedef short s16x4 __attribute__((ext_vector_type(4)));
typedef float f32x16 __attribute__((ext_vector_type(16)));
typedef float f32x4 __attribute__((ext_vector_type(4)));
typedef unsigned u32x4 __attribute__((ext_vector_type(4)));
constexpr int D = 128, NW = 8, QBLK = 32, KVBLK = 64, QB = NW * QBLK, LDQ = 6144, LDO = 2048;
constexpr float SCALE = 0.08838834764831845f, THR = 8.f;
constexpr int SHM_V = KVBLK * D * 2, SHM_K = KVBLK * D * 2, NSLOT = 3;
constexpr int OFF_V = 0, OFF_K = NSLOT * SHM_V, OFF_WS = OFF_K + NSLOT * SHM_K, OFF_CL = OFF_WS + NW * 64 * 4, OFF_TB = OFF_CL + NSLOT * 256, LDS_BYTES = OFF_TB + 8192;
#define KSWZ(row, colB) ((row) * 256 + ((colB) ^ (((row) & 7) << 4)))
#define SBAR() __builtin_amdgcn_sched_barrier(0)
__device__ __forceinline__ int v_st(int k, int c) { const int kk = (k & ~0xC) | ((k & 4) << 1) | ((k & 8) >> 1); return ((kk >> 3) * 4 + (c >> 5)) * 512 + ((kk & 7) * 32 + (c & 31)) * 2; }
__device__ __forceinline__ int v_rd_base(int lane) { return ((lane & 3) << 3) | (((lane >> 2) & 3) << 6) | (((lane >> 4) & 1) << 5) | (((lane >> 5) & 1) << 8); }
constexpr int v_rd_off(int d0, int ks, int half) { return d0 * 512 + ks * 4096 + half * 2048; }
__device__ __forceinline__ int crow(int r, int hi) { return (r & 3) + 8 * (r >> 2) + 4 * hi; }
__device__ __forceinline__ unsigned cvtpk(float lo, float hi) { unsigned r; asm volatile("v_cvt_pk_bf16_f32 %0, %1, %2" : "=v"(r) : "v"(lo), "v"(hi)); return r; }
__device__ __forceinline__ void mask_tile(f32x16& p0, f32x16& p1, int dq, unsigned W) {
    const float NEG = -__builtin_inff();
#pragma unroll
    for (int r = 0; r < 16; ++r) { const int c = (r & 3) + 8 * (r >> 2);
        if ((unsigned)(dq - c) >= W) p0[r] = NEG;
        if ((unsigned)(dq - c - 32) >= W) p1[r] = NEG; }
}
__device__ __forceinline__ void add_bias(f32x16& p0, f32x16& p1, const float* tb, int relbase) {
    const float* t = tb + relbase;
#pragma unroll
    for (int r = 0; r < 16; ++r) { const int c = (r & 3) + 8 * (r >> 2); p0[r] += t[c]; p1[r] += t[c + 32]; }
}
__device__ __forceinline__ void partialSM(f32x16& p0, f32x16& p1, float& m_reg, float& mn, float& alpha) {
    float pmax = p0[0]; for (int r = 1; r < 16; ++r) pmax = fmaxf(pmax, p0[r]); for (int r = 0; r < 16; ++r) pmax = fmaxf(pmax, p1[r]);
    { auto rr = __builtin_amdgcn_permlane32_swap(__float_as_uint(pmax), __float_as_uint(pmax), false, false);
      pmax = fmaxf(__uint_as_float(rr[0]), __uint_as_float(rr[1])); }
    constexpr float C2 = 1.4426950408889634f * SCALE;
    if (__builtin_expect(__all((pmax - m_reg) * SCALE <= THR), 1)) { mn = m_reg; alpha = 1.f; }
    else { mn = fmaxf(m_reg, pmax); alpha = __builtin_amdgcn_exp2f((m_reg - mn) * C2); m_reg = mn; }
    const float mnL = -mn * C2;
    for (int r = 0; r < 16; ++r) p0[r] = fmaf(p0[r], C2, mnL); for (int r = 0; r < 16; ++r) p1[r] = fmaf(p1[r], C2, mnL);
    for (int r = 0; r < 16; ++r) p0[r] = __builtin_amdgcn_exp2f(p0[r]);
}
__device__ __forceinline__ void finishSM(f32x16& p0, f32x16& p1, float alpha, float& l_reg, bf16x8& pa0, bf16x8& pa1, bf16x8& pa2, bf16x8& pa3) {
    for (int r = 0; r < 16; ++r) p1[r] = __builtin_amdgcn_exp2f(p1[r]);
    float ps = 0; for (int r = 0; r < 16; ++r) ps += p0[r]; for (int r = 0; r < 16; ++r) ps += p1[r];
    { auto rr = __builtin_amdgcn_permlane32_swap(__float_as_uint(ps), __float_as_uint(ps), false, false);
      ps = __uint_as_float(rr[0]) + __uint_as_float(rr[1]); }
    l_reg = l_reg * alpha + ps;
#define PK4(P, B_, OUT) do { unsigned a0 = cvtpk(P[B_+0], P[B_+1]), a1 = cvtpk(P[B_+2], P[B_+3]);                          \
        unsigned b0 = cvtpk(P[B_+4], P[B_+5]), b1 = cvtpk(P[B_+6], P[B_+7]);                                             \
        auto r0 = __builtin_amdgcn_permlane32_swap(a0, b0, false, false); auto r1 = __builtin_amdgcn_permlane32_swap(a1, b1, false, false); \
        u32x4 w = {r0[0], r1[0], r0[1], r1[1]}; OUT = *reinterpret_cast<bf16x8*>(&w); } while (0)
    PK4(p0, 0, pa0); PK4(p0, 8, pa1); PK4(p1, 0, pa2); PK4(p1, 8, pa3);
#undef PK4
}
template <bool SK, int MODE>
__device__ __forceinline__ void qkt(f32x16& p0, f32x16& p1, const char* lds, int kslot  , int cslot  , int r32, int hi, const bf16x8* qr, bool act) {
    if (SK && !act) { const float NEG = -__builtin_inff();
#pragma unroll
        for (int r = 0; r < 16; ++r) { p0[r] = NEG; p1[r] = NEG; } return; }
    if (MODE == 1) { const float* cl = (const float*)(lds + OFF_CL) + cslot + 4 * hi;
#pragma unroll
        for (int g = 0; g < 4; ++g) { const f32x4 a = *(const f32x4*)(cl + 8 * g), b = *(const f32x4*)(cl + 32 + 8 * g);
            p0[4 * g] = a[0]; p0[4 * g + 1] = a[1]; p0[4 * g + 2] = a[2]; p0[4 * g + 3] = a[3];
            p1[4 * g] = b[0]; p1[4 * g + 1] = b[1]; p1[4 * g + 2] = b[2]; p1[4 * g + 3] = b[3]; } }
    else { p0 = f32x16{}; p1 = f32x16{}; }
    const char* K_lds = lds + OFF_K + kslot;
    const char* kb[4];
#pragma unroll
    for (int dd = 0; dd < 4; ++dd) kb[dd] = K_lds + KSWZ(r32, (dd * 16 + hi * 8) * 2);
#pragma unroll
    for (int d0 = 0; d0 < 8; ++d0) { const char* a = kb[d0 & 3] + (d0 >> 2) * 128;
        bf16x8 b0 = *reinterpret_cast<const bf16x8*>(a);
        bf16x8 b1 = *reinterpret_cast<const bf16x8*>(a + 32 * 256);
        p0 = __builtin_amdgcn_mfma_f32_32x32x16_bf16(b0, qr[d0], p0, 0, 0, 0);
        p1 = __builtin_amdgcn_mfma_f32_32x32x16_bf16(b1, qr[d0], p1, 0, 0, 0); }
}
template <bool SK>
__device__ __forceinline__ void pv_tile(f32x16* o, int vb0  , bf16x8 pa0, bf16x8 pa1, bf16x8 pa2, bf16x8 pa3, bool act) {
    if (SK && !act) return;
#define TRRD(dst, off) asm volatile("ds_read_b64_tr_b16 %0, %1 offset:%2" : "=&v"(dst) : "v"(vb0), "i"(off) : "memory")
#define RD_D0(d0, L0, H0, L1, H1, L2, H2, L3, H3) do { constexpr int b_ = v_rd_off(d0, 0, 0); \
        TRRD(L0, b_); TRRD(H0, b_ + 2048); TRRD(L1, b_ + 4096); TRRD(H1, b_ + 6144); TRRD(L2, b_ + 8192); TRRD(H2, b_ + 10240); TRRD(L3, b_ + 12288); TRRD(H3, b_ + 14336); } while (0)
#define MM_D0(d0, L0, H0, L1, H1, L2, H2, L3, H3) do { \
        o[d0] = __builtin_amdgcn_mfma_f32_32x32x16_bf16(pa0, (bf16x8){L0[0], L0[1], L0[2], L0[3], H0[0], H0[1], H0[2], H0[3]}, o[d0], 0, 0, 0);   \
        o[d0] = __builtin_amdgcn_mfma_f32_32x32x16_bf16(pa1, (bf16x8){L1[0], L1[1], L1[2], L1[3], H1[0], H1[1], H1[2], H1[3]}, o[d0], 0, 0, 0);   \
        o[d0] = __builtin_amdgcn_mfma_f32_32x32x16_bf16(pa2, (bf16x8){L2[0], L2[1], L2[2], L2[3], H2[0], H2[1], H2[2], H2[3]}, o[d0], 0, 0, 0);   \
        o[d0] = __builtin_amdgcn_mfma_f32_32x32x16_bf16(pa3, (bf16x8){L3[0], L3[1], L3[2], L3[3], H3[0], H3[1], H3[2], H3[3]}, o[d0], 0, 0, 0); } while (0)
    s16x4 al0, ah0, al1, ah1, al2, ah2, al3, ah3, bl0, bh0, bl1, bh1, bl2, bh2, bl3, bh3;
    SBAR();
    RD_D0(0, al0, ah0, al1, ah1, al2, ah2, al3, ah3);
    RD_D0(1, bl0, bh0, bl1, bh1, bl2, bh2, bl3, bh3);
    asm volatile("s_waitcnt lgkmcnt(8)" ::: "memory"); SBAR();
    MM_D0(0, al0, ah0, al1, ah1, al2, ah2, al3, ah3); SBAR();
    RD_D0(2, al0, ah0, al1, ah1, al2, ah2, al3, ah3);
    asm volatile("s_waitcnt lgkmcnt(8)" ::: "memory"); SBAR();
    MM_D0(1, bl0, bh0, bl1, bh1, bl2, bh2, bl3, bh3); SBAR();
    RD_D0(3, bl0, bh0, bl1, bh1, bl2, bh2, bl3, bh3);
    asm volatile("s_waitcnt lgkmcnt(8)" ::: "memory"); SBAR();
    MM_D0(2, al0, ah0, al1, ah1, al2, ah2, al3, ah3); SBAR();
    asm volatile("s_waitcnt lgkmcnt(0)" ::: "memory"); SBAR();
    MM_D0(3, bl0, bh0, bl1, bh1, bl2, bh2, bl3, bh3);
#undef MM_D0
#undef RD_D0
#undef TRRD
}
struct BlockRef { const bf16* Q; const bf16* K; const bf16* V; bf16* O; const float* CB; int P0, jlo, h; };
__device__ __forceinline__ void glds16(const void* sbase, unsigned voff, unsigned lds_dst) { unsigned keep;
    asm volatile("s_mov_b32 %0, m0\n\ts_mov_b32 m0, %3\n\ts_nop 0\n\tglobal_load_lds_dwordx4 %1, %2\n\ts_mov_b32 m0, %0" : "=&s"(keep) : "v"(voff), "s"(sbase), "s"(lds_dst) : "memory"); }
__device__ __forceinline__ void glds4(const void* sbase, unsigned voff, unsigned lds_dst) { unsigned keep;
    asm volatile("s_mov_b32 %0, m0\n\ts_mov_b32 m0, %3\n\ts_nop 0\n\tglobal_load_lds_dword %1, %2\n\ts_mov_b32 m0, %0" : "=&s"(keep) : "v"(voff), "s"(sbase), "s"(lds_dst) : "memory"); }
#define WAIT_BAR(N) asm volatile("s_waitcnt vmcnt(" #N ") lgkmcnt(0)\n\ts_barrier" ::: "memory")
#define LD8(p) (*reinterpret_cast<const bf16x8*>(p))
template <int MODE>
__device__ __forceinline__ void attn_block(const BlockRef& cur, char* lds) {
    constexpr bool SK = (MODE == 0);
    constexpr int NDMA = (MODE == 1) ? 5 : 4;
    int tid = threadIdx.x; asm volatile("" : "+v"(tid));
    const int wid = __builtin_amdgcn_readfirstlane(tid >> 6), lane = tid & 63, r32 = lane & 31, hi = lane >> 5;
    const int j_lo = cur.jlo, NT = cur.P0 / KVBLK + QB / KVBLK - j_lo;
    const int qlo = cur.P0 + wid * QBLK, qm = qlo + r32 - 4 * hi;
    float* ws = (float*)(lds + OFF_WS) + wid * 64; float* li_l = ws, * al_l = ws + 32;
    const float* tbh = (const float*)(lds + OFF_TB) + cur.h * 256;
    float m_reg = -1e30f, l_reg = 0; f32x16 o[4] = {};
    const unsigned lds0 = (unsigned)(uintptr_t)lds;
    const int vb0 = (int)lds0 + OFF_V + v_rd_base(lane);
    unsigned koff0, koff1, voff0, voff1;
    { const int pc = wid * 2; int row = pc * 4 + (lane >> 4), c = (lane & 15) ^ (row & 7); koff0 = (unsigned)((row * LDQ + c * 8) * 2);
      row += 4; c = (lane & 15) ^ (row & 7); koff1 = (unsigned)((row * LDQ + c * 8) * 2);
      int st = 2 * pc + (lane >> 5), kk = ((st >> 2) << 3) | ((lane & 31) >> 2), k = (kk & ~0xC) | ((kk & 4) << 1) | ((kk & 8) >> 1); voff0 = (unsigned)((k * LDQ + (st & 3) * 32 + (lane & 3) * 8) * 2);
      st += 2; kk = ((st >> 2) << 3) | ((lane & 31) >> 2); k = (kk & ~0xC) | ((kk & 4) << 1) | ((kk & 8) >> 1); voff1 = (unsigned)((k * LDQ + (st & 3) * 32 + (lane & 3) * 8) * 2); }
    const unsigned kdst = lds0 + OFF_K + wid * 2048, vdst = lds0 + OFF_V + wid * 2048, cdst = lds0 + OFF_CL, lane4 = (unsigned)lane * 4u;
#define TIDX(t) (MODE == 1 ? (j_lo + NT - 1 - (t)) : (j_lo + (t)))
#define TILEB(t) ((size_t)TIDX(t) * (KVBLK * LDQ * 2))
#define DMA_K(t, slot) do { const char* g_ = (const char*)cur.K + TILEB(t); glds16(g_, koff0, kdst + (slot)); glds16(g_, koff1, kdst + (slot) + 1024); \
                            if (MODE == 1) glds4(cur.CB + (size_t)TIDX(t) * KVBLK, lane4, cdst + ((slot) >> 6)); } while (0)
#define DMA_V(t, slot) do { const char* g_ = (const char*)cur.V + TILEB(t); glds16(g_, voff0, vdst + (slot)); glds16(g_, voff1, vdst + (slot) + 1024); } while (0)
#define RESC(a) do { if (__any((a) < 1.f)) { if (hi == 0) al_l[r32] = (a); asm volatile("s_waitcnt lgkmcnt(0)" ::: "memory");              \
                     for (int d_ = 0; d_ < 4; ++d_) for (int r = 0; r < 16; ++r) o[d_][r] *= al_l[crow(r, hi)]; } } while (0)
#define KBASE(t) (TIDX(t) * KVBLK)
#define ACT(t) (MODE == 0 ? (KBASE(t) <= qlo) : true)
#define MASKT(P0_, P1_, t) do { const int kb_ = KBASE(t);                                                                              \
        if (MODE == 1) { if (kb_ + KVBLK - 1 > qlo) mask_tile(P0_, P1_, qm - kb_, 0x40000000u); }                                       \
        else { if (kb_ <= qlo && kb_ + KVBLK - 1 - qlo >= -90) add_bias(P0_, P1_, tbh, kb_ - qm + 192); } } while (0)
    DMA_K(0, 0); DMA_V(0, 0); DMA_K(1, SHM_K);
    bf16x8 qr[8];
    { const unsigned qo = (unsigned)(((wid * QBLK + r32) * LDQ + hi * 8) * 2);
#pragma unroll
      for (int d0 = 0; d0 < 8; ++d0) qr[d0] = LD8((const char*)cur.Q + qo + d0 * 32); }
    WAIT_BAR(0);
    int sl_prev = 2 * SHM_K, sl_cur = 0, sl_nxt = SHM_K;
#define ROT() do { const int t_ = sl_prev; sl_prev = sl_cur; sl_cur = sl_nxt; sl_nxt = t_; } while (0)
    f32x16 pA0, pA1, pB0, pB1; float mnA, mnB, alA, alB; bf16x8 pa0, pa1, pa2, pa3;
    DMA_K(2, sl_prev); DMA_V(1, sl_nxt);
    SBAR(); qkt<SK, MODE>(pA0, pA1, lds, sl_cur, sl_cur >> 8, r32, hi, qr, ACT(0));
    MASKT(pA0, pA1, 0); partialSM(pA0, pA1, m_reg, mnA, alA);
    if (2 < NT) { if (MODE == 1) WAIT_BAR(5); else WAIT_BAR(4); } else WAIT_BAR(0);
    ROT();
#define STEP(PL, PX0, PX1, mnX, alX, PY0, PY1, alY, s) do {                                                                    \
        if ((PL) || (s) + 2 < NT) DMA_K((s) + 2, sl_prev);                                                                     \
        if ((PL) || (s) + 1 < NT) DMA_V((s) + 1, sl_nxt);                                                                      \
        SBAR(); qkt<(SK && !(PL)), MODE>(PX0, PX1, lds, sl_cur, sl_cur >> 8, r32, hi, qr, ACT(s));                             \
        finishSM(PY0, PY1, alY, l_reg, pa0, pa1, pa2, pa3); SBAR();                                                            \
        pv_tile<(SK && !(PL))>(o, vb0 + sl_prev, pa0, pa1, pa2, pa3, ACT((s) - 1)); if (!(PL) || MODE == 1) MASKT(PX0, PX1, (s)); partialSM(PX0, PX1, m_reg, mnX, alX); \
        RESC(alX);                                                                                                             \
        if ((PL) || (s) + 2 < NT) { if (MODE == 1) WAIT_BAR(5); else WAIT_BAR(4); } else WAIT_BAR(0);                          \
        ROT(); } while (0)
    int s = 1;
    { const int NH = NT - (MODE == 0 ? 6 : 0) - 2;
      for (; s + 1 < NH; s += 2) {
        STEP(true, pB0, pB1, mnB, alB, pA0, pA1, alA, s);
        STEP(true, pA0, pA1, mnA, alA, pB0, pB1, alB, s + 1);
      } }
    for (; s + 1 < NT; s += 2) {
        STEP(false, pB0, pB1, mnB, alB, pA0, pA1, alA, s);
        STEP(false, pA0, pA1, mnA, alA, pB0, pB1, alB, s + 1);
    }
    if (s < NT) {
        STEP(false, pB0, pB1, mnB, alB, pA0, pA1, alA, s);
        finishSM(pB0, pB1, alB, l_reg, pa0, pa1, pa2, pa3); SBAR(); pv_tile<SK>(o, vb0 + sl_prev, pa0, pa1, pa2, pa3, ACT(NT - 1));
    } else {
        finishSM(pA0, pA1, alA, l_reg, pa0, pa1, pa2, pa3); SBAR(); pv_tile<SK>(o, vb0 + sl_prev, pa0, pa1, pa2, pa3, ACT(NT - 1));
    }
    if (hi == 0) li_l[r32] = l_reg; asm volatile("s_waitcnt lgkmcnt(0)" ::: "memory");
    float rli[16];
#pragma unroll
    for (int r = 0; r < 16; ++r) rli[r] = __builtin_amdgcn_rcpf(li_l[crow(r, hi)]);
    char* Ow = (char*)cur.O; const unsigned oo = (unsigned)(((wid * QBLK + 4 * hi) * LDO + r32) * 2);
#pragma unroll
    for (int r = 0; r < 16; ++r) { const unsigned orow = (unsigned)(((r & 3) + 8 * (r >> 2)) * LDO * 2);
#pragma unroll
        for (int d0 = 0; d0 < 4; ++d0) { const float v = o[d0][r] * rli[r];
            const float vn = __shfl_xor(v, 1);
            if ((r32 & 1) == 0) *(unsigned*)(Ow + (oo + orow + d0 * 64)) = cvtpk(v, vn); } }
    asm volatile("s_waitcnt lgkmcnt(0)\n\ts_barrier" ::: "memory");
#undef TILEB
#undef TIDX
#undef DMA_K
#undef DMA_V
#undef RESC
#undef KBASE
#undef ACT
#undef MASKT
#undef ROT
#undef STEP
}
#undef WAIT_BAR
#undef LD8
#undef SBAR
#undef KSWZ
}
#define GAS __attribute__((address_space(1)))
#define LAS __attribute__((address_space(3)))
typedef unsigned short bf16;
typedef unsigned v4u __attribute__((ext_vector_type(4)));
typedef unsigned v2u __attribute__((ext_vector_type(2)));
typedef float f32x4 __attribute__((ext_vector_type(4)));
constexpr int NWAVES = 8;
constexpr int BATCH = 2, SEQ = 16384, DM = 2048, TOK = BATCH * SEQ, FF = 8192, NQKV = 6144, NQKV1 = 6400, FH = 16;
constexpr float NORM_EPS = 1e-6f, SUBLN_EPS = 1e-5f, LAMBDA_INIT = 0.2f;
constexpr size_t MiB = 1u << 20;
constexpr size_t WS_F = 0, WS_CB = 2 * MiB;
constexpr size_t WS_WQKV0 = 4 * MiB, WS_WOA = 28 * MiB, WS_WMI0 = 36 * MiB, WS_WMO0 = 68 * MiB, WS_WQKV1 = 100 * MiB, WS_WOB = 126 * MiB, WS_WMI1 = 134 * MiB, WS_WMO1 = 166 * MiB;
constexpr size_t WS_NRM = 198 * MiB;
constexpr size_t WS_RS = 198 * MiB + 65536;
constexpr size_t WS_BAR = 199 * MiB;
constexpr size_t WS_HB = 712 * MiB;
constexpr size_t WS_QKV = 200 * MiB;
constexpr size_t WS_OC = 584 * MiB;
constexpr size_t WS_HID = 200 * MiB;
constexpr size_t WS_XN = 840 * MiB;
constexpr size_t WS_END = 968 * MiB;
constexpr int LDS_BYTES = 147456;

__device__ __forceinline__ GAS unsigned char* launder_g(GAS unsigned char* p) { asm volatile("" : "+s"(p)); return p; }
__device__ __forceinline__ unsigned f2bf(float f) { unsigned u = __builtin_bit_cast(unsigned, f); return (u + 0x7fffu + ((u >> 16) & 1u)) >> 16; }
__device__ __forceinline__ unsigned pk2(float lo, float hi) { return f2bf(lo) | (f2bf(hi) << 16); }
__device__ __forceinline__ float bf2f(unsigned short b) { return __builtin_bit_cast(float, (unsigned)b << 16); }
__device__ __forceinline__ float wave_sum(float v) {
#pragma unroll
    for (int o = 1; o < 64; o <<= 1) v += __shfl_xor(v, o);
    return v;
}
__device__ __forceinline__ void transpose_item(const float* W, int K, int N, bf16* WT, int row_off, const float* g, LAS float* scr, int item, int lane) {
    const int nblk = N / 64, kb = item / nblk, nb = item % nblk, k0 = 64 * kb, n0 = 64 * nb, kr = lane >> 4, nq = lane & 15;
    f32x4 v[16];
#pragma unroll
    for (int i = 0; i < 16; ++i) v[i] = *(const f32x4*)(W + (size_t)(k0 + 4 * i + kr) * N + n0 + 4 * nq);
#pragma unroll
    for (int i = 0; i < 16; ++i) { const int kk = 4 * i + kr; f32x4 t = v[i]; if (g) t = t * g[k0 + kk];
        scr[(4 * nq + 0) * 65 + kk] = t[0]; scr[(4 * nq + 1) * 65 + kk] = t[1]; scr[(4 * nq + 2) * 65 + kk] = t[2]; scr[(4 * nq + 3) * 65 + kk] = t[3]; }
    asm volatile("s_waitcnt lgkmcnt(0)" ::: "memory");
    const int c = lane & 7;
#pragma unroll
    for (int j = 0; j < 8; ++j) { const int n = (lane >> 3) + 8 * j; const LAS float* sp = scr + n * 65 + 8 * c;
        v4u o; o.x = pk2(sp[0], sp[1]); o.y = pk2(sp[2], sp[3]); o.z = pk2(sp[4], sp[5]); o.w = pk2(sp[6], sp[7]);
        *(v4u*)(WT + (size_t)(row_off + n0 + n) * K + k0 + 8 * c) = o; }
    asm volatile("s_waitcnt lgkmcnt(0)" ::: "memory");
}
__device__ __forceinline__ void norm_row_to_bf16(const float* xrow, bf16* orow, int lane) {
    const f32x4* xr = (const f32x4*)xrow + lane;
    f32x4 v[8]; float s = 0.f;
#pragma unroll
    for (int j = 0; j < 8; ++j) { v[j] = xr[64 * j]; s += (v[j].x * v[j].x + v[j].y * v[j].y) + (v[j].z * v[j].z + v[j].w * v[j].w); }
    const float rstd = 1.f / sqrtf(wave_sum(s) * (1.f / DM) + NORM_EPS);
    v2u* o8 = (v2u*)orow + lane;
#pragma unroll
    for (int j = 0; j < 8; ++j) { v2u w; w.x = pk2(v[j].x * rstd, v[j].y * rstd); w.y = pk2(v[j].z * rstd, v[j].w * rstd); o8[64 * j] = w; }
}
__device__ __forceinline__ void norm_phase(const float* src, bf16* dst, int gw, int NGW, int lane) {
    for (int m = gw; m < TOK; m += NGW) norm_row_to_bf16(src + (size_t)m * DM, dst + (size_t)m * DM, lane);
}
__device__ __forceinline__ void final_norm_phase(float* io, const float* g, const float* rs, int gw, int NGW, int lane) {
    for (int m = gw; m < TOK; m += NGW) {
        f32x4* xr = (f32x4*)(io + (size_t)m * DM) + lane; const f32x4* gr = (const f32x4*)g + lane;
        const float rstd = 1.f / sqrtf(rs[m] * (1.f / DM) + NORM_EPS);
#pragma unroll
        for (int j = 0; j < 8; ++j) xr[64 * j] = xr[64 * j] * rstd * gr[64 * j];
    }
}
__device__ __forceinline__ void combine_phase(const bf16* OC, bf16* O, const float* lq1, const float* lk1, const float* lq2, const float* lk2, const float* sg, int gw, int NGW, int lane) {
    const float s1 = wave_sum(lq1[lane] * lk1[lane] + lq1[lane + 64] * lk1[lane + 64]), s2 = wave_sum(lq2[lane] * lk2[lane] + lq2[lane + 64] * lk2[lane + 64]);
    const float lam = expf(s1) - expf(s2) + LAMBDA_INIT;
    float gs[8];
#pragma unroll
    for (int e = 0; e < 8; ++e) gs[e] = sg[(lane & 31) * 8 + e] * (1.f - LAMBDA_INIT);
    for (int m = gw; m < TOK; m += NGW) {
        const v4u* a = (const v4u*)(OC + (size_t)m * DM) + lane; const v4u* b = (const v4u*)(OC + (size_t)TOK * DM + (size_t)m * DM) + lane; v4u* o = (v4u*)(O + (size_t)m * DM) + lane;
#pragma unroll
        for (int st = 0; st < 4; ++st) { const v4u av = a[64 * st], bv = b[64 * st]; float d[8]; float ss = 0.f;
#pragma unroll
            for (int e = 0; e < 4; ++e) { const unsigned aw = av[e], bw = bv[e];
                d[2 * e] = __builtin_bit_cast(float, aw << 16) - lam * __builtin_bit_cast(float, bw << 16);
                d[2 * e + 1] = __builtin_bit_cast(float, aw & 0xffff0000u) - lam * __builtin_bit_cast(float, bw & 0xffff0000u);
                ss += d[2 * e] * d[2 * e] + d[2 * e + 1] * d[2 * e + 1]; }
#pragma unroll
            for (int of = 1; of < 32; of <<= 1) ss += __shfl_xor(ss, of);
            const float rstd = 1.f / sqrtf(ss * (1.f / 256.f) + SUBLN_EPS);
            v4u w; w.x = pk2(d[0] * rstd * gs[0], d[1] * rstd * gs[1]); w.y = pk2(d[2] * rstd * gs[2], d[3] * rstd * gs[3]);
            w.z = pk2(d[4] * rstd * gs[4], d[5] * rstd * gs[5]); w.w = pk2(d[6] * rstd * gs[6], d[7] * rstd * gs[7]); o[64 * st] = w; }
    }
}
__device__ __forceinline__ void cumsum_phase(const float* F, const float* bfb, float* CB, LAS unsigned char* lds, int bx, int G, int tid) {
    LAS double* sc = (LAS double*)lds;
    for (int bh = bx; bh < BATCH * FH; bh += G) {
        const int b = bh / FH, h = bh % FH; const float bias = bfb[h];
        const float* fp = F + ((size_t)b * SEQ + (size_t)tid * 32) * FH + h;
        float ls[32]; double run = 0.0;
#pragma unroll
        for (int i = 0; i < 32; ++i) { const float x = fp[(size_t)i * FH] + bias; ls[i] = fminf(x, 0.f) - log1pf(expf(-fabsf(x))); run += (double)ls[i]; }
        sc[tid] = run; __syncthreads();
        int cur = 0;
        for (int of = 1; of < 512; of <<= 1) { double v = sc[cur * 512 + tid]; if (tid >= of) v += sc[cur * 512 + tid - of]; sc[(cur ^ 1) * 512 + tid] = v; cur ^= 1; __syncthreads(); }
        double acc = sc[cur * 512 + tid] - run;
        float* op = CB + (size_t)bh * SEQ + (size_t)tid * 32;
#pragma unroll
        for (int i = 0; i < 32; ++i) { acc += (double)ls[i]; op[i] = (float)(-acc * 11.313708498984761); }
        __syncthreads();
    }
}

__device__ __forceinline__ void rownorm_phase(const bf16* QKV, unsigned* NRM, int bx, int G, int tid) {
    for (int vw = bx; vw < 256; vw += G) {
        const int bh = vw >> 3, part = vw & 7, b = bh >> 4, h = bh & 15;
        const char* base = (const char*)(QKV + ((size_t)b * SEQ + (size_t)part * 2048) * NQKV + h * 128);
        const unsigned vo = (unsigned)(((tid >> 4) * NQKV + (tid & 15) * 8) * 2);
        float mq = 0.f, mk = 0.f;
#pragma unroll 4
        for (int it = 0; it < 64; ++it) {
            const char* rp = base + (size_t)it * 32 * NQKV * 2;
            const v4u qv = *(const v4u*)(rp + vo), kv = *(const v4u*)(rp + vo + 2048 * 2);
            float sq = 0.f, sk = 0.f;
#pragma unroll
            for (int e = 0; e < 4; ++e) { const float a0 = __builtin_bit_cast(float, qv[e] << 16), a1 = __builtin_bit_cast(float, qv[e] & 0xffff0000u), b0 = __builtin_bit_cast(float, kv[e] << 16), b1 = __builtin_bit_cast(float, kv[e] & 0xffff0000u);
                sq += a0 * a0 + a1 * a1; sk += b0 * b0 + b1 * b1; }
#pragma unroll
            for (int of = 1; of < 16; of <<= 1) { sq += __shfl_xor(sq, of); sk += __shfl_xor(sk, of); }
            mq = fmaxf(mq, sq); mk = fmaxf(mk, sk);
        }
        mq = fmaxf(mq, __shfl_xor(mq, 16)); mq = fmaxf(mq, __shfl_xor(mq, 32)); mk = fmaxf(mk, __shfl_xor(mk, 16)); mk = fmaxf(mk, __shfl_xor(mk, 32));
        if ((tid & 63) == 0) { atomicMax(NRM + bh * 2, __float_as_uint(mq)); atomicMax(NRM + bh * 2 + 1, __float_as_uint(mk)); }
    }
}

#define XB_TMO      128
#define XB_XCNT(j)  (256  + 64 * (j))
#define XB_XSUB(j)  (1280 + 64 * (j))
#define XB_XGEN(j)  (2304 + 64 * (j))
#define XB_TOP      3328
#define XB_TOPGEN   3392
#define XCD_BAR_WORDS 3456
#define XB_SPIN_CAP (1u << 18)

__device__ __forceinline__ unsigned xb_ld(unsigned* p)              { return __hip_atomic_load(p, __ATOMIC_RELAXED, __HIP_MEMORY_SCOPE_AGENT); }
__device__ __forceinline__ unsigned xb_add(unsigned* p, unsigned v) { return __hip_atomic_fetch_add(p, v, __ATOMIC_RELAXED, __HIP_MEMORY_SCOPE_AGENT); }
__device__ __forceinline__ unsigned xb_xcc_id() { return (unsigned)__builtin_amdgcn_s_getreg((3 << 11) | 20) & 0xFu; }
#define XB_SPIN(cond, bar) do { unsigned _sp = 0; while (cond) { __builtin_amdgcn_s_sleep(1); \
    if ((++_sp & 255u) == 0u) { if (xb_ld(&(bar)[XB_TMO])) break; if (_sp > XB_SPIN_CAP) { atomicAdd(&(bar)[XB_TMO], 1u); break; } } } } while (0)

struct XcdBarrier {
    unsigned* bar; unsigned x;
    volatile LAS unsigned* st;
};

__device__ __forceinline__ XcdBarrier xcd_barrier_post(unsigned* bar, volatile LAS unsigned* st) {
    XcdBarrier b; b.bar = bar; b.x = xb_xcc_id(); b.st = st;
    if (threadIdx.x == 0) (void)xb_add(&bar[XB_XCNT(b.x)], 1u);
    return b;
}
__device__ __forceinline__ void xcd_barrier_complete(unsigned* bar, unsigned x, unsigned& nloc, unsigned& nx) {
    const unsigned G = gridDim.x * gridDim.y * gridDim.z;
    unsigned sum, cnt, mine, sp = 0u;
    for (;;) {
        sum = 0u; cnt = 0u; mine = 0u;
#pragma unroll
        for (unsigned j = 0; j < 16; ++j) { const unsigned c = xb_ld(&bar[XB_XCNT(j)]); sum += c; cnt += (c > 0u) ? 1u : 0u; mine = (j == x) ? c : mine; }
        if (sum == G) break;
        __builtin_amdgcn_s_sleep(1);
        if ((++sp & 255u) == 0u) { if (xb_ld(&bar[XB_TMO])) break; if (sp > XB_SPIN_CAP) { atomicAdd(&bar[XB_TMO], 1u); break; } }
    }
    nloc = mine > 0u ? mine : 1u; nx = cnt > 0u ? cnt : 1u;
}

__device__ __forceinline__ void xcd_barrier(const XcdBarrier& b) {
    asm volatile("s_waitcnt vmcnt(0)" ::: "memory");
    __syncthreads();
    if (threadIdx.x == 0) {
        unsigned* bar = b.bar;
        __builtin_amdgcn_s_waitcnt(0);
        unsigned nloc = b.st[0], nx = b.st[1];
        if (nloc == 0u) { xcd_barrier_complete(bar, b.x, nloc, nx); b.st[0] = nloc; b.st[1] = nx; }
        const unsigned old = xb_add(&bar[XB_XSUB(b.x)], 1u);
        const unsigned gen = old / nloc;
        if (old + 1u == (gen + 1u) * nloc) {
            __builtin_amdgcn_fence(__ATOMIC_RELEASE, "agent");
            asm volatile("s_waitcnt vmcnt(0)" ::: "memory");
            const unsigned og = xb_add(&bar[XB_TOP], 1u);
            const unsigned tg = og / nx;
            if (og + 1u == (tg + 1u) * nx) xb_add(&bar[XB_TOPGEN], 1u);
            else XB_SPIN(xb_ld(&bar[XB_TOPGEN]) == tg, bar);
            __builtin_amdgcn_fence(__ATOMIC_ACQUIRE, "agent");
            xb_add(&bar[XB_XGEN(b.x)], 1u);
            asm volatile("s_waitcnt vmcnt(0)" ::: "memory");
        } else {
            XB_SPIN(xb_ld(&bar[XB_XGEN(b.x)]) == gen, bar);
            __builtin_amdgcn_fence(__ATOMIC_ACQUIRE, "agent");
            asm volatile("s_waitcnt vmcnt(0)" ::: "memory");
        }
    }
    __syncthreads();
}

struct Args { const float* in[21]; float* out; unsigned char* ws; };
template <int MODE> __device__ __forceinline__ bool attn_item(int i, int G, int bx, int& s, int& x) {
    constexpr int NS = MODE == 0 ? 64 : 32;
    if ((G & 7) == 0) { const int xcd = bx & 7, k = bx >> 3, kpx = G >> 3; const int idx = k + i * kpx; if (idx >= (NS / 8) * 32) return false; s = (idx >> 5) * 8 + xcd; x = idx & 31; return true; }
    const int L = bx + i * G; if (L >= NS * 32) return false; s = L >> 5; x = L & 31; return true;
}
template <int MODE> __device__ __forceinline__ att::BlockRef attn_ref(int s, int qb, int jlo, const bf16* QKV, bf16* Obuf, const float* CB) {
    att::BlockRef r; r.P0 = qb * 256; r.jlo = jlo;
    if (MODE == 0) { const int xcd = s & 7, sl = s >> 3, vh = sl & 1, c = (sl >> 1) & 1, bh = xcd * 2 + ((sl >> 2) & 1), b = bh >> 3, h = bh & 7;
        const bf16* base = QKV + (size_t)b * SEQ * NQKV;
        r.Q = base + (size_t)r.P0 * NQKV + h * 256 + c * 128; r.K = base + 2048 + h * 256 + c * 128; r.V = base + 4096 + h * 256 + vh * 128;
        r.O = Obuf + (size_t)c * TOK * DM + ((size_t)b * SEQ + r.P0) * DM + h * 256 + vh * 128; r.CB = nullptr; r.h = h; }
    else { const int b = s >> 4, h = s & 15; const bf16* base = QKV + (size_t)b * SEQ * NQKV;
        r.Q = base + (size_t)r.P0 * NQKV + h * 128; r.K = base + 2048 + h * 128; r.V = base + 4096 + h * 128;
        r.O = Obuf + ((size_t)b * SEQ + r.P0) * DM + h * 128; r.CB = CB + (size_t)s * SEQ; r.h = 0; }
    return r;
}
template <int MODE> __device__ __forceinline__ void attn_phase(char* lds, const bf16* QKV, bf16* Obuf, const float* CB, const unsigned* NRM, int G, int bx) {
    int* jt = (int*)(lds + att::OFF_TB);
    if (MODE == 1) {
        int tid = threadIdx.x; asm volatile("" : "+v"(tid)); const int w = __builtin_amdgcn_readfirstlane(tid >> 6), lane = tid & 63;
        if (tid < 64) jt[tid] = 0;
        __syncthreads();
        for (int e = w; e < 64; e += 8) { int s, x; if (!attn_item<MODE>(e >> 1, G, bx, s, x)) break;
            const int qb = (e & 1) ? 63 - x : x, jmax = qb * 4; const float* cb = CB + (size_t)s * SEQ;
            const float qn = sqrtf(__uint_as_float(NRM[s * 2])) * 1.01f, kn = sqrtf(__uint_as_float(NRM[s * 2 + 1])) * 1.01f;
            const float thr = cb[qb * 256] - 110.f * 11.313708498984761f - 2.f * qn * kn;
            int need = 0;
            for (int j0 = jmax - 1; j0 >= 0; j0 -= 64) { const int j = j0 - lane; const bool c = (j >= 0) && (cb[(j >= 0 ? j : 0) * 64 + 63] >= thr);
                const unsigned long long m = __ballot(c); const int n = __builtin_popcountll(m); need += n; if (n < 64) break; }
            if (lane == 0) jt[e] = jmax - need; }
        __syncthreads();
    }
    for (int i = 0; ; ++i) { int s, x; if (!attn_item<MODE>(i, G, bx, s, x)) break;
        for (int pass = 0; pass < 2; ++pass) {
            const int jl = (MODE == 1 && i < 32) ? jt[i * 2 + pass] : 0;
            const att::BlockRef cur = attn_ref<MODE>(s, pass ? 63 - x : x, jl, QKV, Obuf, CB);
            att::attn_block<MODE>(cur, lds); } }
}

__global__ void __launch_bounds__(NWAVES * 64, 2) yoco_fwd(Args args) {
    extern __shared__ __attribute__((aligned(16))) unsigned char lds[];
    cg::grid_group grid = cg::this_grid();
    LAS unsigned char* ldsl = (LAS unsigned char*)lds;
    const int G = gridDim.x, bx = blockIdx.x, NGW = G * NWAVES;
    int tid, lane, wave, gw;
#define FRESH() do { tid = threadIdx.x; asm volatile("" : "+v"(tid)); lane = tid & 63; wave = __builtin_amdgcn_readfirstlane(tid >> 6); gw = bx * NWAVES + wave; } while (0)
    FRESH();
#define WSP(T, off) ((T*)(launder_g((GAS unsigned char*)args.ws) + (off)))
#define Wqkv0 WSP(bf16, WS_WQKV0)
#define Woa WSP(bf16, WS_WOA)
#define Wmi0 WSP(bf16, WS_WMI0)
#define Wmo0 WSP(bf16, WS_WMO0)
#define Wqkv1 WSP(bf16, WS_WQKV1)
#define Wob WSP(bf16, WS_WOB)
#define Wmi1 WSP(bf16, WS_WMI1)
#define Wmo1 WSP(bf16, WS_WMO1)
#define QKV WSP(bf16, WS_QKV)
#define OC WSP(bf16, WS_OC)
#define HID WSP(bf16, WS_HID)
#define XN WSP(bf16, WS_XN)
#define Fb WSP(float, WS_F)
#define CB WSP(float, WS_CB)
#define NRM WSP(unsigned, WS_NRM)
#define RS WSP(float, WS_RS)
#define HB WSP(bf16, WS_HB)
#define out ((float*)launder_g((GAS unsigned char*)args.out))
#define XIN ((const float*)launder_g((GAS unsigned char*)args.in[0]))
    volatile LAS unsigned* xst = (volatile LAS unsigned*)(ldsl + LDS_BYTES - 64);
    if (tid < 2) xst[tid] = 0u;
    __syncthreads();
    const XcdBarrier xbar = xcd_barrier_post(WSP(unsigned, WS_BAR), xst);

    {
        LAS float* scr = (LAS float*)(ldsl + wave * 16640);
        bf16* const wqkv1 = Wqkv1;
        const float* ag = args.in[2]; const float* mg = args.in[3]; const float* kg = args.in[11];
        constexpr int I_QKV = (DM / 64) * (NQKV / 64), I_DD = (DM / 64) * (DM / 64), I_MI = (DM / 64) * (FF / 64), I_MO = (FF / 64) * (DM / 64);
        constexpr int NITEMS = I_QKV + 5 * I_DD + 2 * I_MI + 2 * I_MO;
        for (int it = gw; it < NITEMS; it += NGW) {
            int r = it;
            if (r < I_QKV) { transpose_item(args.in[4], DM, NQKV, Wqkv0, 0, ag, scr, r, lane); continue; } r -= I_QKV;
            if (r < I_DD) { transpose_item(args.in[10], DM, DM, Woa, 0, nullptr, scr, r, lane); continue; } r -= I_DD;
            if (r < I_DD) { transpose_item(args.in[16], DM, DM, wqkv1, 0, ag + DM, scr, r, lane); continue; } r -= I_DD;
            if (r < I_DD) { transpose_item(args.in[12], DM, DM, wqkv1, DM, kg, scr, r, lane); continue; } r -= I_DD;
            if (r < I_DD) { transpose_item(args.in[13], DM, DM, wqkv1, 2 * DM, kg, scr, r, lane); continue; } r -= I_DD;
            if (r < I_DD) { transpose_item(args.in[17], DM, DM, Wob, 0, nullptr, scr, r, lane); continue; } r -= I_DD;
            if (r < I_MI) { transpose_item(args.in[18], DM, FF, Wmi0, 0, mg, scr, r, lane); continue; } r -= I_MI;
            if (r < I_MI) { transpose_item(args.in[18] + (size_t)DM * FF, DM, FF, Wmi1, 0, mg + DM, scr, r, lane); continue; } r -= I_MI;
            if (r < I_MO) { transpose_item(args.in[19], FF, DM, Wmo0, 0, nullptr, scr, r, lane); continue; } r -= I_MO;
            transpose_item(args.in[19] + (size_t)FF * DM, FF, DM, Wmo1, 0, nullptr, scr, r, lane);
        }
        { const float* wf = args.in[14]; const int gt = bx * 512 + tid, NT_ = G * 512;
          for (int e = gt; e < (NQKV1 - NQKV) * DM; e += NT_) { const int n = e / DM, k = e % DM; wqkv1[(size_t)(NQKV + n) * DM + k] = (n < FH) ? (bf16)f2bf(wf[(size_t)k * FH + n] * kg[k]) : (bf16)0; } }
        if (bx == 0 && tid < 64) NRM[tid] = 0u;
        { float* rsz = RS; for (int e = bx * 512 + tid; e < 4 * TOK; e += G * 512) rsz[e] = 0.f; }
        norm_phase(XIN, XN, gw, NGW, lane);
    }
    grid.sync();
#define GSYNC() xcd_barrier(xbar)
#define GEMM_PHASE(EPI, A_, B_, N_, K_, ...) do { pg8::Gemm g{A_, B_, TOK, N_, K_}; pg8::StaticOrder S; S.init(TOK, N_, G, bx); EPI E{__VA_ARGS__}; \
        pg8::gemm_phase<EPI, pg8::StaticOrder, PG8_ALIGN, PG8_SP2>(ldsl, g, S, E); } while (0)
    typedef pg8::EpiX<0, false, false, false> EpiQKV0; typedef pg8::EpiX<3, true, false, false> EpiQKV1; typedef pg8::EpiX<1, true, false, false> EpiMlpIn;
    typedef pg8::EpiX<2, false, true, true> EpiRes; typedef pg8::EpiX<2, false, false, true> EpiResLast;
    GEMM_PHASE(EpiQKV0, XN, Wqkv0, NQKV, DM, QKV, NQKV, nullptr, nullptr, nullptr, nullptr, nullptr);
    GSYNC();
    {
      FRESH(); const float* tab = args.in[1]; float* tb = (float*)(lds + att::OFF_TB);
      for (int idx = tid; idx < 2048; idx += 512) { const int h = idx >> 8, rel = (idx & 255) - 192; const int n = rel < 0 ? -rel : rel;
          int bk = n < 8 ? n : 8 + (n >= 12) + (n >= 16) + (n >= 23) + (n >= 32) + (n >= 46) + (n >= 64) + (n >= 91); if (rel > 0) bk += 16;
          tb[idx] = (tab[bk * 8 + h] - tab[15 * 8 + h]) * 11.313708498984761f; }
      __syncthreads();
      attn_phase<0>((char*)lds, QKV, OC, nullptr, nullptr, G, bx);
    }
    GSYNC();
    FRESH(); combine_phase(OC, XN, args.in[5], args.in[6], args.in[7], args.in[8], args.in[9], gw, NGW, lane);
    GSYNC();
    GEMM_PHASE(EpiRes, XN, Woa, DM, DM, HB, DM, XIN, out, nullptr, nullptr, RS);
    GSYNC();
    GEMM_PHASE(EpiMlpIn, HB, Wmi0, FF, DM, HID, FF, nullptr, nullptr, nullptr, RS, nullptr);
    GSYNC();
    GEMM_PHASE(EpiRes, HID, Wmo0, DM, FF, XN, DM, out, out, nullptr, nullptr, RS + TOK);
    GSYNC();
    GEMM_PHASE(EpiQKV1, XN, Wqkv1, NQKV1, DM, QKV, NQKV, nullptr, nullptr, Fb, RS + TOK, nullptr);
    GSYNC();
    FRESH(); cumsum_phase(Fb, args.in[15], CB, ldsl, bx, G, tid);
    rownorm_phase(QKV, NRM, bx, G, tid);
    GSYNC();
    attn_phase<1>((char*)lds, QKV, XN, CB, NRM, G, bx);
    GSYNC();
    GEMM_PHASE(EpiRes, XN, Wob, DM, DM, HB, DM, out, out, nullptr, nullptr, RS + 2 * TOK);
    GSYNC();
    GEMM_PHASE(EpiMlpIn, HB, Wmi1, FF, DM, HID, FF, nullptr, nullptr, nullptr, RS + 2 * TOK, nullptr);
    GSYNC();
    GEMM_PHASE(EpiResLast, HID, Wmo1, DM, FF, nullptr, DM, out, out, nullptr, nullptr, RS + 3 * TOK);
    GSYNC();
    FRESH(); final_norm_phase(out, args.in[20], RS + 3 * TOK, gw, NGW, lane);
}

#undef out
#undef XIN
extern "C" void kernel_launch(void* const* d_in, const int* in_sizes, int n_in, void* d_out, int out_size, void* d_ws, size_t ws_size, hipStream_t stream) {
    static int grid = 0;
    if (grid == 0) {
        if (n_in != 21 || in_sizes[0] != TOK * DM || out_size != TOK * DM || ws_size < WS_END) { fprintf(stderr, "kernel_launch: unexpected shapes (n_in %d, in0 %d, out %d, ws %zu)\n", n_in, n_in > 0 ? in_sizes[0] : -1, out_size, ws_size); grid = -1; return; }
        int dev = 0, cus = 0, per_cu = 0;
        (void)hipGetDevice(&dev); (void)hipDeviceGetAttribute(&cus, hipDeviceAttributeMultiprocessorCount, dev);
        if (hipFuncSetAttribute((const void*)yoco_fwd, hipFuncAttributeMaxDynamicSharedMemorySize, LDS_BYTES) != hipSuccess) { fprintf(stderr, "kernel_launch: hipFuncSetAttribute failed\n"); grid = -1; return; }
        if (hipOccupancyMaxActiveBlocksPerMultiprocessor(&per_cu, (const void*)yoco_fwd, NWAVES * 64, LDS_BYTES) != hipSuccess || per_cu < 1) { fprintf(stderr, "kernel_launch: occupancy query gives %d\n", per_cu); per_cu = 1; }
        (void)hipGetLastError();
        grid = cus > 0 ? cus : 256;
    }
    if (grid < 0) return;
    if (hipMemsetAsync((char*)d_ws + WS_BAR, 0, 16384, stream) != hipSuccess) { fprintf(stderr, "kernel_launch: hipMemsetAsync failed\n"); return; }
    Args a{};
    for (int i = 0; i < 21; ++i) a.in[i] = (const float*)d_in[i];
    a.out = (float*)d_out; a.ws = (unsigned char*)d_ws;
    void* kargs[] = {&a};
    hipError_t e = hipLaunchCooperativeKernel((const void*)yoco_fwd, dim3(grid), dim3(NWAVES * 64), kargs, LDS_BYTES, stream);
    if (e != hipSuccess) fprintf(stderr, "kernel_launch: cooperative launch failed: %s (grid %d)\n", hipGetErrorString(e), grid);
}
```

```cpp
#include <hip/hip_runtime.h>
#include <hip/hip_cooperative_groups.h>
#include <cstdio>
#include <cstdint>
namespace cg = cooperative_groups;
namespace pg8 {
#define PG8_LAS __attribute__((address_space(3)))
typedef unsigned short bf16_t;
typedef short bf16x8 __attribute__((ext_vector_type(8)));
typedef float f32x4 __attribute__((ext_vector_type(4)));
typedef unsigned u32x4 __attribute__((ext_vector_type(4)));
constexpr int BM = 256, BK = 64, HALF = 128, HTB = HALF * BK * 2  , STAGE_BYTES = 8 * HTB, NXCD = 8, WGM = 8;

__host__ __device__ __forceinline__ int lds_byte(int r, int c) { const int st = (r >> 4) * 2 + (c >> 5), rr = r & 15, cc = c & 31, ob = rr * 64 + cc * 2; return st * 1024 + (ob ^ (((ob >> 9) & 1) << 5)); }
__host__ __device__ __forceinline__ void stage_rc(int b, int& R, int& C) { const int st = b / 1024, sb = b % 1024, swz = sb ^ (((sb >> 9) & 1) << 5); R = (st >> 1) * 16 + swz / 64; C = (st & 1) * 32 + (swz % 64) / 2; }
__host__ __device__ __forceinline__ int perm32(int rho) { const int n = rho >> 4, i = rho & 15; return 8 * (i >> 2) + 4 * n + (i & 3); }

struct Unit { int pm, pn; };
struct Gemm { const bf16_t* A; const bf16_t* Bt; int M, N, K; };

struct StaticOrder {
    int nM, nN, nwg, G, c;
    __host__ __device__ void init(int M, int N, int G_, int c_) { nM = M / BM; nN = N / BM; nwg = nM * nN; G = G_; c = c_; }
    __host__ __device__ bool next(int i, Unit& u) const {
        const long L = (long)i * G + c; if (L >= nwg) return false;
        int wgid = (int)L; { const int q = nwg / NXCD, r = nwg % NXCD, xcd = wgid % NXCD, off = wgid / NXCD; wgid = (xcd < r ? xcd * (q + 1) : r * (q + 1) + (xcd - r) * q) + off; }
        const int nig = WGM * nN, gid = wgid / nig, fm = gid * WGM, gsz = (nM - fm) < WGM ? (nM - fm) : WGM;
        u.pm = fm + ((wgid % nig) % gsz); u.pn = (wgid % nig) / gsz; return true;
    }
    __device__ __forceinline__ void a_ready(const Unit&) const {}
    __device__ __forceinline__ void done(const Unit&) const {}
};

__device__ __forceinline__ unsigned cvt_pk_bf16(float lo, float hi) { unsigned r; asm volatile("v_cvt_pk_bf16_f32 %0, %1, %2" : "=v"(r) : "v"(lo), "v"(hi)); return r; }
typedef float f32x2 __attribute__((ext_vector_type(2)));
__device__ __forceinline__ size_t hm_off(int row, int col) { return ((size_t)(((col >> 11) * 2 + (row >> 14)) * 16 + ((col >> 7) & 15)) << 21) + ((size_t)(row & 16383) << 7) + (size_t)(col & 127); }
template <int MODE, bool RS_IN, bool COPY, bool SUMSQ> struct EpiX {
    static constexpr bool PERM = true, AFTER_DRAIN = false;
    bf16_t* O; int ldc; const float* base; float* out; float* F; const float* rs_in; float* rs_out;
    __device__ __forceinline__ void operator()(const f32x4 (&acc)[2][2][4][2], const Unit& u, int wr, int wc, int fr, int fq) const {
        const int row0 = u.pm * BM + wr * 64 + fr, col0 = u.pn * BM + wc * 32 + 8 * fq;
        const bool ftile = (MODE == 3) && (u.pn * BM >= 6144);
#pragma unroll
        for (int ai = 0; ai < 2; ++ai)
#pragma unroll
            for (int m = 0; m < 4; ++m) { const size_t row = (size_t)(row0 + ai * HALF + m * 16);
                float rs = 1.f; if (RS_IN) rs = 1.f / sqrtf(rs_in[row] * (1.f / 2048.f) + 1e-6f);
                float ss = 0.f;
#pragma unroll
                for (int bj = 0; bj < 2; ++bj) { f32x4 v0 = acc[ai][bj][m][0], v1 = acc[ai][bj][m][1]; const int col = col0 + bj * HALF;
                    if (RS_IN) { v0 = v0 * rs; v1 = v1 * rs; }
                    if (MODE == 2) { const float* bp = base + row * ldc + col; float* op = out + row * ldc + col;
                        const f32x4 b0 = *(const f32x4*)bp, b1 = *(const f32x4*)(bp + 4); v0 = b0 + v0; v1 = b1 + v1; *(f32x4*)op = v0; *(f32x4*)(op + 4) = v1;
                        if (SUMSQ) ss += (v0[0] * v0[0] + v0[1] * v0[1]) + (v0[2] * v0[2] + v0[3] * v0[3]) + (v1[0] * v1[0] + v1[1] * v1[1]) + (v1[2] * v1[2] + v1[3] * v1[3]);
                        if (COPY) { u32x4 w; w.x = cvt_pk_bf16(v0[0], v0[1]); w.y = cvt_pk_bf16(v0[2], v0[3]); w.z = cvt_pk_bf16(v1[0], v1[1]); w.w = cvt_pk_bf16(v1[2], v1[3]); *(u32x4*)(O + row * ldc + col) = w; } }
                    else if (ftile) { if (bj == 0 && wc == 0 && fq < 2) { float* fp = F + row * 16 + 8 * fq; *(f32x4*)fp = v0; *(f32x4*)(fp + 4) = v1; } }
                    else { if (MODE == 1) {
#pragma unroll
                            for (int e = 0; e < 4; ++e) { const float a = fmaxf(v0[e], 0.f), b = fmaxf(v1[e], 0.f); v0[e] = a * a; v1[e] = b * b; } }
                        u32x4 w; w.x = cvt_pk_bf16(v0[0], v0[1]); w.y = cvt_pk_bf16(v0[2], v0[3]); w.z = cvt_pk_bf16(v1[0], v1[1]); w.w = cvt_pk_bf16(v1[2], v1[3]);
                        if (MODE == 0 || MODE == 3) *(u32x4*)(O + hm_off((int)row, col)) = w;
                        else *(u32x4*)(O + row * ldc + col) = w; } }
                if (SUMSQ) { ss += __shfl_xor(ss, 16); ss += __shfl_xor(ss, 32); if (fq == 0) atomicAdd(rs_out + row, ss); }
                if (MODE == 2) asm volatile("" ::: "memory"); }
    }
};
template <class Epi, class Sched, bool ALIGN_EPI = false, bool SP2 = false>
__device__ __forceinline__ void gemm_phase(PG8_LAS unsigned char* lds, const Gemm g, const Sched& S, const Epi& E) {
    int tid = threadIdx.x; asm volatile("" : "+v"(tid));
    const int wid = __builtin_amdgcn_readfirstlane(tid >> 6), lane = tid & 63, wr = wid >> 2, wc = wid & 3, fr = lane & 15, fq = lane >> 4;
    const int K = g.K, nt = K / BK;
    unsigned voffA[2], voffB[2];
#pragma unroll
    for (int i = 0; i < 2; ++i) { int R, C; stage_rc(tid * 16 + i * 8192, R, C); const int Rb = Epi::PERM ? ((R & ~31) + perm32(R & 31)) : R;
        voffA[i] = (unsigned)(R * K + C) * 2u; voffB[i] = (unsigned)(Rb * K + C) * 2u; }
    const size_t kstep = (size_t)(BK * 2);
    const size_t hstep = (size_t)HALF * K * 2;
    const size_t tstep = 2 * hstep;
    const unsigned ldsw = (unsigned)wid * 1024u;
    const int aoff = lds_byte(wr * 64 + fr, fq * 8), boff = lds_byte(wc * 32 + fr, fq * 8);
#define PG8_SA(b, h) (((b) * 2 + (h)) * HTB)
#define PG8_SB(b, h) ((4 + (b) * 2 + (h)) * HTB)
#define PG8_STAGE(bufoff, gbase, voff) do { _Pragma("unroll") for (int _i = 0; _i < 2; ++_i) \
        __builtin_amdgcn_global_load_lds((const unsigned*)((const char*)(gbase) + (voff)[_i]), (PG8_LAS unsigned*)(lds + (bufoff) + ldsw + _i * 8192), 16, 0, 0); } while (0)
#define PG8_LDA(dst, b, h) do { _Pragma("unroll") for (int m = 0; m < 4; ++m) _Pragma("unroll") for (int k = 0; k < 2; ++k) dst[m][k] = *(const PG8_LAS bf16x8*)(lds + PG8_SA(b, h) + aoff + m * 2048 + k * 1024); } while (0)
#define PG8_LDB(dst, b, h) do { _Pragma("unroll") for (int n = 0; n < 2; ++n) _Pragma("unroll") for (int k = 0; k < 2; ++k) dst[n][k] = *(const PG8_LAS bf16x8*)(lds + PG8_SB(b, h) + boff + n * 2048 + k * 1024); } while (0)
#define PG8_MMA(ai, bj, At, Bt) do { __builtin_amdgcn_s_setprio(1); _Pragma("unroll") for (int m = 0; m < 4; ++m) _Pragma("unroll") for (int n = 0; n < 2; ++n) _Pragma("unroll") for (int k = 0; k < 2; ++k) \
        acc[ai][bj][m][n] = __builtin_amdgcn_mfma_f32_16x16x32_bf16(Bt[n][k], At[m][k], acc[ai][bj][m][n], 0, 0, 0); __builtin_amdgcn_s_setprio(0); } while (0)
#define PG8_WAIT_V(n) asm volatile("s_waitcnt vmcnt(" #n ")" ::: "memory")
#define PG8_WAIT_L(n) asm volatile("s_waitcnt lgkmcnt(" #n ")" ::: "memory")
#define PG8_BAR __builtin_amdgcn_s_barrier()
#define PG8_SCHED __builtin_amdgcn_sched_barrier(0)
    Unit cur, nxt; int ui = 0;
    if (!S.next(0, cur)) return;
    f32x4 acc[2][2][4][2];
#pragma unroll
    for (int a = 0; a < 2; ++a)
#pragma unroll
        for (int b = 0; b < 2; ++b)
#pragma unroll
            for (int m = 0; m < 4; ++m)
#pragma unroll
                for (int n = 0; n < 2; ++n) acc[a][b][m][n] = (f32x4){0.f, 0.f, 0.f, 0.f};
    bf16x8 At[4][2], B0[2][2], B1[2][2];
    const char* cA = (const char*)g.A + (size_t)cur.pm * tstep; const char* cB = (const char*)g.Bt + (size_t)cur.pn * tstep;
    S.a_ready(cur);
    if constexpr (SP2) {
        PG8_STAGE(PG8_SB(0, 0), cB, voffB); PG8_STAGE(PG8_SB(0, 1), cB + hstep, voffB); PG8_STAGE(PG8_SA(0, 0), cA, voffA); PG8_STAGE(PG8_SA(0, 1), cA + hstep, voffA);
        if (wr == 1) PG8_BAR;
        PG8_WAIT_V(2); PG8_BAR;
        PG8_STAGE(PG8_SB(1, 0), cB + kstep, voffB); PG8_STAGE(PG8_SA(1, 0), cA + kstep, voffA); PG8_STAGE(PG8_SB(1, 1), cB + hstep + kstep, voffB);
        PG8_WAIT_V(6); PG8_BAR;
    } else {
        PG8_STAGE(PG8_SB(0, 0), cB, voffB); PG8_STAGE(PG8_SA(0, 0), cA, voffA); PG8_STAGE(PG8_SB(0, 1), cB + hstep, voffB); PG8_STAGE(PG8_SA(0, 1), cA + hstep, voffA);
        if (wr == 1) PG8_BAR;
        PG8_WAIT_V(4); PG8_BAR;
        PG8_STAGE(PG8_SB(1, 0), cB + kstep, voffB); PG8_STAGE(PG8_SA(1, 0), cA + kstep, voffA); PG8_STAGE(PG8_SB(1, 1), cB + hstep + kstep, voffB);
        PG8_WAIT_V(6); PG8_BAR;
    }
    for (;;) {
        const bool has_next = S.next(ui + 1, nxt);
        const char* nA = has_next ? (const char*)g.A + (size_t)nxt.pm * tstep : cA; const char* nB = has_next ? (const char*)g.Bt + (size_t)nxt.pn * tstep : cB;
        for (int t = 0; t < nt; t += 2) {
            const bool last = (t == nt - 2);
            const char* a1 = cA + (size_t)(t + 1) * kstep;
            const char* a2 = last ? nA : cA + (size_t)(t + 2) * kstep; const char* b2 = last ? nB : cB + (size_t)(t + 2) * kstep;
            const char* a3 = a2 + kstep; const char* b3 = b2 + kstep;
            if (last && has_next) S.a_ready(nxt);
            if constexpr (SP2) {
            PG8_LDB(B0, 0, 0); PG8_LDB(B1, 0, 1); PG8_SCHED; PG8_LDA(At, 0, 0); PG8_STAGE(PG8_SA(1, 1), a1 + hstep, voffA);
            PG8_WAIT_V(8); PG8_WAIT_L(0); PG8_BAR; PG8_MMA(0, 0, At, B0); PG8_MMA(0, 1, At, B1); PG8_BAR; PG8_SCHED;
            PG8_LDA(At, 0, 1); PG8_STAGE(PG8_SB(0, 0), b2, voffB); PG8_STAGE(PG8_SB(0, 1), b2 + hstep, voffB); PG8_STAGE(PG8_SA(0, 0), a2, voffA);
            PG8_WAIT_V(8); PG8_WAIT_L(0); PG8_BAR; PG8_MMA(1, 0, At, B0); PG8_MMA(1, 1, At, B1); PG8_BAR; PG8_SCHED;
            PG8_LDB(B0, 1, 0); PG8_LDB(B1, 1, 1); PG8_SCHED; PG8_LDA(At, 1, 0); PG8_STAGE(PG8_SA(0, 1), a2 + hstep, voffA);
            PG8_WAIT_V(8); PG8_WAIT_L(0); PG8_BAR; PG8_MMA(0, 0, At, B0); PG8_MMA(0, 1, At, B1); PG8_BAR; PG8_SCHED;
            PG8_LDA(At, 1, 1); PG8_STAGE(PG8_SB(1, 0), b3, voffB); PG8_STAGE(PG8_SB(1, 1), b3 + hstep, voffB); PG8_STAGE(PG8_SA(1, 0), a3, voffA);
            PG8_WAIT_V(8); PG8_WAIT_L(0); PG8_BAR; PG8_MMA(1, 0, At, B0); PG8_MMA(1, 1, At, B1); PG8_BAR; PG8_SCHED;
            } else {
            PG8_LDB(B0, 0, 0); PG8_SCHED; PG8_LDA(At, 0, 0); PG8_STAGE(PG8_SA(1, 1), a1 + hstep, voffA);
            PG8_WAIT_L(8); PG8_BAR; PG8_WAIT_L(0); PG8_MMA(0, 0, At, B0); PG8_BAR; PG8_SCHED;
            PG8_LDB(B1, 0, 1); PG8_STAGE(PG8_SB(0, 0), b2, voffB);
            PG8_BAR; PG8_WAIT_L(0); PG8_MMA(0, 1, At, B1); PG8_BAR;
            PG8_LDA(At, 0, 1); PG8_STAGE(PG8_SA(0, 0), a2, voffA);
            PG8_BAR; PG8_WAIT_L(0); PG8_MMA(1, 0, At, B0); PG8_BAR; PG8_SCHED;
            PG8_STAGE(PG8_SB(0, 1), b2 + hstep, voffB);
            PG8_WAIT_V(6); PG8_BAR; PG8_MMA(1, 1, At, B1); PG8_BAR;
            PG8_LDB(B0, 1, 0); PG8_SCHED; PG8_LDA(At, 1, 0); PG8_STAGE(PG8_SA(0, 1), a2 + hstep, voffA);
            PG8_WAIT_L(8); PG8_BAR; PG8_WAIT_L(0); PG8_MMA(0, 0, At, B0); PG8_BAR; PG8_SCHED;
            PG8_LDB(B1, 1, 1); PG8_STAGE(PG8_SB(1, 0), b3, voffB);
            PG8_BAR; PG8_WAIT_L(0); PG8_MMA(0, 1, At, B1); PG8_BAR;
            PG8_LDA(At, 1, 1); PG8_STAGE(PG8_SA(1, 0), a3, voffA);
            PG8_BAR; PG8_WAIT_L(0); PG8_MMA(1, 0, At, B0); PG8_BAR; PG8_SCHED;
            PG8_STAGE(PG8_SB(1, 1), b3 + hstep, voffB);
            PG8_WAIT_V(6); PG8_BAR; PG8_MMA(1, 1, At, B1); PG8_BAR;
            }
        }
        if constexpr (ALIGN_EPI) { if (wr == 0) PG8_BAR; }
        if constexpr (!Epi::AFTER_DRAIN) { E(acc, cur, wr, wc, fr, fq); S.done(cur); }
        if (!has_next) break;
#pragma unroll
        for (int a = 0; a < 2; ++a)
#pragma unroll
            for (int b = 0; b < 2; ++b)
#pragma unroll
                for (int m = 0; m < 4; ++m)
#pragma unroll
                    for (int n = 0; n < 2; ++n) acc[a][b][m][n] = (f32x4){0.f, 0.f, 0.f, 0.f};
        cur = nxt; cA = nA; cB = nB; ++ui;
        if constexpr (ALIGN_EPI) { if (wr == 1) PG8_BAR; }
    }
    PG8_WAIT_V(0);
    if constexpr (!ALIGN_EPI) { if (wr == 0) PG8_BAR; }
    PG8_BAR;
    if constexpr (Epi::AFTER_DRAIN) { E.fused(acc, cur, wr, wc, fr, fq, lds, wid, lane); S.done(cur); }
#undef PG8_SA
#undef PG8_SB
#undef PG8_STAGE
#undef PG8_LDA
#undef PG8_LDB
#undef PG8_MMA
#undef PG8_WAIT_V
#undef PG8_WAIT_L
#undef PG8_BAR
#undef PG8_SCHED
}
}
#ifndef PG8_SP2
#define PG8_SP2 true
#endif
#ifndef PG8_ALIGN
#define PG8_ALIGN true
#endif
namespace att {
typedef unsigned short bf16;
typedef short bf16x8 __attribute__((ext_vector_type(8)));
typedef short s16x4 __attribute__((ext_vector_type(4)));
typedef float f32x16 __attribute__((ext_vector_type(16)));
typedef float f32x4 __attribute__((ext_vector_type(4)));
typedef unsigned u32x4 __attribute__((ext_vector_type(4)));
constexpr int D = 128, NW = 8, QBLK = 32, KVBLK = 64, QB = NW * QBLK, LDQ = 128, LDO = 2048;
constexpr float SCALE = 0.08838834764831845f, THR = 8.f;
constexpr int SHM_V = KVBLK * D * 2, SHM_K = KVBLK * D * 2, NSLOT = 3;
constexpr int OFF_V = 0, OFF_K = NSLOT * SHM_V, OFF_WS = OFF_K + NSLOT * SHM_K, OFF_CL = OFF_WS + NW * 64 * 4, OFF_TB = OFF_CL + NSLOT * 256, LDS_BYTES = OFF_TB + 8192;
#define KSWZ(row, colB) ((row) * 256 + ((colB) ^ (((row) & 7) << 4)))
#define SBAR() __builtin_amdgcn_sched_barrier(0)
__device__ __forceinline__ int v_st(int k, int c) { const int kk = (k & ~0xC) | ((k & 4) << 1) | ((k & 8) >> 1); return ((kk >> 3) * 4 + (c >> 5)) * 512 + ((kk & 7) * 32 + (c & 31)) * 2; }
__device__ __forceinline__ int v_rd_base(int lane) { return ((lane & 3) << 3) | (((lane >> 2) & 3) << 6) | (((lane >> 4) & 1) << 5) | (((lane >> 5) & 1) << 8); }
constexpr int v_rd_off(int d0, int ks, int half) { return d0 * 512 + ks * 4096 + half * 2048; }
__device__ __forceinline__ int crow(int r, int hi) { return (r & 3) + 8 * (r >> 2) + 4 * hi; }
__device__ __forceinline__ unsigned cvtpk(float lo, float hi) { unsigned r; asm volatile("v_cvt_pk_bf16_f32 %0, %1, %2" : "=v"(r) : "v"(lo), "v"(hi)); return r; }
__device__ __forceinline__ void mask_tile(f32x16& p0, f32x16& p1, int dq, unsigned W) {
    const float NEG = -__builtin_inff();
#pragma unroll
    for (int r = 0; r < 16; ++r) { const int c = (r & 3) + 8 * (r >> 2);
        if ((unsigned)(dq - c) >= W) p0[r] = NEG;
        if ((unsigned)(dq - c - 32) >= W) p1[r] = NEG; }
}
__device__ __forceinline__ void add_bias(f32x16& p0, f32x16& p1, const float* tb, int relbase) {
    const float* t = tb + relbase;
#pragma unroll
    for (int r = 0; r < 16; ++r) { const int c = (r & 3) + 8 * (r >> 2); p0[r] += t[c]; p1[r] += t[c + 32]; }
}
__device__ __forceinline__ void partialSM(f32x16& p0, f32x16& p1, float& m_reg, float& mn, float& alpha) {
    float pmax = p0[0]; for (int r = 1; r < 16; ++r) pmax = fmaxf(pmax, p0[r]); for (int r = 0; r < 16; ++r) pmax = fmaxf(pmax, p1[r]);
    { auto rr = __builtin_amdgcn_permlane32_swap(__float_as_uint(pmax), __float_as_uint(pmax), false, false);
      pmax = fmaxf(__uint_as_float(rr[0]), __uint_as_float(rr[1])); }
    constexpr float C2 = 1.4426950408889634f * SCALE;
    if (__builtin_expect(__all((pmax - m_reg) * SCALE <= THR), 1)) { mn = m_reg; alpha = 1.f; }
    else { mn = fmaxf(m_reg, pmax); alpha = __builtin_amdgcn_exp2f((m_reg - mn) * C2); m_reg = mn; }
    const float mnL = -mn * C2;
    for (int r = 0; r < 16; ++r) p0[r] = fmaf(p0[r], C2, mnL); for (int r = 0; r < 16; ++r) p1[r] = fmaf(p1[r], C2, mnL);
    for (int r = 0; r < 16; ++r) p0[r] = __builtin_amdgcn_exp2f(p0[r]);
}
__device__ __forceinline__ void finishSM(f32x16& p0, f32x16& p1, float alpha, float& l_reg, bf16x8& pa0, bf16x8& pa1, bf16x8& pa2, bf16x8& pa3) {
    for (int r = 0; r < 16; ++r) p1[r] = __builtin_amdgcn_exp2f(p1[r]);
    float ps = 0; for (int r = 0; r < 16; ++r) ps += p0[r]; for (int r = 0; r < 16; ++r) ps += p1[r];
    { auto rr = __builtin_amdgcn_permlane32_swap(__float_as_uint(ps), __float_as_uint(ps), false, false);
      ps = __uint_as_float(rr[0]) + __uint_as_float(rr[1]); }
    l_reg = l_reg * alpha + ps;
#define PK4(P, B_, OUT) do { unsigned a0 = cvtpk(P[B_+0], P[B_+1]), a1 = cvtpk(P[B_+2], P[B_+3]);                          \
        unsigned b0 = cvtpk(P[B_+4], P[B_+5]), b1 = cvtpk(P[B_+6], P[B_+7]);                                             \
        auto r0 = __builtin_amdgcn_permlane32_swap(a0, b0, false, false); auto r1 = __builtin_amdgcn_permlane32_swap(a1, b1, false, false); \
        u32x4 w = {r0[0], r1[0], r0[1], r1[1]}; OUT = *reinterpret_cast<bf16x8*>(&w); } while (0)
    PK4(p0, 0, pa0); PK4(p0, 8, pa1); PK4(p1, 0, pa2); PK4(p1, 8, pa3);
#undef PK4
}
template <bool SK, int MODE>
__device__ __forceinline__ void qkt(f32x16& p0, f32x16& p1, const char* lds, int kslot  , int cslot  , int r32, int hi, const bf16x8* qr, bool act) {
    if (SK && !act) { const float NEG = -__builtin_inff();
#pragma unroll
        for (int r = 0; r < 16; ++r) { p0[r] = NEG; p1[r] = NEG; } return; }
    if (MODE == 1) { const float* cl = (const float*)(lds + OFF_CL) + cslot + 4 * hi;
#pragma unroll
        for (int g = 0; g < 4; ++g) { const f32x4 a = *(const f32x4*)(cl + 8 * g), b = *(const f32x4*)(cl + 32 + 8 * g);
            p0[4 * g] = a[0]; p0[4 * g + 1] = a[1]; p0[4 * g + 2] = a[2]; p0[4 * g + 3] = a[3];
            p1[4 * g] = b[0]; p1[4 * g + 1] = b[1]; p1[4 * g + 2] = b[2]; p1[4 * g + 3] = b[3]; } }
    else { p0 = f32x16{}; p1 = f32x16{}; }
    const char* K_lds = lds + OFF_K + kslot;
    const char* kb[4];
#pragma unroll
    for (int dd = 0; dd < 4; ++dd) kb[dd] = K_lds + KSWZ(r32, (dd * 16 + hi * 8) * 2);
#pragma unroll
    for (int d0 = 0; d0 < 8; ++d0) { const char* a = kb[d0 & 3] + (d0 >> 2) * 128;
        bf16x8 b0 = *reinterpret_cast<const bf16x8*>(a);
        bf16x8 b1 = *reinterpret_cast<const bf16x8*>(a + 32 * 256);
        p0 = __builtin_amdgcn_mfma_f32_32x32x16_bf16(b0, qr[d0], p0, 0, 0, 0);
        p1 = __builtin_amdgcn_mfma_f32_32x32x16_bf16(b1, qr[d0], p1, 0, 0, 0); }
}
template <bool SK>
__device__ __forceinline__ void pv_tile(f32x16* o, int vb0  , bf16x8 pa0, bf16x8 pa1, bf16x8 pa2, bf16x8 pa3, bool act) {
    if (SK && !act) return;
#define TRRD(dst, off) asm volatile("ds_read_b64_tr_b16 %0, %1 offset:%2" : "=&v"(dst) : "v"(vb0), "i"(off) : "memory")
#define RD_D0(d0, L0, H0, L1, H1, L2, H2, L3, H3) do { constexpr int b_ = v_rd_off(d0, 0, 0); \
        TRRD(L0, b_); TRRD(H0, b_ + 2048); TRRD(L1, b_ + 4096); TRRD(H1, b_ + 6144); TRRD(L2, b_ + 8192); TRRD(H2, b_ + 10240); TRRD(L3, b_ + 12288); TRRD(H3, b_ + 14336); } while (0)
#define MM_D0(d0, L0, H0, L1, H1, L2, H2, L3, H3) do { \
        o[d0] = __builtin_amdgcn_mfma_f32_32x32x16_bf16(pa0, (bf16x8){L0[0], L0[1], L0[2], L0[3], H0[0], H0[1], H0[2], H0[3]}, o[d0], 0, 0, 0);   \
        o[d0] = __builtin_amdgcn_mfma_f32_32x32x16_bf16(pa1, (bf16x8){L1[0], L1[1], L1[2], L1[3], H1[0], H1[1], H1[2], H1[3]}, o[d0], 0, 0, 0);   \
        o[d0] = __builtin_amdgcn_mfma_f32_32x32x16_bf16(pa2, (bf16x8){L2[0], L2[1], L2[2], L2[3], H2[0], H2[1], H2[2], H2[3]}, o[d0], 0, 0, 0);   \
        o[d0] = __builtin_amdgcn_mfma_f32_32x32x16_bf16(pa3, (bf16x8){L3[0], L3[1], L3[2], L3[3], H3[0], H3[1], H3[2], H3[3]}, o[d0], 0, 0, 0); } while (0)
    s16x4 al0, ah0, al1, ah1, al2, ah2, al3, ah3, bl0, bh0, bl1, bh1, bl2, bh2, bl3, bh3;
    SBAR();
    RD_D0(0, al0, ah0, al1, ah1, al2, ah2, al3, ah3);
    RD_D0(1, bl0, bh0, bl1, bh1, bl2, bh2, bl3, bh3);
    asm volatile("s_waitcnt lgkmcnt(8)" ::: "memory"); SBAR();
    MM_D0(0, al0, ah0, al1, ah1, al2, ah2, al3, ah3); SBAR();
    RD_D0(2, al0, ah0, al1, ah1, al2, ah2, al3, ah3);
    asm volatile("s_waitcnt lgkmcnt(8)" ::: "memory"); SBAR();
    MM_D0(1, bl0, bh0, bl1, bh1, bl2, bh2, bl3, bh3); SBAR();
    RD_D0(3, bl0, bh0, bl1, bh1, bl2, bh2, bl3, bh3);
    asm volatile("s_waitcnt lgkmcnt(8)" ::: "memory"); SBAR();
    MM_D0(2, al0, ah0, al1, ah1, al2, ah2, al3, ah3); SBAR();
    asm volatile("s_waitcnt lgkmcnt(0)" ::: "memory"); SBAR();
    MM_D0(3, bl0, bh0, bl1, bh1, bl2, bh2, bl3, bh3);
#undef MM_D0
#undef RD_D0
#undef TRRD
}
struct BlockRef { const bf16* Q; const bf16* K; const bf16* V; bf16* O; const float* CB; int P0, jlo, h; };
__device__ __forceinline__ void glds16(const void* sbase, unsigned voff, unsigned lds_dst) { unsigned keep;
    asm volatile("s_mov_b32 %0, m0\n\ts_mov_b32 m0, %3\n\ts_nop 0\n\tglobal_load_lds_dwordx4 %1, %2\n\ts_mov_b32 m0, %0" : "=&s"(keep) : "v"(voff), "s"(sbase), "s"(lds_dst) : "memory"); }
__device__ __forceinline__ void glds4(const void* sbase, unsigned voff, unsigned lds_dst) { unsigned keep;
    asm volatile("s_mov_b32 %0, m0\n\ts_mov_b32 m0, %3\n\ts_nop 0\n\tglobal_load_lds_dword %1, %2\n\ts_mov_b32 m0, %0" : "=&s"(keep) : "v"(voff), "s"(sbase), "s"(lds_dst) : "memory"); }
#define WAIT_BAR(N) asm volatile("s_waitcnt vmcnt(" #N ") lgkmcnt(0)\n\ts_barrier" ::: "memory")
#define LD8(p) (*reinterpret_cast<const bf16x8*>(p))
template <int MODE>
__device__ __forceinline__ void attn_block(const BlockRef& cur, char* lds) {
    constexpr bool SK = (MODE == 0);
    constexpr int NDMA = (MODE == 1) ? 5 : 4;
    int tid = threadIdx.x; asm volatile("" : "+v"(tid));
    const int wid = __builtin_amdgcn_readfirstlane(tid >> 6), lane = tid & 63, r32 = lane & 31, hi = lane >> 5;
    const int j_lo = cur.jlo, NT = cur.P0 / KVBLK + QB / KVBLK - j_lo;
    const int qlo = cur.P0 + wid * QBLK, qm = qlo + r32 - 4 * hi;
    float* ws = (float*)(lds + OFF_WS) + wid * 64; float* li_l = ws, * al_l = ws + 32;
    const float* tbh = (const float*)(lds + OFF_TB) + cur.h * 256;
    float m_reg = -1e30f, l_reg = 0; f32x16 o[4] = {};
    const unsigned lds0 = (unsigned)(uintptr_t)lds;
    const int vb0 = (int)lds0 + OFF_V + v_rd_base(lane);
    unsigned koff0, koff1, voff0, voff1;
    { const int pc = wid * 2; int row = pc * 4 + (lane >> 4), c = (lane & 15) ^ (row & 7); koff0 = (unsigned)((row * LDQ + c * 8) * 2);
      row += 4; c = (lane & 15) ^ (row & 7); koff1 = (unsigned)((row * LDQ + c * 8) * 2);
      int st = 2 * pc + (lane >> 5), kk = ((st >> 2) << 3) | ((lane & 31) >> 2), k = (kk & ~0xC) | ((kk & 4) << 1) | ((kk & 8) >> 1); voff0 = (unsigned)((k * LDQ + (st & 3) * 32 + (lane & 3) * 8) * 2);
      st += 2; kk = ((st >> 2) << 3) | ((lane & 31) >> 2); k = (kk & ~0xC) | ((kk & 4) << 1) | ((kk & 8) >> 1); voff1 = (unsigned)((k * LDQ + (st & 3) * 32 + (lane & 3) * 8) * 2); }
    const unsigned kdst = lds0 + OFF_K + wid * 2048, vdst = lds0 + OFF_V + wid * 2048, cdst = lds0 + OFF_CL, lane4 = (unsigned)lane * 4u;
#define TIDX(t) (MODE == 1 ? (j_lo + NT - 1 - (t)) : (j_lo + (t)))
#define TILEB(t) ((size_t)TIDX(t) * (KVBLK * LDQ * 2))
#define DMA_K(t, slot) do { const char* g_ = (const char*)cur.K + TILEB(t); glds16(g_, koff0, kdst + (slot)); glds16(g_, koff1, kdst + (slot) + 1024); \
                            if (MODE == 1) glds4(cur.CB + (size_t)TIDX(t) * KVBLK, lane4, cdst + ((slot) >> 6)); } while (0)
#define DMA_V(t, slot) do { const char* g_ = (const char*)cur.V + TILEB(t); glds16(g_, voff0, vdst + (slot)); glds16(g_, voff1, vdst + (slot) + 1024); } while (0)
#define RESC(a) do { if (__any((a) < 1.f)) { if (hi == 0) al_l[r32] = (a); asm volatile("s_waitcnt lgkmcnt(0)" ::: "memory");              \
                     for (int d_ = 0; d_ < 4; ++d_) for (int r = 0; r < 16; ++r) o[d_][r] *= al_l[crow(r, hi)]; } } while (0)
#define KBASE(t) (TIDX(t) * KVBLK)
#define ACT(t) (MODE == 0 ? (KBASE(t) <= qlo) : true)
#define MASKT(P0_, P1_, t) do { const int kb_ = KBASE(t);                                                                              \
        if (MODE == 1) { if (kb_ + KVBLK - 1 > qlo) mask_tile(P0_, P1_, qm - kb_, 0x40000000u); }                                       \
        else { if (kb_ <= qlo && kb_ + KVBLK - 1 - qlo >= -90) add_bias(P0_, P1_, tbh, kb_ - qm + 192); } } while (0)
    DMA_K(0, 0); DMA_V(0, 0); DMA_K(1, SHM_K);
    bf16x8 qr[8];
    { const unsigned qo = (unsigned)(((wid * QBLK + r32) * LDQ + hi * 8) * 2);
#pragma unroll
      for (int d0 = 0; d0 < 8; ++d0) qr[d0] = LD8((const char*)cur.Q + qo + d0 * 32); }
    WAIT_BAR(0);
    int sl_prev = 2 * SHM_K, sl_cur = 0, sl_nxt = SHM_K;
#define ROT() do { const int t_ = sl_prev; sl_prev = sl_cur; sl_cur = sl_nxt; sl_nxt = t_; } while (0)
    f32x16 pA0, pA1, pB0, pB1; float mnA, mnB, alA, alB; bf16x8 pa0, pa1, pa2, pa3;
    DMA_K(2, sl_prev); DMA_V(1, sl_nxt);
    SBAR(); qkt<SK, MODE>(pA0, pA1, lds, sl_cur, sl_cur >> 8, r32, hi, qr, ACT(0));
    MASKT(pA0, pA1, 0); partialSM(pA0, pA1, m_reg, mnA, alA);
    if (2 < NT) { if (MODE == 1) WAIT_BAR(5); else WAIT_BAR(4); } else WAIT_BAR(0);
    ROT();
#define STEP(PL, PX0, PX1, mnX, alX, PY0, PY1, alY, s) do {                                                                    \
        if ((PL) || (s) + 2 < NT) DMA_K((s) + 2, sl_prev);                                                                     \
        if ((PL) || (s) + 1 < NT) DMA_V((s) + 1, sl_nxt);                                                                      \
        SBAR(); qkt<(SK && !(PL)), MODE>(PX0, PX1, lds, sl_cur, sl_cur >> 8, r32, hi, qr, ACT(s));                             \
        finishSM(PY0, PY1, alY, l_reg, pa0, pa1, pa2, pa3); SBAR();                                                            \
        pv_tile<(SK && !(PL))>(o, vb0 + sl_prev, pa0, pa1, pa2, pa3, ACT((s) - 1)); if (!(PL) || MODE == 1) MASKT(PX0, PX1, (s)); partialSM(PX0, PX1, m_reg, mnX, alX); \
        RESC(alX);                                                                                                             \
        if ((PL) || (s) + 2 < NT) { if (MODE == 1) WAIT_BAR(5); else WAIT_BAR(4); } else WAIT_BAR(0);                          \
        ROT(); } while (0)
    int s = 1;
    { const int NH = NT - (MODE == 0 ? 6 : 0) - 2;
      for (; s + 1 < NH; s += 2) {
        STEP(true, pB0, pB1, mnB, alB, pA0, pA1, alA, s);
        STEP(true, pA0, pA1, mnA, alA, pB0, pB1, alB, s + 1);
      } }
    for (; s + 1 < NT; s += 2) {
        STEP(false, pB0, pB1, mnB, alB, pA0, pA1, alA, s);
        STEP(false, pA0, pA1, mnA, alA, pB0, pB1, alB, s + 1);
    }
    if (s < NT) {
        STEP(false, pB0, pB1, mnB, alB, pA0, pA1, alA, s);
        finishSM(pB0, pB1, alB, l_reg, pa0, pa1, pa2, pa3); SBAR(); pv_tile<SK>(o, vb0 + sl_prev, pa0, pa1, pa2, pa3, ACT(NT - 1));
    } else {
        finishSM(pA0, pA1, alA, l_reg, pa0, pa1, pa2, pa3); SBAR(); pv_tile<SK>(o, vb0 + sl_prev, pa0, pa1, pa2, pa3, ACT(NT - 1));
    }
    if (hi == 0) li_l[r32] = l_reg; asm volatile("s_waitcnt lgkmcnt(0)" ::: "memory");
    float rli[16];
#pragma unroll
    for (int r = 0; r < 16; ++r) rli[r] = __builtin_amdgcn_rcpf(li_l[crow(r, hi)]);
    char* Ow = (char*)cur.O; const unsigned oo = (unsigned)(((wid * QBLK + 4 * hi) * LDO + r32) * 2);
#pragma unroll
    for (int r = 0; r < 16; ++r) { const unsigned orow = (unsigned)(((r & 3) + 8 * (r >> 2)) * LDO * 2);
#pragma unroll
        for (int d0 = 0; d0 < 4; ++d0) { const float v = o[d0][r] * rli[r];
            const float vn = __shfl_xor(v, 1);
            if ((r32 & 1) == 0) *(unsigned*)(Ow + (oo + orow + d0 * 64)) = cvtpk(v, vn); } }
    asm volatile("s_waitcnt lgkmcnt(0)\n\ts_barrier" ::: "memory");
#undef TILEB
#undef TIDX
#undef DMA_K
#undef DMA_V
#undef RESC
#undef KBASE
#undef ACT
#undef MASKT
#undef ROT
#undef STEP
}
#undef WAIT_BAR
#undef LD8
#undef SBAR
#undef KSWZ
}
#define GAS __attribute__((address_space(1)))
#define LAS __attribute__((address_space(3)))
typedef unsigned short bf16;
typedef unsigned v4u __attribute__((ext_vector_type(4)));
typedef unsigned v2u __attribute__((ext_vector_type(2)));
typedef float f32x4 __attribute__((ext_vector_type(4)));
constexpr int NWAVES = 8;
constexpr int BATCH = 2, SEQ = 16384, DM = 2048, TOK = BATCH * SEQ, FF = 8192, NQKV = 6144, NQKV1 = 6400, FH = 16;
constexpr float NORM_EPS = 1e-6f, SUBLN_EPS = 1e-5f, LAMBDA_INIT = 0.2f;
constexpr size_t MiB = 1u << 20;
constexpr size_t WS_F = 0, WS_CB = 2 * MiB;
constexpr size_t WS_WQKV0 = 4 * MiB, WS_WOA = 28 * MiB, WS_WMI0 = 36 * MiB, WS_WMO0 = 68 * MiB, WS_WQKV1 = 100 * MiB, WS_WOB = 126 * MiB, WS_WMI1 = 134 * MiB, WS_WMO1 = 166 * MiB;
constexpr size_t WS_NRM = 198 * MiB;
constexpr size_t WS_RS = 198 * MiB + 65536;
constexpr size_t WS_BAR = 199 * MiB;
constexpr size_t WS_HB = 712 * MiB;
constexpr size_t WS_QKV = 200 * MiB;
constexpr size_t WS_OC = 584 * MiB;
constexpr size_t WS_HID = 200 * MiB;
constexpr size_t WS_XN = 840 * MiB;
constexpr size_t WS_END = 968 * MiB;
constexpr int LDS_BYTES = 147456;

__device__ __forceinline__ GAS unsigned char* launder_g(GAS unsigned char* p) { asm volatile("" : "+s"(p)); return p; }
__device__ __forceinline__ unsigned f2bf(float f) { unsigned u = __builtin_bit_cast(unsigned, f); return (u + 0x7fffu + ((u >> 16) & 1u)) >> 16; }
__device__ __forceinline__ unsigned pk2(float lo, float hi) { return f2bf(lo) | (f2bf(hi) << 16); }
__device__ __forceinline__ float bf2f(unsigned short b) { return __builtin_bit_cast(float, (unsigned)b << 16); }
__device__ __forceinline__ float wave_sum(float v) {
#pragma unroll
    for (int o = 1; o < 64; o <<= 1) v += __shfl_xor(v, o);
    return v;
}
__device__ __forceinline__ void transpose_item(const float* W, int K, int N, bf16* WT, int row_off, const float* g, LAS float* scr, int item, int lane) {
    const int nblk = N / 64, kb = item / nblk, nb = item % nblk, k0 = 64 * kb, n0 = 64 * nb, kr = lane >> 4, nq = lane & 15;
    f32x4 v[16];
#pragma unroll
    for (int i = 0; i < 16; ++i) v[i] = *(const f32x4*)(W + (size_t)(k0 + 4 * i + kr) * N + n0 + 4 * nq);
#pragma unroll
    for (int i = 0; i < 16; ++i) { const int kk = 4 * i + kr; f32x4 t = v[i]; if (g) t = t * g[k0 + kk];
        scr[(4 * nq + 0) * 65 + kk] = t[0]; scr[(4 * nq + 1) * 65 + kk] = t[1]; scr[(4 * nq + 2) * 65 + kk] = t[2]; scr[(4 * nq + 3) * 65 + kk] = t[3]; }
    asm volatile("s_waitcnt lgkmcnt(0)" ::: "memory");
    const int c = lane & 7;
#pragma unroll
    for (int j = 0; j < 8; ++j) { const int n = (lane >> 3) + 8 * j; const LAS float* sp = scr + n * 65 + 8 * c;
        v4u o; o.x = pk2(sp[0], sp[1]); o.y = pk2(sp[2], sp[3]); o.z = pk2(sp[4], sp[5]); o.w = pk2(sp[6], sp[7]);
        *(v4u*)(WT + (size_t)(row_off + n0 + n) * K + k0 + 8 * c) = o; }
    asm volatile("s_waitcnt lgkmcnt(0)" ::: "memory");
}
__device__ __forceinline__ void norm_row_to_bf16(const float* xrow, bf16* orow, int lane) {
    const f32x4* xr = (const f32x4*)xrow + lane;
    f32x4 v[8]; float s = 0.f;
#pragma unroll
    for (int j = 0; j < 8; ++j) { v[j] = xr[64 * j]; s += (v[j].x * v[j].x + v[j].y * v[j].y) + (v[j].z * v[j].z + v[j].w * v[j].w); }
    const float rstd = 1.f / sqrtf(wave_sum(s) * (1.f / DM) + NORM_EPS);
    v2u* o8 = (v2u*)orow + lane;
#pragma unroll
    for (int j = 0; j < 8; ++j) { v2u w; w.x = pk2(v[j].x * rstd, v[j].y * rstd); w.y = pk2(v[j].z * rstd, v[j].w * rstd); o8[64 * j] = w; }
}
__device__ __forceinline__ void norm_phase(const float* src, bf16* dst, int gw, int NGW, int lane) {
    for (int m = gw; m < TOK; m += NGW) norm_row_to_bf16(src + (size_t)m * DM, dst + (size_t)m * DM, lane);
}
__device__ __forceinline__ void final_norm_phase(float* io, const float* g, const float* rs, int gw, int NGW, int lane) {
    for (int m = gw; m < TOK; m += NGW) {
        f32x4* xr = (f32x4*)(io + (size_t)m * DM) + lane; const f32x4* gr = (const f32x4*)g + lane;
        const float rstd = 1.f / sqrtf(rs[m] * (1.f / DM) + NORM_EPS);
#pragma unroll
        for (int j = 0; j < 8; ++j) xr[64 * j] = xr[64 * j] * rstd * gr[64 * j];
    }
}
__device__ __forceinline__ void combine_phase(const bf16* OC, bf16* O, const float* lq1, const float* lk1, const float* lq2, const float* lk2, const float* sg, int gw, int NGW, int lane) {
    const float s1 = wave_sum(lq1[lane] * lk1[lane] + lq1[lane + 64] * lk1[lane + 64]), s2 = wave_sum(lq2[lane] * lk2[lane] + lq2[lane + 64] * lk2[lane + 64]);
    const float lam = expf(s1) - expf(s2) + LAMBDA_INIT;
    float gs[8];
#pragma unroll
    for (int e = 0; e < 8; ++e) gs[e] = sg[(lane & 31) * 8 + e] * (1.f - LAMBDA_INIT);
    for (int m = gw; m < TOK; m += NGW) {
        const v4u* a = (const v4u*)(OC + (size_t)m * DM) + lane; const v4u* b = (const v4u*)(OC + (size_t)TOK * DM + (size_t)m * DM) + lane; v4u* o = (v4u*)(O + (size_t)m * DM) + lane;
#pragma unroll
        for (int st = 0; st < 4; ++st) { const v4u av = a[64 * st], bv = b[64 * st]; float d[8]; float ss = 0.f;
#pragma unroll
            for (int e = 0; e < 4; ++e) { const unsigned aw = av[e], bw = bv[e];
                d[2 * e] = __builtin_bit_cast(float, aw << 16) - lam * __builtin_bit_cast(float, bw << 16);
                d[2 * e + 1] = __builtin_bit_cast(float, aw & 0xffff0000u) - lam * __builtin_bit_cast(float, bw & 0xffff0000u);
                ss += d[2 * e] * d[2 * e] + d[2 * e + 1] * d[2 * e + 1]; }
#pragma unroll
            for (int of = 1; of < 32; of <<= 1) ss += __shfl_xor(ss, of);
            const float rstd = 1.f / sqrtf(ss * (1.f / 256.f) + SUBLN_EPS);
            v4u w; w.x = pk2(d[0] * rstd * gs[0], d[1] * rstd * gs[1]); w.y = pk2(d[2] * rstd * gs[2], d[3] * rstd * gs[3]);
            w.z = pk2(d[4] * rstd * gs[4], d[5] * rstd * gs[5]); w.w = pk2(d[6] * rstd * gs[6], d[7] * rstd * gs[7]); o[64 * st] = w; }
    }
}
__device__ __forceinline__ void cumsum_phase(const float* F, const float* bfb, float* CB, LAS unsigned char* lds, int bx, int G, int tid) {
    LAS double* sc = (LAS double*)lds;
    for (int bh = bx; bh < BATCH * FH; bh += G) {
        const int b = bh / FH, h = bh % FH; const float bias = bfb[h];
        const float* fp = F + ((size_t)b * SEQ + (size_t)tid * 32) * FH + h;
        float ls[32]; double run = 0.0;
#pragma unroll
        for (int i = 0; i < 32; ++i) { const float x = fp[(size_t)i * FH] + bias; ls[i] = fminf(x, 0.f) - log1pf(expf(-fabsf(x))); run += (double)ls[i]; }
        sc[tid] = run; __syncthreads();
        int cur = 0;
        for (int of = 1; of < 512; of <<= 1) { double v = sc[cur * 512 + tid]; if (tid >= of) v += sc[cur * 512 + tid - of]; sc[(cur ^ 1) * 512 + tid] = v; cur ^= 1; __syncthreads(); }
        double acc = sc[cur * 512 + tid] - run;
        float* op = CB + (size_t)bh * SEQ + (size_t)tid * 32;
#pragma unroll
        for (int i = 0; i < 32; ++i) { acc += (double)ls[i]; op[i] = (float)(-acc * 11.313708498984761); }
        __syncthreads();
    }
}

__device__ __forceinline__ void rownorm_phase(const bf16* QKV, unsigned* NRM, int bx, int G, int tid) {
    for (int vw = bx; vw < 256; vw += G) {
        const int bh = vw >> 3, part = vw & 7, b = bh >> 4, h = bh & 15;
        const char* base = (const char*)(QKV + ((size_t)(b * 16 + h) * SEQ + (size_t)part * 2048) * 128);
        const unsigned vo = (unsigned)(((tid >> 4) * 128 + (tid & 15) * 8) * 2);
        constexpr size_t KOFF = (size_t)32 * SEQ * 128 * 2;
        float mq = 0.f, mk = 0.f;
#pragma unroll 4
        for (int it = 0; it < 64; ++it) {
            const char* rp = base + (size_t)it * 32 * 128 * 2;
            const v4u qv = *(const v4u*)(rp + vo), kv = *(const v4u*)(rp + KOFF + vo);
            float sq = 0.f, sk = 0.f;
#pragma unroll
            for (int e = 0; e < 4; ++e) { const float a0 = __builtin_bit_cast(float, qv[e] << 16), a1 = __builtin_bit_cast(float, qv[e] & 0xffff0000u), b0 = __builtin_bit_cast(float, kv[e] << 16), b1 = __builtin_bit_cast(float, kv[e] & 0xffff0000u);
                sq += a0 * a0 + a1 * a1; sk += b0 * b0 + b1 * b1; }
#pragma unroll
            for (int of = 1; of < 16; of <<= 1) { sq += __shfl_xor(sq, of); sk += __shfl_xor(sk, of); }
            mq = fmaxf(mq, sq); mk = fmaxf(mk, sk);
        }
        mq = fmaxf(mq, __shfl_xor(mq, 16)); mq = fmaxf(mq, __shfl_xor(mq, 32)); mk = fmaxf(mk, __shfl_xor(mk, 16)); mk = fmaxf(mk, __shfl_xor(mk, 32));
        if ((tid & 63) == 0) { atomicMax(NRM + bh * 2, __float_as_uint(mq)); atomicMax(NRM + bh * 2 + 1, __float_as_uint(mk)); }
    }
}

#define XB_TMO      128
#define XB_XCNT(j)  (256  + 64 * (j))
#define XB_XSUB(j)  (1280 + 64 * (j))
#define XB_XGEN(j)  (2304 + 64 * (j))
#define XB_TOP      3328
#define XB_TOPGEN   3392
#define XCD_BAR_WORDS 3456
#define XB_SPIN_CAP (1u << 18)

__device__ __forceinline__ unsigned xb_ld(unsigned* p)              { return __hip_atomic_load(p, __ATOMIC_RELAXED, __HIP_MEMORY_SCOPE_AGENT); }
__device__ __forceinline__ unsigned xb_add(unsigned* p, unsigned v) { return __hip_atomic_fetch_add(p, v, __ATOMIC_RELAXED, __HIP_MEMORY_SCOPE_AGENT); }
__device__ __forceinline__ unsigned xb_xcc_id() { return (unsigned)__builtin_amdgcn_s_getreg((3 << 11) | 20) & 0xFu; }
#define XB_SPIN(cond, bar) do { unsigned _sp = 0; while (cond) { __builtin_amdgcn_s_sleep(1); \
    if ((++_sp & 255u) == 0u) { if (xb_ld(&(bar)[XB_TMO])) break; if (_sp > XB_SPIN_CAP) { atomicAdd(&(bar)[XB_TMO], 1u); break; } } } } while (0)

struct XcdBarrier {
    unsigned* bar; unsigned x;
    volatile LAS unsigned* st;
};

__device__ __forceinline__ XcdBarrier xcd_barrier_post(unsigned* bar, volatile LAS unsigned* st) {
    XcdBarrier b; b.bar = bar; b.x = xb_xcc_id(); b.st = st;
    if (threadIdx.x == 0) (void)xb_add(&bar[XB_XCNT(b.x)], 1u);
    return b;
}
__device__ __forceinline__ void xcd_barrier_complete(unsigned* bar, unsigned x, unsigned& nloc, unsigned& nx) {
    const unsigned G = gridDim.x * gridDim.y * gridDim.z;
    unsigned sum, cnt, mine, sp = 0u;
    for (;;) {
        sum = 0u; cnt = 0u; mine = 0u;
#pragma unroll
        for (unsigned j = 0; j < 16; ++j) { const unsigned c = xb_ld(&bar[XB_XCNT(j)]); sum += c; cnt += (c > 0u) ? 1u : 0u; mine = (j == x) ? c : mine; }
        if (sum == G) break;
        __builtin_amdgcn_s_sleep(1);
        if ((++sp & 255u) == 0u) { if (xb_ld(&bar[XB_TMO])) break; if (sp > XB_SPIN_CAP) { atomicAdd(&bar[XB_TMO], 1u); break; } }
    }
    nloc = mine > 0u ? mine : 1u; nx = cnt > 0u ? cnt : 1u;
}

__device__ __forceinline__ void xcd_barrier(const XcdBarrier& b) {
    asm volatile("s_waitcnt vmcnt(0)" ::: "memory");
    __syncthreads();
    if (threadIdx.x == 0) {
        unsigned* bar = b.bar;
        __builtin_amdgcn_s_waitcnt(0);
        unsigned nloc = b.st[0], nx = b.st[1];
        if (nloc == 0u) { xcd_barrier_complete(bar, b.x, nloc, nx); b.st[0] = nloc; b.st[1] = nx; }
        const unsigned old = xb_add(&bar[XB_XSUB(b.x)], 1u);
        const unsigned gen = old / nloc;
        if (old + 1u == (gen + 1u) * nloc) {
            __builtin_amdgcn_fence(__ATOMIC_RELEASE, "agent");
            asm volatile("s_waitcnt vmcnt(0)" ::: "memory");
            const unsigned og = xb_add(&bar[XB_TOP], 1u);
            const unsigned tg = og / nx;
            if (og + 1u == (tg + 1u) * nx) xb_add(&bar[XB_TOPGEN], 1u);
            else XB_SPIN(xb_ld(&bar[XB_TOPGEN]) == tg, bar);
            __builtin_amdgcn_fence(__ATOMIC_ACQUIRE, "agent");
            xb_add(&bar[XB_XGEN(b.x)], 1u);
            asm volatile("s_waitcnt vmcnt(0)" ::: "memory");
        } else {
            XB_SPIN(xb_ld(&bar[XB_XGEN(b.x)]) == gen, bar);
            __builtin_amdgcn_fence(__ATOMIC_ACQUIRE, "agent");
            asm volatile("s_waitcnt vmcnt(0)" ::: "memory");
        }
    }
    __syncthreads();
}

struct Args { const float* in[21]; float* out; unsigned char* ws; };
template <int MODE> __device__ __forceinline__ bool attn_item(int i, int G, int bx, int& s, int& x) {
    constexpr int NS = MODE == 0 ? 64 : 32;
    if ((G & 7) == 0) { const int xcd = bx & 7, k = bx >> 3, kpx = G >> 3; const int idx = k + i * kpx; if (idx >= (NS / 8) * 32) return false; s = (idx >> 5) * 8 + xcd; x = idx & 31; return true; }
    const int L = bx + i * G; if (L >= NS * 32) return false; s = L >> 5; x = L & 31; return true;
}
template <int MODE> __device__ __forceinline__ att::BlockRef attn_ref(int s, int qb, int jlo, const bf16* QKV, bf16* Obuf, const float* CB) {
    att::BlockRef r; r.P0 = qb * 256; r.jlo = jlo;
    constexpr size_t HS = (size_t)SEQ * 128;
    if (MODE == 0) { const int xcd = s & 7, sl = s >> 3, vh = sl & 1, c = (sl >> 1) & 1, bh = xcd * 2 + ((sl >> 2) & 1), b = bh >> 3, h = bh & 7;
        r.Q = QKV + (size_t)((0 + b) * 16 + h * 2 + c) * HS + (size_t)r.P0 * 128; r.K = QKV + (size_t)((2 + b) * 16 + h * 2 + c) * HS; r.V = QKV + (size_t)((4 + b) * 16 + h * 2 + vh) * HS;
        r.O = Obuf + (size_t)c * TOK * DM + ((size_t)b * SEQ + r.P0) * DM + h * 256 + vh * 128; r.CB = nullptr; r.h = h; }
    else { const int b = s >> 4, h = s & 15;
        r.Q = QKV + (size_t)((0 + b) * 16 + h) * HS + (size_t)r.P0 * 128; r.K = QKV + (size_t)((2 + b) * 16 + h) * HS; r.V = QKV + (size_t)((4 + b) * 16 + h) * HS;
        r.O = Obuf + ((size_t)b * SEQ + r.P0) * DM + h * 128; r.CB = CB + (size_t)s * SEQ; r.h = 0; }
    return r;
}
template <int MODE> __device__ __forceinline__ void attn_phase(char* lds, const bf16* QKV, bf16* Obuf, const float* CB, const unsigned* NRM, int G, int bx) {
    int* jt = (int*)(lds + att::OFF_TB);
    if (MODE == 1) {
        int tid = threadIdx.x; asm volatile("" : "+v"(tid)); const int w = __builtin_amdgcn_readfirstlane(tid >> 6), lane = tid & 63;
        if (tid < 64) jt[tid] = 0;
        __syncthreads();
        for (int e = w; e < 64; e += 8) { int s, x; if (!attn_item<MODE>(e >> 1, G, bx, s, x)) break;
            const int qb = (e & 1) ? 63 - x : x, jmax = qb * 4; const float* cb = CB + (size_t)s * SEQ;
            const float qn = sqrtf(__uint_as_float(NRM[s * 2])) * 1.01f, kn = sqrtf(__uint_as_float(NRM[s * 2 + 1])) * 1.01f;
            const float thr = cb[qb * 256] - 110.f * 11.313708498984761f - 2.f * qn * kn;
            int need = 0;
            for (int j0 = jmax - 1; j0 >= 0; j0 -= 64) { const int j = j0 - lane; const bool c = (j >= 0) && (cb[(j >= 0 ? j : 0) * 64 + 63] >= thr);
                const unsigned long long m = __ballot(c); const int n = __builtin_popcountll(m); need += n; if (n < 64) break; }
            if (lane == 0) jt[e] = jmax - need; }
        __syncthreads();
    }
    for (int i = 0; ; ++i) { int s, x; if (!attn_item<MODE>(i, G, bx, s, x)) break;
        for (int pass = 0; pass < 2; ++pass) {
            const int jl = (MODE == 1 && i < 32) ? jt[i * 2 + pass] : 0;
            const att::BlockRef cur = attn_ref<MODE>(s, pass ? 63 - x : x, jl, QKV, Obuf, CB);
            att::attn_block<MODE>(cur, lds); } }
}

__global__ void __launch_bounds__(NWAVES * 64, 2) yoco_fwd(Args args) {
    extern __shared__ __attribute__((aligned(16))) unsigned char lds[];
    cg::grid_group grid = cg::this_grid();
    LAS unsigned char* ldsl = (LAS unsigned char*)lds;
    const int G = gridDim.x, bx = blockIdx.x, NGW = G * NWAVES;
    int tid, lane, wave, gw;
#define FRESH() do { tid = threadIdx.x; asm volatile("" : "+v"(tid)); lane = tid & 63; wave = __builtin_amdgcn_readfirstlane(tid >> 6); gw = bx * NWAVES + wave; } while (0)
    FRESH();
#define WSP(T, off) ((T*)(launder_g((GAS unsigned char*)args.ws) + (off)))
#define Wqkv0 WSP(bf16, WS_WQKV0)
#define Woa WSP(bf16, WS_WOA)
#define Wmi0 WSP(bf16, WS_WMI0)
#define Wmo0 WSP(bf16, WS_WMO0)
#define Wqkv1 WSP(bf16, WS_WQKV1)
#define Wob WSP(bf16, WS_WOB)
#define Wmi1 WSP(bf16, WS_WMI1)
#define Wmo1 WSP(bf16, WS_WMO1)
#define QKV WSP(bf16, WS_QKV)
#define OC WSP(bf16, WS_OC)
#define HID WSP(bf16, WS_HID)
#define XN WSP(bf16, WS_XN)
#define Fb WSP(float, WS_F)
#define CB WSP(float, WS_CB)
#define NRM WSP(unsigned, WS_NRM)
#define RS WSP(float, WS_RS)
#define HB WSP(bf16, WS_HB)
#define out ((float*)launder_g((GAS unsigned char*)args.out))
#define XIN ((const float*)launder_g((GAS unsigned char*)args.in[0]))
    volatile LAS unsigned* xst = (volatile LAS unsigned*)(ldsl + LDS_BYTES - 64);
    if (tid < 2) xst[tid] = 0u;
    __syncthreads();
    const XcdBarrier xbar = xcd_barrier_post(WSP(unsigned, WS_BAR), xst);

    {
        LAS float* scr = (LAS float*)(ldsl + wave * 16640);
        bf16* const wqkv1 = Wqkv1;
        const float* ag = args.in[2]; const float* mg = args.in[3]; const float* kg = args.in[11];
        constexpr int I_QKV = (DM / 64) * (NQKV / 64), I_DD = (DM / 64) * (DM / 64), I_MI = (DM / 64) * (FF / 64), I_MO = (FF / 64) * (DM / 64);
        constexpr int NITEMS = I_QKV + 5 * I_DD + 2 * I_MI + 2 * I_MO;
        for (int it = gw; it < NITEMS; it += NGW) {
            int r = it;
            if (r < I_QKV) { transpose_item(args.in[4], DM, NQKV, Wqkv0, 0, ag, scr, r, lane); continue; } r -= I_QKV;
            if (r < I_DD) { transpose_item(args.in[10], DM, DM, Woa, 0, nullptr, scr, r, lane); continue; } r -= I_DD;
            if (r < I_DD) { transpose_item(args.in[16], DM, DM, wqkv1, 0, ag + DM, scr, r, lane); continue; } r -= I_DD;
            if (r < I_DD) { transpose_item(args.in[12], DM, DM, wqkv1, DM, kg, scr, r, lane); continue; } r -= I_DD;
            if (r < I_DD) { transpose_item(args.in[13], DM, DM, wqkv1, 2 * DM, kg, scr, r, lane); continue; } r -= I_DD;
            if (r < I_DD) { transpose_item(args.in[17], DM, DM, Wob, 0, nullptr, scr, r, lane); continue; } r -= I_DD;
            if (r < I_MI) { transpose_item(args.in[18], DM, FF, Wmi0, 0, mg, scr, r, lane); continue; } r -= I_MI;
            if (r < I_MI) { transpose_item(args.in[18] + (size_t)DM * FF, DM, FF, Wmi1, 0, mg + DM, scr, r, lane); continue; } r -= I_MI;
            if (r < I_MO) { transpose_item(args.in[19], FF, DM, Wmo0, 0, nullptr, scr, r, lane); continue; } r -= I_MO;
            transpose_item(args.in[19] + (size_t)FF * DM, FF, DM, Wmo1, 0, nullptr, scr, r, lane);
        }
        { const float* wf = args.in[14]; const int gt = bx * 512 + tid, NT_ = G * 512;
          for (int e = gt; e < (NQKV1 - NQKV) * DM; e += NT_) { const int n = e / DM, k = e % DM; wqkv1[(size_t)(NQKV + n) * DM + k] = (n < FH) ? (bf16)f2bf(wf[(size_t)k * FH + n] * kg[k]) : (bf16)0; } }
        if (bx == 0 && tid < 64) NRM[tid] = 0u;
        { float* rsz = RS; for (int e = bx * 512 + tid; e < 4 * TOK; e += G * 512) rsz[e] = 0.f; }
        norm_phase(XIN, XN, gw, NGW, lane);
    }
    grid.sync();
#define GSYNC() xcd_barrier(xbar)
#define GEMM_PHASE(EPI, A_, B_, N_, K_, ...) do { pg8::Gemm g{A_, B_, TOK, N_, K_}; pg8::StaticOrder S; S.init(TOK, N_, G, bx); EPI E{__VA_ARGS__}; \
        pg8::gemm_phase<EPI, pg8::StaticOrder, PG8_ALIGN, PG8_SP2>(ldsl, g, S, E); } while (0)
    typedef pg8::EpiX<0, false, false, false> EpiQKV0; typedef pg8::EpiX<3, true, false, false> EpiQKV1; typedef pg8::EpiX<1, true, false, false> EpiMlpIn;
    typedef pg8::EpiX<2, false, true, true> EpiRes; typedef pg8::EpiX<2, false, false, true> EpiResLast;
    GEMM_PHASE(EpiQKV0, XN, Wqkv0, NQKV, DM, QKV, NQKV, nullptr, nullptr, nullptr, nullptr, nullptr);
    GSYNC();
    {
      FRESH(); const float* tab = args.in[1]; float* tb = (float*)(lds + att::OFF_TB);
      for (int idx = tid; idx < 2048; idx += 512) { const int h = idx >> 8, rel = (idx & 255) - 192; const int n = rel < 0 ? -rel : rel;
          int bk = n < 8 ? n : 8 + (n >= 12) + (n >= 16) + (n >= 23) + (n >= 32) + (n >= 46) + (n >= 64) + (n >= 91); if (rel > 0) bk += 16;
          tb[idx] = (tab[bk * 8 + h] - tab[15 * 8 + h]) * 11.313708498984761f; }
      __syncthreads();
      attn_phase<0>((char*)lds, QKV, OC, nullptr, nullptr, G, bx);
    }
    GSYNC();
    FRESH(); combine_phase(OC, XN, args.in[5], args.in[6], args.in[7], args.in[8], args.in[9], gw, NGW, lane);
    GSYNC();
    GEMM_PHASE(EpiRes, XN, Woa, DM, DM, HB, DM, XIN, out, nullptr, nullptr, RS);
    GSYNC();
    GEMM_PHASE(EpiMlpIn, HB, Wmi0, FF, DM, HID, FF, nullptr, nullptr, nullptr, RS, nullptr);
    GSYNC();
    GEMM_PHASE(EpiRes, HID, Wmo0, DM, FF, XN, DM, out, out, nullptr, nullptr, RS + TOK);
    GSYNC();
    GEMM_PHASE(EpiQKV1, XN, Wqkv1, NQKV1, DM, QKV, NQKV, nullptr, nullptr, Fb, RS + TOK, nullptr);
    GSYNC();
    FRESH(); cumsum_phase(Fb, args.in[15], CB, ldsl, bx, G, tid);
    rownorm_phase(QKV, NRM, bx, G, tid);
    GSYNC();
    attn_phase<1>((char*)lds, QKV, XN, CB, NRM, G, bx);
    GSYNC();
    GEMM_PHASE(EpiRes, XN, Wob, DM, DM, HB, DM, out, out, nullptr, nullptr, RS + 2 * TOK);
    GSYNC();
    GEMM_PHASE(EpiMlpIn, HB, Wmi1, FF, DM, HID, FF, nullptr, nullptr, nullptr, RS + 2 * TOK, nullptr);
    GSYNC();
    GEMM_PHASE(EpiResLast, HID, Wmo1, DM, FF, nullptr, DM, out, out, nullptr, nullptr, RS + 3 * TOK);
    GSYNC();
    FRESH(); final_norm_phase(out, args.in[20], RS + 3 * TOK, gw, NGW, lane);
}

#undef out
#undef XIN
extern "C" void kernel_launch(void* const* d_in, const int* in_sizes, int n_in, void* d_out, int out_size, void* d_ws, size_t ws_size, hipStream_t stream) {
    static int grid = 0;
    if (grid == 0) {
        if (n_in != 21 || in_sizes[0] != TOK * DM || out_size != TOK * DM || ws_size < WS_END) { fprintf(stderr, "kernel_launch: unexpected shapes (n_in %d, in0 %d, out %d, ws %zu)\n", n_in, n_in > 0 ? in_sizes[0] : -1, out_size, ws_size); grid = -1; return; }
        int dev = 0, cus = 0, per_cu = 0;
        (void)hipGetDevice(&dev); (void)hipDeviceGetAttribute(&cus, hipDeviceAttributeMultiprocessorCount, dev);
        if (hipFuncSetAttribute((const void*)yoco_fwd, hipFuncAttributeMaxDynamicSharedMemorySize, LDS_BYTES) != hipSuccess) { fprintf(stderr, "kernel_launch: hipFuncSetAttribute failed\n"); grid = -1; return; }
        if (hipOccupancyMaxActiveBlocksPerMultiprocessor(&per_cu, (const void*)yoco_fwd, NWAVES * 64, LDS_BYTES) != hipSuccess || per_cu < 1) { fprintf(stderr, "kernel_launch: occupancy query gives %d\n", per_cu); per_cu = 1; }
        (void)hipGetLastError();
        grid = cus > 0 ? cus : 256;
    }
    if (grid < 0) return;
    if (hipMemsetAsync((char*)d_ws + WS_BAR, 0, 16384, stream) != hipSuccess) { fprintf(stderr, "kernel_launch: hipMemsetAsync failed\n"); return; }
    Args a{};
    for (int i = 0; i < 21; ++i) a.in[i] = (const float*)d_in[i];
    a.out = (float*)d_out; a.ws = (unsigned char*)d_ws;
    void* kargs[] = {&a};
    hipError_t e = hipLaunchCooperativeKernel((const void*)yoco_fwd, dim3(grid), dim3(NWAVES * 64), kargs, LDS_BYTES, stream);
    if (e != hipSuccess) fprintf(stderr, "kernel_launch: cooperative launch failed: %s (grid %d)\n", hipGetErrorString(e), grid);
}
```

```cpp
#include <hip/hip_runtime.h>
#include <hip/hip_cooperative_groups.h>
#include <cstdio>
#include <cstdint>
namespace cg = cooperative_groups;
namespace pg8 {
#define PG8_LAS __attribute__((address_space(3)))
typedef unsigned short bf16_t;
typedef short bf16x8 __attribute__((ext_vector_type(8)));
typedef float f32x4 __attribute__((ext_vector_type(4)));
typedef unsigned u32x4 __attribute__((ext_vector_type(4)));
constexpr int BM = 256, BK = 64, HALF = 128, HTB = HALF * BK * 2  , STAGE_BYTES = 8 * HTB, NXCD = 8, WGM = 8;

__host__ __device__ __forceinline__ int lds_byte(int r, int c) { const int st = (r >> 4) * 2 + (c >> 5), rr = r & 15, cc = c & 31, ob = rr * 64 + cc * 2; return st * 1024 + (ob ^ (((ob >> 9) & 1) << 5)); }
__host__ __device__ __forceinline__ void stage_rc(int b, int& R, int& C) { const int st = b / 1024, sb = b % 1024, swz = sb ^ (((sb >> 9) & 1) << 5); R = (st >> 1) * 16 + swz / 64; C = (st & 1) * 32 + (swz % 64) / 2; }
__host__ __device__ __forceinline__ int perm32(int rho) { const int n = rho >> 4, i = rho & 15; return 8 * (i >> 2) + 4 * n + (i & 3); }

struct Unit { int pm, pn; };
struct Gemm { const bf16_t* A; const bf16_t* Bt; int M, N, K; };

struct StaticOrder {
    int nM, nN, nwg, G, c;
    __host__ __device__ void init(int M, int N, int G_, int c_) { nM = M / BM; nN = N / BM; nwg = nM * nN; G = G_; c = c_; }
    __host__ __device__ bool next(int i, Unit& u) const {
        const long L = (long)i * G + c; if (L >= nwg) return false;
        int wgid = (int)L; { const int q = nwg / NXCD, r = nwg % NXCD, xcd = wgid % NXCD, off = wgid / NXCD; wgid = (xcd < r ? xcd * (q + 1) : r * (q + 1) + (xcd - r) * q) + off; }
        const int nig = WGM * nN, gid = wgid / nig, fm = gid * WGM, gsz = (nM - fm) < WGM ? (nM - fm) : WGM;
        u.pm = fm + ((wgid % nig) % gsz); u.pn = (wgid % nig) / gsz; return true;
    }
    __device__ __forceinline__ void a_ready(const Unit&) const {}
    __device__ __forceinline__ void done(const Unit&) const {}
};

__device__ __forceinline__ unsigned cvt_pk_bf16(float lo, float hi) { unsigned r; asm volatile("v_cvt_pk_bf16_f32 %0, %1, %2" : "=v"(r) : "v"(lo), "v"(hi)); return r; }
typedef float f32x2 __attribute__((ext_vector_type(2)));
__device__ __forceinline__ size_t hm_off(int row, int col) { return ((size_t)(((col >> 11) * 2 + (row >> 14)) * 16 + ((col >> 7) & 15)) << 21) + ((size_t)(row & 16383) << 7) + (size_t)(col & 127); }
template <int MODE, bool RS_IN, bool COPY, bool SUMSQ> struct EpiX {
    static constexpr bool PERM = true, AFTER_DRAIN = false;
    bf16_t* O; int ldc; const float* base; float* out; float* F; const float* rs_in; float* rs_out;
    __device__ __forceinline__ void operator()(const f32x4 (&acc)[2][2][4][2], const Unit& u, int wr, int wc, int fr, int fq) const {
        const int row0 = u.pm * BM + wr * 64 + fr, col0 = u.pn * BM + wc * 32 + 8 * fq;
        const bool ftile = (MODE == 3) && (u.pn * BM >= 6144);
#pragma unroll
        for (int ai = 0; ai < 2; ++ai)
#pragma unroll
            for (int m = 0; m < 4; ++m) { const size_t row = (size_t)(row0 + ai * HALF + m * 16);
                float rs = 1.f; if (RS_IN) rs = 1.f / sqrtf(rs_in[row] * (1.f / 2048.f) + 1e-6f);
                float ss = 0.f;
#pragma unroll
                for (int bj = 0; bj < 2; ++bj) { f32x4 v0 = acc[ai][bj][m][0], v1 = acc[ai][bj][m][1]; const int col = col0 + bj * HALF;
                    if (RS_IN) { v0 = v0 * rs; v1 = v1 * rs; }
                    if (MODE == 2) { const float* bp = base + row * ldc + col; float* op = out + row * ldc + col;
                        const f32x4 b0 = *(const f32x4*)bp, b1 = *(const f32x4*)(bp + 4); v0 = b0 + v0; v1 = b1 + v1; *(f32x4*)op = v0; *(f32x4*)(op + 4) = v1;
                        if (SUMSQ) ss += (v0[0] * v0[0] + v0[1] * v0[1]) + (v0[2] * v0[2] + v0[3] * v0[3]) + (v1[0] * v1[0] + v1[1] * v1[1]) + (v1[2] * v1[2] + v1[3] * v1[3]);
                        if (COPY) { u32x4 w; w.x = cvt_pk_bf16(v0[0], v0[1]); w.y = cvt_pk_bf16(v0[2], v0[3]); w.z = cvt_pk_bf16(v1[0], v1[1]); w.w = cvt_pk_bf16(v1[2], v1[3]); *(u32x4*)(O + row * ldc + col) = w; } }
                    else if (ftile) { if (bj == 0 && wc == 0 && fq < 2) { float* fp = F + row * 16 + 8 * fq; *(f32x4*)fp = v0; *(f32x4*)(fp + 4) = v1; } }
                    else { if (MODE == 1) {
#pragma unroll
                            for (int e = 0; e < 4; ++e) { const float a = fmaxf(v0[e], 0.f), b = fmaxf(v1[e], 0.f); v0[e] = a * a; v1[e] = b * b; } }
                        u32x4 w; w.x = cvt_pk_bf16(v0[0], v0[1]); w.y = cvt_pk_bf16(v0[2], v0[3]); w.z = cvt_pk_bf16(v1[0], v1[1]); w.w = cvt_pk_bf16(v1[2], v1[3]);
                        if (MODE == 0 || MODE == 3) *(u32x4*)(O + hm_off((int)row, col)) = w;
                        else *(u32x4*)(O + row * ldc + col) = w; } }
                if (SUMSQ) { ss += __shfl_xor(ss, 16); ss += __shfl_xor(ss, 32); if (fq == 0) atomicAdd(rs_out + row, ss); }
                if (MODE == 2) asm volatile("" ::: "memory"); }
    }
};
template <class Epi, class Sched, bool ALIGN_EPI = false, bool SP2 = false>
__device__ __forceinline__ void gemm_phase(PG8_LAS unsigned char* lds, const Gemm g, const Sched& S, const Epi& E) {
    int tid = threadIdx.x; asm volatile("" : "+v"(tid));
    const int wid = __builtin_amdgcn_readfirstlane(tid >> 6), lane = tid & 63, wr = wid >> 2, wc = wid & 3, fr = lane & 15, fq = lane >> 4;
    const int K = g.K, nt = K / BK;
    unsigned voffA[2], voffB[2];
#pragma unroll
    for (int i = 0; i < 2; ++i) { int R, C; stage_rc(tid * 16 + i * 8192, R, C); const int Rb = Epi::PERM ? ((R & ~31) + perm32(R & 31)) : R;
        voffA[i] = (unsigned)(R * K + C) * 2u; voffB[i] = (unsigned)(Rb * K + C) * 2u; }
    const size_t kstep = (size_t)(BK * 2);
    const size_t hstep = (size_t)HALF * K * 2;
    const size_t tstep = 2 * hstep;
    const unsigned ldsw = (unsigned)wid * 1024u;
    const int aoff = lds_byte(wr * 64 + fr, fq * 8), boff = lds_byte(wc * 32 + fr, fq * 8);
#define PG8_SA(b, h) (((b) * 2 + (h)) * HTB)
#define PG8_SB(b, h) ((4 + (b) * 2 + (h)) * HTB)
#define PG8_STAGE(bufoff, gbase, voff) do { _Pragma("unroll") for (int _i = 0; _i < 2; ++_i) \
        __builtin_amdgcn_global_load_lds((const unsigned*)((const char*)(gbase) + (voff)[_i]), (PG8_LAS unsigned*)(lds + (bufoff) + ldsw + _i * 8192), 16, 0, 0); } while (0)
#define PG8_LDA(dst, b, h) do { _Pragma("unroll") for (int m = 0; m < 4; ++m) _Pragma("unroll") for (int k = 0; k < 2; ++k) dst[m][k] = *(const PG8_LAS bf16x8*)(lds + PG8_SA(b, h) + aoff + m * 2048 + k * 1024); } while (0)
#define PG8_LDB(dst, b, h) do { _Pragma("unroll") for (int n = 0; n < 2; ++n) _Pragma("unroll") for (int k = 0; k < 2; ++k) dst[n][k] = *(const PG8_LAS bf16x8*)(lds + PG8_SB(b, h) + boff + n * 2048 + k * 1024); } while (0)
#define PG8_MMA(ai, bj, At, Bt) do { __builtin_amdgcn_s_setprio(1); _Pragma("unroll") for (int m = 0; m < 4; ++m) _Pragma("unroll") for (int n = 0; n < 2; ++n) _Pragma("unroll") for (int k = 0; k < 2; ++k) \
        acc[ai][bj][m][n] = __builtin_amdgcn_mfma_f32_16x16x32_bf16(Bt[n][k], At[m][k], acc[ai][bj][m][n], 0, 0, 0); __builtin_amdgcn_s_setprio(0); } while (0)
#define PG8_WAIT_V(n) asm volatile("s_waitcnt vmcnt(" #n ")" ::: "memory")
#define PG8_WAIT_L(n) asm volatile("s_waitcnt lgkmcnt(" #n ")" ::: "memory")
#define PG8_BAR __builtin_amdgcn_s_barrier()
#define PG8_SCHED __builtin_amdgcn_sched_barrier(0)
    Unit cur, nxt; int ui = 0;
    if (!S.next(0, cur)) return;
    f32x4 acc[2][2][4][2];
#pragma unroll
    for (int a = 0; a < 2; ++a)
#pragma unroll
        for (int b = 0; b < 2; ++b)
#pragma unroll
            for (int m = 0; m < 4; ++m)
#pragma unroll
                for (int n = 0; n < 2; ++n) acc[a][b][m][n] = (f32x4){0.f, 0.f, 0.f, 0.f};
    bf16x8 At[4][2], B0[2][2], B1[2][2];
    const char* cA = (const char*)g.A + (size_t)cur.pm * tstep; const char* cB = (const char*)g.Bt + (size_t)cur.pn * tstep;
    S.a_ready(cur);
    if constexpr (SP2) {
        PG8_STAGE(PG8_SB(0, 0), cB, voffB); PG8_STAGE(PG8_SB(0, 1), cB + hstep, voffB); PG8_STAGE(PG8_SA(0, 0), cA, voffA); PG8_STAGE(PG8_SA(0, 1), cA + hstep, voffA);
        if (wr == 1) PG8_BAR;
        PG8_WAIT_V(2); PG8_BAR;
        PG8_STAGE(PG8_SB(1, 0), cB + kstep, voffB); PG8_STAGE(PG8_SA(1, 0), cA + kstep, voffA); PG8_STAGE(PG8_SB(1, 1), cB + hstep + kstep, voffB);
        PG8_WAIT_V(6); PG8_BAR;
    } else {
        PG8_STAGE(PG8_SB(0, 0), cB, voffB); PG8_STAGE(PG8_SA(0, 0), cA, voffA); PG8_STAGE(PG8_SB(0, 1), cB + hstep, voffB); PG8_STAGE(PG8_SA(0, 1), cA + hstep, voffA);
        if (wr == 1) PG8_BAR;
        PG8_WAIT_V(4); PG8_BAR;
        PG8_STAGE(PG8_SB(1, 0), cB + kstep, voffB); PG8_STAGE(PG8_SA(1, 0), cA + kstep, voffA); PG8_STAGE(PG8_SB(1, 1), cB + hstep + kstep, voffB);
        PG8_WAIT_V(6); PG8_BAR;
    }
    for (;;) {
        const bool has_next = S.next(ui + 1, nxt);
        const char* nA = has_next ? (const char*)g.A + (size_t)nxt.pm * tstep : cA; const char* nB = has_next ? (const char*)g.Bt + (size_t)nxt.pn * tstep : cB;
        for (int t = 0; t < nt; t += 2) {
            const bool last = (t == nt - 2);
            const char* a1 = cA + (size_t)(t + 1) * kstep;
            const char* a2 = last ? nA : cA + (size_t)(t + 2) * kstep; const char* b2 = last ? nB : cB + (size_t)(t + 2) * kstep;
            const char* a3 = a2 + kstep; const char* b3 = b2 + kstep;
            if (last && has_next) S.a_ready(nxt);
            if constexpr (SP2) {
            PG8_LDB(B0, 0, 0); PG8_LDB(B1, 0, 1); PG8_SCHED; PG8_LDA(At, 0, 0); PG8_STAGE(PG8_SA(1, 1), a1 + hstep, voffA);
            PG8_WAIT_V(8); PG8_WAIT_L(0); PG8_BAR; PG8_MMA(0, 0, At, B0); PG8_MMA(0, 1, At, B1); PG8_BAR; PG8_SCHED;
            PG8_LDA(At, 0, 1); PG8_STAGE(PG8_SB(0, 0), b2, voffB); PG8_STAGE(PG8_SB(0, 1), b2 + hstep, voffB); PG8_STAGE(PG8_SA(0, 0), a2, voffA);
            PG8_WAIT_V(8); PG8_WAIT_L(0); PG8_BAR; PG8_MMA(1, 0, At, B0); PG8_MMA(1, 1, At, B1); PG8_BAR; PG8_SCHED;
            PG8_LDB(B0, 1, 0); PG8_LDB(B1, 1, 1); PG8_SCHED; PG8_LDA(At, 1, 0); PG8_STAGE(PG8_SA(0, 1), a2 + hstep, voffA);
            PG8_WAIT_V(8); PG8_WAIT_L(0); PG8_BAR; PG8_MMA(0, 0, At, B0); PG8_MMA(0, 1, At, B1); PG8_BAR; PG8_SCHED;
            PG8_LDA(At, 1, 1); PG8_STAGE(PG8_SB(1, 0), b3, voffB); PG8_STAGE(PG8_SB(1, 1), b3 + hstep, voffB); PG8_STAGE(PG8_SA(1, 0), a3, voffA);
            PG8_WAIT_V(8); PG8_WAIT_L(0); PG8_BAR; PG8_MMA(1, 0, At, B0); PG8_MMA(1, 1, At, B1); PG8_BAR; PG8_SCHED;
            } else {
            PG8_LDB(B0, 0, 0); PG8_SCHED; PG8_LDA(At, 0, 0); PG8_STAGE(PG8_SA(1, 1), a1 + hstep, voffA);
            PG8_WAIT_L(8); PG8_BAR; PG8_WAIT_L(0); PG8_MMA(0, 0, At, B0); PG8_BAR; PG8_SCHED;
            PG8_LDB(B1, 0, 1); PG8_STAGE(PG8_SB(0, 0), b2, voffB);
            PG8_BAR; PG8_WAIT_L(0); PG8_MMA(0, 1, At, B1); PG8_BAR;
            PG8_LDA(At, 0, 1); PG8_STAGE(PG8_SA(0, 0), a2, voffA);
            PG8_BAR; PG8_WAIT_L(0); PG8_MMA(1, 0, At, B0); PG8_BAR; PG8_SCHED;
            PG8_STAGE(PG8_SB(0, 1), b2 + hstep, voffB);
            PG8_WAIT_V(6); PG8_BAR; PG8_MMA(1, 1, At, B1); PG8_BAR;
            PG8_LDB(B0, 1, 0); PG8_SCHED; PG8_LDA(At, 1, 0); PG8_STAGE(PG8_SA(0, 1), a2 + hstep, voffA);
            PG8_WAIT_L(8); PG8_BAR; PG8_WAIT_L(0); PG8_MMA(0, 0, At, B0); PG8_BAR; PG8_SCHED;
            PG8_LDB(B1, 1, 1); PG8_STAGE(PG8_SB(1, 0), b3, voffB);
            PG8_BAR; PG8_WAIT_L(0); PG8_MMA(0, 1, At, B1); PG8_BAR;
            PG8_LDA(At, 1, 1); PG8_STAGE(PG8_SA(1, 0), a3, voffA);
            PG8_BAR; PG8_WAIT_L(0); PG8_MMA(1, 0, At, B0); PG8_BAR; PG8_SCHED;
            PG8_STAGE(PG8_SB(1, 1), b3 + hstep, voffB);
            PG8_WAIT_V(6); PG8_BAR; PG8_MMA(1, 1, At, B1); PG8_BAR;
            }
        }
        if constexpr (ALIGN_EPI) { if (wr == 0) PG8_BAR; }
        if constexpr (!Epi::AFTER_DRAIN) { E(acc, cur, wr, wc, fr, fq); S.done(cur); }
        if (!has_next) break;
#pragma unroll
        for (int a = 0; a < 2; ++a)
#pragma unroll
            for (int b = 0; b < 2; ++b)
#pragma unroll
                for (int m = 0; m < 4; ++m)
#pragma unroll
                    for (int n = 0; n < 2; ++n) acc[a][b][m][n] = (f32x4){0.f, 0.f, 0.f, 0.f};
        cur = nxt; cA = nA; cB = nB; ++ui;
        if constexpr (ALIGN_EPI) { if (wr == 1) PG8_BAR; }
    }
    PG8_WAIT_V(0);
    if constexpr (!ALIGN_EPI) { if (wr == 0) PG8_BAR; }
    PG8_BAR;
    if constexpr (Epi::AFTER_DRAIN) { E.fused(acc, cur, wr, wc, fr, fq, lds, wid, lane); S.done(cur); }
#undef PG8_SA
#undef PG8_SB
#undef PG8_STAGE
#undef PG8_LDA
#undef PG8_LDB
#undef PG8_MMA
#undef PG8_WAIT_V
#undef PG8_WAIT_L
#undef PG8_BAR
#undef PG8_SCHED
}
}
#ifndef PG8_SP2
#define PG8_SP2 true
#endif
#ifndef PG8_ALIGN
#define PG8_ALIGN true
#endif
namespace att {
typedef unsigned short bf16;
typedef short bf16x8 __attribute__((ext_vector_type(8)));
typedef short s16x4 __attribute__((ext_vector_type(4)));
typedef float f32x16 __attribute__((ext_vector_type(16)));
typedef float f32x4 __attribute__((ext_vector_type(4)));
typedef unsigned u32x4 __attribute__((ext_vector_type(4)));
constexpr int D = 128, NW = 8, QBLK = 32, KVBLK = 64, QB = NW * QBLK, LDQ = 128, LDO = 2048;
constexpr float SCALE = 0.08838834764831845f, THR = 8.f;
constexpr int SHM_V = KVBLK * D * 2, SHM_K = KVBLK * D * 2, NSLOT = 3;
constexpr int OFF_V = 0, OFF_K = NSLOT * SHM_V, OFF_WS = OFF_K + NSLOT * SHM_K, OFF_CL = OFF_WS + NW * 64 * 4, OFF_TB = OFF_CL + NSLOT * 256, LDS_BYTES = OFF_TB + 8192;
#define KSWZ(row, colB) ((row) * 256 + ((colB) ^ (((row) & 7) << 4)))
#define SBAR() __builtin_amdgcn_sched_barrier(0)
__device__ __forceinline__ int v_st(int k, int c) { const int kk = (k & ~0xC) | ((k & 4) << 1) | ((k & 8) >> 1); return ((kk >> 3) * 4 + (c >> 5)) * 512 + ((kk & 7) * 32 + (c & 31)) * 2; }
__device__ __forceinline__ int v_rd_base(int lane) { return ((lane & 3) << 3) | (((lane >> 2) & 3) << 6) | (((lane >> 4) & 1) << 5) | (((lane >> 5) & 1) << 8); }
constexpr int v_rd_off(int d0, int ks, int half) { return d0 * 512 + ks * 4096 + half * 2048; }
__device__ __forceinline__ int crow(int r, int hi) { return (r & 3) + 8 * (r >> 2) + 4 * hi; }
__device__ __forceinline__ unsigned cvtpk(float lo, float hi) { unsigned r; asm volatile("v_cvt_pk_bf16_f32 %0, %1, %2" : "=v"(r) : "v"(lo), "v"(hi)); return r; }
__device__ __forceinline__ void mask_tile(f32x16& p0, f32x16& p1, int dq, unsigned W) {
    const float NEG = -__builtin_inff();
#pragma unroll
    for (int r = 0; r < 16; ++r) { const int c = (r & 3) + 8 * (r >> 2);
        if ((unsigned)(dq - c) >= W) p0[r] = NEG;
        if ((unsigned)(dq - c - 32) >= W) p1[r] = NEG; }
}
__device__ __forceinline__ void add_bias(f32x16& p0, f32x16& p1, const float* tb, int relbase) {
    const float* t = tb + relbase;
#pragma unroll
    for (int r = 0; r < 16; ++r) { const int c = (r & 3) + 8 * (r >> 2); p0[r] += t[c]; p1[r] += t[c + 32]; }
}
__device__ __forceinline__ void partialSM(f32x16& p0, f32x16& p1, float& m_reg, float& mn, float& alpha) {
    float pmax = p0[0]; for (int r = 1; r < 16; ++r) pmax = fmaxf(pmax, p0[r]); for (int r = 0; r < 16; ++r) pmax = fmaxf(pmax, p1[r]);
    { auto rr = __builtin_amdgcn_permlane32_swap(__float_as_uint(pmax), __float_as_uint(pmax), false, false);
      pmax = fmaxf(__uint_as_float(rr[0]), __uint_as_float(rr[1])); }
    constexpr float C2 = 1.4426950408889634f * SCALE;
    if (__builtin_expect(__all((pmax - m_reg) * SCALE <= THR), 1)) { mn = m_reg; alpha = 1.f; }
    else { mn = fmaxf(m_reg, pmax); alpha = __builtin_amdgcn_exp2f((m_reg - mn) * C2); m_reg = mn; }
    const float mnL = -mn * C2;
    for (int r = 0; r < 16; ++r) p0[r] = fmaf(p0[r], C2, mnL); for (int r = 0; r < 16; ++r) p1[r] = fmaf(p1[r], C2, mnL);
    for (int r = 0; r < 16; ++r) p0[r] = __builtin_amdgcn_exp2f(p0[r]);
}
__device__ __forceinline__ void finishSM(f32x16& p0, f32x16& p1, float alpha, float& l_reg, bf16x8& pa0, bf16x8& pa1, bf16x8& pa2, bf16x8& pa3) {
    for (int r = 0; r < 16; ++r) p1[r] = __builtin_amdgcn_exp2f(p1[r]);
    float ps = 0; for (int r = 0; r < 16; ++r) ps += p0[r]; for (int r = 0; r < 16; ++r) ps += p1[r];
    { auto rr = __builtin_amdgcn_permlane32_swap(__float_as_uint(ps), __float_as_uint(ps), false, false);
      ps = __uint_as_float(rr[0]) + __uint_as_float(rr[1]); }
    l_reg = l_reg * alpha + ps;
#define PK4(P, B_, OUT) do { unsigned a0 = cvtpk(P[B_+0], P[B_+1]), a1 = cvtpk(P[B_+2], P[B_+3]);                          \
        unsigned b0 = cvtpk(P[B_+4], P[B_+5]), b1 = cvtpk(P[B_+6], P[B_+7]);                                             \
        auto r0 = __builtin_amdgcn_permlane32_swap(a0, b0, false, false); auto r1 = __builtin_amdgcn_permlane32_swap(a1, b1, false, false); \
        u32x4 w = {r0[0], r1[0], r0[1], r1[1]}; OUT = *reinterpret_cast<bf16x8*>(&w); } while (0)
    PK4(p0, 0, pa0); PK4(p0, 8, pa1); PK4(p1, 0, pa2); PK4(p1, 8, pa3);
#undef PK4
}
template <bool SK, int MODE>
__device__ __forceinline__ void qkt(f32x16& p0, f32x16& p1, const char* lds, int kslot  , int cslot  , int r32, int hi, const bf16x8* qr, bool act) {
    if (SK && !act) { const float NEG = -__builtin_inff();
#pragma unroll
        for (int r = 0; r < 16; ++r) { p0[r] = NEG; p1[r] = NEG; } return; }
    if (MODE == 1) { const float* cl = (const float*)(lds + OFF_CL) + cslot + 4 * hi;
#pragma unroll
        for (int g = 0; g < 4; ++g) { const f32x4 a = *(const f32x4*)(cl + 8 * g), b = *(const f32x4*)(cl + 32 + 8 * g);
            p0[4 * g] = a[0]; p0[4 * g + 1] = a[1]; p0[4 * g + 2] = a[2]; p0[4 * g + 3] = a[3];
            p1[4 * g] = b[0]; p1[4 * g + 1] = b[1]; p1[4 * g + 2] = b[2]; p1[4 * g + 3] = b[3]; } }
    else { p0 = f32x16{}; p1 = f32x16{}; }
    const char* K_lds = lds + OFF_K + kslot;
    const char* kb[4];
#pragma unroll
    for (int dd = 0; dd < 4; ++dd) kb[dd] = K_lds + KSWZ(r32, (dd * 16 + hi * 8) * 2);
    __builtin_amdgcn_s_setprio(1);
#pragma unroll
    for (int d0 = 0; d0 < 8; ++d0) { const char* a = kb[d0 & 3] + (d0 >> 2) * 128;
        bf16x8 b0 = *reinterpret_cast<const bf16x8*>(a);
        bf16x8 b1 = *reinterpret_cast<const bf16x8*>(a + 32 * 256);
        p0 = __builtin_amdgcn_mfma_f32_32x32x16_bf16(b0, qr[d0], p0, 0, 0, 0);
        p1 = __builtin_amdgcn_mfma_f32_32x32x16_bf16(b1, qr[d0], p1, 0, 0, 0); }
    __builtin_amdgcn_s_setprio(0);
}
template <bool SK>
__device__ __forceinline__ void pv_tile(f32x16* o, int vb0  , bf16x8 pa0, bf16x8 pa1, bf16x8 pa2, bf16x8 pa3, bool act) {
    if (SK && !act) return;
#define TRRD(dst, off) asm volatile("ds_read_b64_tr_b16 %0, %1 offset:%2" : "=&v"(dst) : "v"(vb0), "i"(off) : "memory")
#define RD_D0(d0, L0, H0, L1, H1, L2, H2, L3, H3) do { constexpr int b_ = v_rd_off(d0, 0, 0); \
        TRRD(L0, b_); TRRD(H0, b_ + 2048); TRRD(L1, b_ + 4096); TRRD(H1, b_ + 6144); TRRD(L2, b_ + 8192); TRRD(H2, b_ + 10240); TRRD(L3, b_ + 12288); TRRD(H3, b_ + 14336); } while (0)
#define MM_D0(d0, L0, H0, L1, H1, L2, H2, L3, H3) do { __builtin_amdgcn_s_setprio(1); \
        o[d0] = __builtin_amdgcn_mfma_f32_32x32x16_bf16(pa0, (bf16x8){L0[0], L0[1], L0[2], L0[3], H0[0], H0[1], H0[2], H0[3]}, o[d0], 0, 0, 0);   \
        o[d0] = __builtin_amdgcn_mfma_f32_32x32x16_bf16(pa1, (bf16x8){L1[0], L1[1], L1[2], L1[3], H1[0], H1[1], H1[2], H1[3]}, o[d0], 0, 0, 0);   \
        o[d0] = __builtin_amdgcn_mfma_f32_32x32x16_bf16(pa2, (bf16x8){L2[0], L2[1], L2[2], L2[3], H2[0], H2[1], H2[2], H2[3]}, o[d0], 0, 0, 0);   \
        o[d0] = __builtin_amdgcn_mfma_f32_32x32x16_bf16(pa3, (bf16x8){L3[0], L3[1], L3[2], L3[3], H3[0], H3[1], H3[2], H3[3]}, o[d0], 0, 0, 0); __builtin_amdgcn_s_setprio(0); } while (0)
    s16x4 al0, ah0, al1, ah1, al2, ah2, al3, ah3, bl0, bh0, bl1, bh1, bl2, bh2, bl3, bh3;
    SBAR();
    RD_D0(0, al0, ah0, al1, ah1, al2, ah2, al3, ah3);
    RD_D0(1, bl0, bh0, bl1, bh1, bl2, bh2, bl3, bh3);
    asm volatile("s_waitcnt lgkmcnt(8)" ::: "memory"); SBAR();
    MM_D0(0, al0, ah0, al1, ah1, al2, ah2, al3, ah3); SBAR();
    RD_D0(2, al0, ah0, al1, ah1, al2, ah2, al3, ah3);
    asm volatile("s_waitcnt lgkmcnt(8)" ::: "memory"); SBAR();
    MM_D0(1, bl0, bh0, bl1, bh1, bl2, bh2, bl3, bh3); SBAR();
    RD_D0(3, bl0, bh0, bl1, bh1, bl2, bh2, bl3, bh3);
    asm volatile("s_waitcnt lgkmcnt(8)" ::: "memory"); SBAR();
    MM_D0(2, al0, ah0, al1, ah1, al2, ah2, al3, ah3); SBAR();
    asm volatile("s_waitcnt lgkmcnt(0)" ::: "memory"); SBAR();
    MM_D0(3, bl0, bh0, bl1, bh1, bl2, bh2, bl3, bh3);
#undef MM_D0
#undef RD_D0
#undef TRRD
}
struct BlockRef { const bf16* Q; const bf16* K; const bf16* V; bf16* O; const float* CB; int P0, jlo, h; };
__device__ __forceinline__ void glds16(const void* sbase, unsigned voff, unsigned lds_dst) { unsigned keep;
    asm volatile("s_mov_b32 %0, m0\n\ts_mov_b32 m0, %3\n\ts_nop 0\n\tglobal_load_lds_dwordx4 %1, %2\n\ts_mov_b32 m0, %0" : "=&s"(keep) : "v"(voff), "s"(sbase), "s"(lds_dst) : "memory"); }
__device__ __forceinline__ void glds4(const void* sbase, unsigned voff, unsigned lds_dst) { unsigned keep;
    asm volatile("s_mov_b32 %0, m0\n\ts_mov_b32 m0, %3\n\ts_nop 0\n\tglobal_load_lds_dword %1, %2\n\ts_mov_b32 m0, %0" : "=&s"(keep) : "v"(voff), "s"(sbase), "s"(lds_dst) : "memory"); }
#define WAIT_BAR(N) asm volatile("s_waitcnt vmcnt(" #N ") lgkmcnt(0)\n\ts_barrier" ::: "memory")
#define LD8(p) (*reinterpret_cast<const bf16x8*>(p))
template <int MODE>
__device__ __forceinline__ void attn_block(const BlockRef& cur, char* lds) {
    constexpr bool SK = (MODE == 0);
    constexpr int NDMA = (MODE == 1) ? 5 : 4;
    int tid = threadIdx.x; asm volatile("" : "+v"(tid));
    const int wid = __builtin_amdgcn_readfirstlane(tid >> 6), lane = tid & 63, r32 = lane & 31, hi = lane >> 5;
    const int j_lo = cur.jlo, NT = cur.P0 / KVBLK + QB / KVBLK - j_lo;
    const int qlo = cur.P0 + wid * QBLK, qm = qlo + r32 - 4 * hi;
    float* ws = (float*)(lds + OFF_WS) + wid * 64; float* li_l = ws, * al_l = ws + 32;
    const float* tbh = (const float*)(lds + OFF_TB) + cur.h * 256;
    float m_reg = -1e30f, l_reg = 0; f32x16 o[4] = {};
    const unsigned lds0 = (unsigned)(uintptr_t)lds;
    const int vb0 = (int)lds0 + OFF_V + v_rd_base(lane);
    unsigned koff0, koff1, voff0, voff1;
    { const int pc = wid * 2; int row = pc * 4 + (lane >> 4), c = (lane & 15) ^ (row & 7); koff0 = (unsigned)((row * LDQ + c * 8) * 2);
      row += 4; c = (lane & 15) ^ (row & 7); koff1 = (unsigned)((row * LDQ + c * 8) * 2);
      int st = 2 * pc + (lane >> 5), kk = ((st >> 2) << 3) | ((lane & 31) >> 2), k = (kk & ~0xC) | ((kk & 4) << 1) | ((kk & 8) >> 1); voff0 = (unsigned)((k * LDQ + (st & 3) * 32 + (lane & 3) * 8) * 2);
      st += 2; kk = ((st >> 2) << 3) | ((lane & 31) >> 2); k = (kk & ~0xC) | ((kk & 4) << 1) | ((kk & 8) >> 1); voff1 = (unsigned)((k * LDQ + (st & 3) * 32 + (lane & 3) * 8) * 2); }
    const unsigned kdst = lds0 + OFF_K + wid * 2048, vdst = lds0 + OFF_V + wid * 2048, cdst = lds0 + OFF_CL, lane4 = (unsigned)lane * 4u;
#define TIDX(t) (MODE == 1 ? (j_lo + NT - 1 - (t)) : (j_lo + (t)))
#define TILEB(t) ((size_t)TIDX(t) * (KVBLK * LDQ * 2))
#define DMA_K(t, slot) do { const char* g_ = (const char*)cur.K + TILEB(t); glds16(g_, koff0, kdst + (slot)); glds16(g_, koff1, kdst + (slot) + 1024); \
                            if (MODE == 1) glds4(cur.CB + (size_t)TIDX(t) * KVBLK, lane4, cdst + ((slot) >> 6)); } while (0)
#define DMA_V(t, slot) do { const char* g_ = (const char*)cur.V + TILEB(t); glds16(g_, voff0, vdst + (slot)); glds16(g_, voff1, vdst + (slot) + 1024); } while (0)
#define RESC(a) do { if (__any((a) < 1.f)) { if (hi == 0) al_l[r32] = (a); asm volatile("s_waitcnt lgkmcnt(0)" ::: "memory");              \
                     for (int d_ = 0; d_ < 4; ++d_) for (int r = 0; r < 16; ++r) o[d_][r] *= al_l[crow(r, hi)]; } } while (0)
#define KBASE(t) (TIDX(t) * KVBLK)
#define ACT(t) (MODE == 0 ? (KBASE(t) <= qlo) : true)
#define MASKT(P0_, P1_, t) do { const int kb_ = KBASE(t);                                                                              \
        if (MODE == 1) { if (kb_ + KVBLK - 1 > qlo) mask_tile(P0_, P1_, qm - kb_, 0x40000000u); }                                       \
        else { if (kb_ <= qlo && kb_ + KVBLK - 1 - qlo >= -90) add_bias(P0_, P1_, tbh, kb_ - qm + 192); } } while (0)
    DMA_K(0, 0); DMA_V(0, 0); DMA_K(1, SHM_K);
    bf16x8 qr[8];
    { const unsigned qo = (unsigned)(((wid * QBLK + r32) * LDQ + hi * 8) * 2);
#pragma unroll
      for (int d0 = 0; d0 < 8; ++d0) qr[d0] = LD8((const char*)cur.Q + qo + d0 * 32); }
    WAIT_BAR(0);
    int sl_prev = 2 * SHM_K, sl_cur = 0, sl_nxt = SHM_K;
#define ROT() do { const int t_ = sl_prev; sl_prev = sl_cur; sl_cur = sl_nxt; sl_nxt = t_; } while (0)
    f32x16 pA0, pA1, pB0, pB1; float mnA, mnB, alA, alB; bf16x8 pa0, pa1, pa2, pa3;
    DMA_K(2, sl_prev); DMA_V(1, sl_nxt);
    SBAR(); qkt<SK, MODE>(pA0, pA1, lds, sl_cur, sl_cur >> 8, r32, hi, qr, ACT(0));
    MASKT(pA0, pA1, 0); partialSM(pA0, pA1, m_reg, mnA, alA);
    if (2 < NT) { if (MODE == 1) WAIT_BAR(5); else WAIT_BAR(4); } else WAIT_BAR(0);
    ROT();
#define STEP(PL, PX0, PX1, mnX, alX, PY0, PY1, alY, s) do {                                                                    \
        if ((PL) || (s) + 2 < NT) DMA_K((s) + 2, sl_prev);                                                                     \
        if ((PL) || (s) + 1 < NT) DMA_V((s) + 1, sl_nxt);                                                                      \
        SBAR(); qkt<(SK && !(PL)), MODE>(PX0, PX1, lds, sl_cur, sl_cur >> 8, r32, hi, qr, ACT(s));                             \
        finishSM(PY0, PY1, alY, l_reg, pa0, pa1, pa2, pa3); SBAR();                                                            \
        pv_tile<(SK && !(PL))>(o, vb0 + sl_prev, pa0, pa1, pa2, pa3, ACT((s) - 1)); if (!(PL) || MODE == 1) MASKT(PX0, PX1, (s)); partialSM(PX0, PX1, m_reg, mnX, alX); \
        RESC(alX);                                                                                                             \
        if ((PL) || (s) + 2 < NT) { if (MODE == 1) WAIT_BAR(5); else WAIT_BAR(4); } else WAIT_BAR(0);                          \
        ROT(); } while (0)
    int s = 1;
    { const int NH = NT - (MODE == 0 ? 6 : 0) - 2;
      for (; s + 1 < NH; s += 2) {
        STEP(true, pB0, pB1, mnB, alB, pA0, pA1, alA, s);
        STEP(true, pA0, pA1, mnA, alA, pB0, pB1, alB, s + 1);
      } }
    for (; s + 1 < NT; s += 2) {
        STEP(false, pB0, pB1, mnB, alB, pA0, pA1, alA, s);
        STEP(false, pA0, pA1, mnA, alA, pB0, pB1, alB, s + 1);
    }
    if (s < NT) {
        STEP(false, pB0, pB1, mnB, alB, pA0, pA1, alA, s);
        finishSM(pB0, pB1, alB, l_reg, pa0, pa1, pa2, pa3); SBAR(); pv_tile<SK>(o, vb0 + sl_prev, pa0, pa1, pa2, pa3, ACT(NT - 1));
    } else {
        finishSM(pA0, pA1, alA, l_reg, pa0, pa1, pa2, pa3); SBAR(); pv_tile<SK>(o, vb0 + sl_prev, pa0, pa1, pa2, pa3, ACT(NT - 1));
    }
    if (hi == 0) li_l[r32] = l_reg; asm volatile("s_waitcnt lgkmcnt(0)" ::: "memory");
    float rli[16];
#pragma unroll
    for (int r = 0; r < 16; ++r) rli[r] = __builtin_amdgcn_rcpf(li_l[crow(r, hi)]);
    char* Ow = (char*)cur.O; const unsigned oo = (unsigned)(((wid * QBLK + 4 * hi) * LDO + r32) * 2);
#pragma unroll
    for (int r = 0; r < 16; ++r) { const unsigned orow = (unsigned)(((r & 3) + 8 * (r >> 2)) * LDO * 2);
#pragma unroll
        for (int d0 = 0; d0 < 4; ++d0) { const float v = o[d0][r] * rli[r];
            const float vn = __shfl_xor(v, 1);
            if ((r32 & 1) == 0) *(unsigned*)(Ow + (oo + orow + d0 * 64)) = cvtpk(v, vn); } }
    asm volatile("s_waitcnt lgkmcnt(0)\n\ts_barrier" ::: "memory");
#undef TILEB
#undef TIDX
#undef DMA_K
#undef DMA_V
#undef RESC
#undef KBASE
#undef ACT
#undef MASKT
#undef ROT
#undef STEP
}
#undef WAIT_BAR
#undef LD8
#undef SBAR
#undef KSWZ
}
#define GAS __attribute__((address_space(1)))
#define LAS __attribute__((address_space(3)))
typedef unsigned short bf16;
typedef unsigned v4u __attribute__((ext_vector_type(4)));
typedef unsigned v2u __attribute__((ext_vector_type(2)));
typedef float f32x4 __attribute__((ext_vector_type(4)));
constexpr int NWAVES = 8;
constexpr int BATCH = 2, SEQ = 16384, DM = 2048, TOK = BATCH * SEQ, FF = 8192, NQKV = 6144, NQKV1 = 6400, FH = 16;
constexpr float NORM_EPS = 1e-6f, SUBLN_EPS = 1e-5f, LAMBDA_INIT = 0.2f;
constexpr size_t MiB = 1u << 20;
constexpr size_t WS_F = 0, WS_CB = 2 * MiB;
constexpr size_t WS_WQKV0 = 4 * MiB, WS_WOA = 28 * MiB, WS_WMI0 = 36 * MiB, WS_WMO0 = 68 * MiB, WS_WQKV1 = 100 * MiB, WS_WOB = 126 * MiB, WS_WMI1 = 134 * MiB, WS_WMO1 = 166 * MiB;
constexpr size_t WS_NRM = 198 * MiB;
constexpr size_t WS_RS = 198 * MiB + 65536;
constexpr size_t WS_BAR = 199 * MiB;
constexpr size_t WS_HB = 712 * MiB;
constexpr size_t WS_QKV = 200 * MiB;
constexpr size_t WS_OC = 584 * MiB;
constexpr size_t WS_HID = 200 * MiB;
constexpr size_t WS_XN = 840 * MiB;
constexpr size_t WS_END = 968 * MiB;
constexpr int LDS_BYTES = 147456;

__device__ __forceinline__ GAS unsigned char* launder_g(GAS unsigned char* p) { asm volatile("" : "+s"(p)); return p; }
__device__ __forceinline__ unsigned f2bf(float f) { unsigned u = __builtin_bit_cast(unsigned, f); return (u + 0x7fffu + ((u >> 16) & 1u)) >> 16; }
__device__ __forceinline__ unsigned pk2(float lo, float hi) { return f2bf(lo) | (f2bf(hi) << 16); }
__device__ __forceinline__ float bf2f(unsigned short b) { return __builtin_bit_cast(float, (unsigned)b << 16); }
__device__ __forceinline__ float wave_sum(float v) {
#pragma unroll
    for (int o = 1; o < 64; o <<= 1) v += __shfl_xor(v, o);
    return v;
}
__device__ __forceinline__ void transpose_item(const float* W, int K, int N, bf16* WT, int row_off, const float* g, LAS float* scr, int item, int lane) {
    const int nblk = N / 64, kb = item / nblk, nb = item % nblk, k0 = 64 * kb, n0 = 64 * nb, kr = lane >> 4, nq = lane & 15;
    f32x4 v[16];
#pragma unroll
    for (int i = 0; i < 16; ++i) v[i] = *(const f32x4*)(W + (size_t)(k0 + 4 * i + kr) * N + n0 + 4 * nq);
#pragma unroll
    for (int i = 0; i < 16; ++i) { const int kk = 4 * i + kr; f32x4 t = v[i]; if (g) t = t * g[k0 + kk];
        scr[(4 * nq + 0) * 65 + kk] = t[0]; scr[(4 * nq + 1) * 65 + kk] = t[1]; scr[(4 * nq + 2) * 65 + kk] = t[2]; scr[(4 * nq + 3) * 65 + kk] = t[3]; }
    asm volatile("s_waitcnt lgkmcnt(0)" ::: "memory");
    const int c = lane & 7;
#pragma unroll
    for (int j = 0; j < 8; ++j) { const int n = (lane >> 3) + 8 * j; const LAS float* sp = scr + n * 65 + 8 * c;
        v4u o; o.x = pk2(sp[0], sp[1]); o.y = pk2(sp[2], sp[3]); o.z = pk2(sp[4], sp[5]); o.w = pk2(sp[6], sp[7]);
        *(v4u*)(WT + (size_t)(row_off + n0 + n) * K + k0 + 8 * c) = o; }
    asm volatile("s_waitcnt lgkmcnt(0)" ::: "memory");
}
__device__ __forceinline__ void norm_row_to_bf16(const float* xrow, bf16* orow, int lane) {
    const f32x4* xr = (const f32x4*)xrow + lane;
    f32x4 v[8]; float s = 0.f;
#pragma unroll
    for (int j = 0; j < 8; ++j) { v[j] = xr[64 * j]; s += (v[j].x * v[j].x + v[j].y * v[j].y) + (v[j].z * v[j].z + v[j].w * v[j].w); }
    const float rstd = 1.f / sqrtf(wave_sum(s) * (1.f / DM) + NORM_EPS);
    v2u* o8 = (v2u*)orow + lane;
#pragma unroll
    for (int j = 0; j < 8; ++j) { v2u w; w.x = pk2(v[j].x * rstd, v[j].y * rstd); w.y = pk2(v[j].z * rstd, v[j].w * rstd); o8[64 * j] = w; }
}
__device__ __forceinline__ void norm_phase(const float* src, bf16* dst, int gw, int NGW, int lane) {
    for (int m = gw; m < TOK; m += NGW) norm_row_to_bf16(src + (size_t)m * DM, dst + (size_t)m * DM, lane);
}
__device__ __forceinline__ void final_norm_phase(float* io, const float* g, const float* rs, int gw, int NGW, int lane) {
    for (int m = gw; m < TOK; m += NGW) {
        f32x4* xr = (f32x4*)(io + (size_t)m * DM) + lane; const f32x4* gr = (const f32x4*)g + lane;
        const float rstd = 1.f / sqrtf(rs[m] * (1.f / DM) + NORM_EPS);
#pragma unroll
        for (int j = 0; j < 8; ++j) xr[64 * j] = xr[64 * j] * rstd * gr[64 * j];
    }
}
__device__ __forceinline__ void combine_phase(const bf16* OC, bf16* O, const float* lq1, const float* lk1, const float* lq2, const float* lk2, const float* sg, int gw, int NGW, int lane) {
    const float s1 = wave_sum(lq1[lane] * lk1[lane] + lq1[lane + 64] * lk1[lane + 64]), s2 = wave_sum(lq2[lane] * lk2[lane] + lq2[lane + 64] * lk2[lane + 64]);
    const float lam = expf(s1) - expf(s2) + LAMBDA_INIT;
    float gs[8];
#pragma unroll
    for (int e = 0; e < 8; ++e) gs[e] = sg[(lane & 31) * 8 + e] * (1.f - LAMBDA_INIT);
    for (int m = gw; m < TOK; m += NGW) {
        const v4u* a = (const v4u*)(OC + (size_t)m * DM) + lane; const v4u* b = (const v4u*)(OC + (size_t)TOK * DM + (size_t)m * DM) + lane; v4u* o = (v4u*)(O + (size_t)m * DM) + lane;
#pragma unroll
        for (int st = 0; st < 4; ++st) { const v4u av = a[64 * st], bv = b[64 * st]; float d[8]; float ss = 0.f;
#pragma unroll
            for (int e = 0; e < 4; ++e) { const unsigned aw = av[e], bw = bv[e];
                d[2 * e] = __builtin_bit_cast(float, aw << 16) - lam * __builtin_bit_cast(float, bw << 16);
                d[2 * e + 1] = __builtin_bit_cast(float, aw & 0xffff0000u) - lam * __builtin_bit_cast(float, bw & 0xffff0000u);
                ss += d[2 * e] * d[2 * e] + d[2 * e + 1] * d[2 * e + 1]; }
#pragma unroll
            for (int of = 1; of < 32; of <<= 1) ss += __shfl_xor(ss, of);
            const float rstd = 1.f / sqrtf(ss * (1.f / 256.f) + SUBLN_EPS);
            v4u w; w.x = pk2(d[0] * rstd * gs[0], d[1] * rstd * gs[1]); w.y = pk2(d[2] * rstd * gs[2], d[3] * rstd * gs[3]);
            w.z = pk2(d[4] * rstd * gs[4], d[5] * rstd * gs[5]); w.w = pk2(d[6] * rstd * gs[6], d[7] * rstd * gs[7]); o[64 * st] = w; }
    }
}
__device__ __forceinline__ void cumsum_phase(const float* F, const float* bfb, float* CB, LAS unsigned char* lds, int bx, int G, int tid) {
    LAS double* sc = (LAS double*)lds;
    for (int bh = bx; bh < BATCH * FH; bh += G) {
        const int b = bh / FH, h = bh % FH; const float bias = bfb[h];
        const float* fp = F + ((size_t)b * SEQ + (size_t)tid * 32) * FH + h;
        float ls[32]; double run = 0.0;
#pragma unroll
        for (int i = 0; i < 32; ++i) { const float x = fp[(size_t)i * FH] + bias; ls[i] = fminf(x, 0.f) - log1pf(expf(-fabsf(x))); run += (double)ls[i]; }
        sc[tid] = run; __syncthreads();
        int cur = 0;
        for (int of = 1; of < 512; of <<= 1) { double v = sc[cur * 512 + tid]; if (tid >= of) v += sc[cur * 512 + tid - of]; sc[(cur ^ 1) * 512 + tid] = v; cur ^= 1; __syncthreads(); }
        double acc = sc[cur * 512 + tid] - run;
        float* op = CB + (size_t)bh * SEQ + (size_t)tid * 32;
#pragma unroll
        for (int i = 0; i < 32; ++i) { acc += (double)ls[i]; op[i] = (float)(-acc * 11.313708498984761); }
        __syncthreads();
    }
}

__device__ __forceinline__ void rownorm_phase(const bf16* QKV, unsigned* NRM, int bx, int G, int tid) {
    for (int vw = bx; vw < 256; vw += G) {
        const int bh = vw >> 3, part = vw & 7, b = bh >> 4, h = bh & 15;
        const char* base = (const char*)(QKV + ((size_t)(b * 16 + h) * SEQ + (size_t)part * 2048) * 128);
        const unsigned vo = (unsigned)(((tid >> 4) * 128 + (tid & 15) * 8) * 2);
        constexpr size_t KOFF = (size_t)32 * SEQ * 128 * 2;
        float mq = 0.f, mk = 0.f;
#pragma unroll 4
        for (int it = 0; it < 64; ++it) {
            const char* rp = base + (size_t)it * 32 * 128 * 2;
            const v4u qv = *(const v4u*)(rp + vo), kv = *(const v4u*)(rp + KOFF + vo);
            float sq = 0.f, sk = 0.f;
#pragma unroll
            for (int e = 0; e < 4; ++e) { const float a0 = __builtin_bit_cast(float, qv[e] << 16), a1 = __builtin_bit_cast(float, qv[e] & 0xffff0000u), b0 = __builtin_bit_cast(float, kv[e] << 16), b1 = __builtin_bit_cast(float, kv[e] & 0xffff0000u);
                sq += a0 * a0 + a1 * a1; sk += b0 * b0 + b1 * b1; }
#pragma unroll
            for (int of = 1; of < 16; of <<= 1) { sq += __shfl_xor(sq, of); sk += __shfl_xor(sk, of); }
            mq = fmaxf(mq, sq); mk = fmaxf(mk, sk);
        }
        mq = fmaxf(mq, __shfl_xor(mq, 16)); mq = fmaxf(mq, __shfl_xor(mq, 32)); mk = fmaxf(mk, __shfl_xor(mk, 16)); mk = fmaxf(mk, __shfl_xor(mk, 32));
        if ((tid & 63) == 0) { atomicMax(NRM + bh * 2, __float_as_uint(mq)); atomicMax(NRM + bh * 2 + 1, __float_as_uint(mk)); }
    }
}

#define XB_TMO      128
#define XB_XCNT(j)  (256  + 64 * (j))
#define XB_XSUB(j)  (1280 + 64 * (j))
#define XB_XGEN(j)  (2304 + 64 * (j))
#define XB_TOP      3328
#define XB_TOPGEN   3392
#define XCD_BAR_WORDS 3456
#define XB_SPIN_CAP (1u << 18)

__device__ __forceinline__ unsigned xb_ld(unsigned* p)              { return __hip_atomic_load(p, __ATOMIC_RELAXED, __HIP_MEMORY_SCOPE_AGENT); }
__device__ __forceinline__ unsigned xb_add(unsigned* p, unsigned v) { return __hip_atomic_fetch_add(p, v, __ATOMIC_RELAXED, __HIP_MEMORY_SCOPE_AGENT); }
__device__ __forceinline__ unsigned xb_xcc_id() { return (unsigned)__builtin_amdgcn_s_getreg((3 << 11) | 20) & 0xFu; }
#define XB_SPIN(cond, bar) do { unsigned _sp = 0; while (cond) { __builtin_amdgcn_s_sleep(1); \
    if ((++_sp & 255u) == 0u) { if (xb_ld(&(bar)[XB_TMO])) break; if (_sp > XB_SPIN_CAP) { atomicAdd(&(bar)[XB_TMO], 1u); break; } } } } while (0)

struct XcdBarrier {
    unsigned* bar; unsigned x;
    volatile LAS unsigned* st;
};

__device__ __forceinline__ XcdBarrier xcd_barrier_post(unsigned* bar, volatile LAS unsigned* st) {
    XcdBarrier b; b.bar = bar; b.x = xb_xcc_id(); b.st = st;
    if (threadIdx.x == 0) (void)xb_add(&bar[XB_XCNT(b.x)], 1u);
    return b;
}
__device__ __forceinline__ void xcd_barrier_complete(unsigned* bar, unsigned x, unsigned& nloc, unsigned& nx) {
    const unsigned G = gridDim.x * gridDim.y * gridDim.z;
    unsigned sum, cnt, mine, sp = 0u;
    for (;;) {
        sum = 0u; cnt = 0u; mine = 0u;
#pragma unroll
        for (unsigned j = 0; j < 16; ++j) { const unsigned c = xb_ld(&bar[XB_XCNT(j)]); sum += c; cnt += (c > 0u) ? 1u : 0u; mine = (j == x) ? c : mine; }
        if (sum == G) break;
        __builtin_amdgcn_s_sleep(1);
        if ((++sp & 255u) == 0u) { if (xb_ld(&bar[XB_TMO])) break; if (sp > XB_SPIN_CAP) { atomicAdd(&bar[XB_TMO], 1u); break; } }
    }
    nloc = mine > 0u ? mine : 1u; nx = cnt > 0u ? cnt : 1u;
}

__device__ __forceinline__ void xcd_barrier(const XcdBarrier& b) {
    asm volatile("s_waitcnt vmcnt(0)" ::: "memory");
    __syncthreads();
    if (threadIdx.x == 0) {
        unsigned* bar = b.bar;
        __builtin_amdgcn_s_waitcnt(0);
        unsigned nloc = b.st[0], nx = b.st[1];
        if (nloc == 0u) { xcd_barrier_complete(bar, b.x, nloc, nx); b.st[0] = nloc; b.st[1] = nx; }
        const unsigned old = xb_add(&bar[XB_XSUB(b.x)], 1u);
        const unsigned gen = old / nloc;
        if (old + 1u == (gen + 1u) * nloc) {
            __builtin_amdgcn_fence(__ATOMIC_RELEASE, "agent");
            asm volatile("s_waitcnt vmcnt(0)" ::: "memory");
            const unsigned og = xb_add(&bar[XB_TOP], 1u);
            const unsigned tg = og / nx;
            if (og + 1u == (tg + 1u) * nx) xb_add(&bar[XB_TOPGEN], 1u);
            else XB_SPIN(xb_ld(&bar[XB_TOPGEN]) == tg, bar);
            __builtin_amdgcn_fence(__ATOMIC_ACQUIRE, "agent");
            xb_add(&bar[XB_XGEN(b.x)], 1u);
            asm volatile("s_waitcnt vmcnt(0)" ::: "memory");
        } else {
            XB_SPIN(xb_ld(&bar[XB_XGEN(b.x)]) == gen, bar);
            __builtin_amdgcn_fence(__ATOMIC_ACQUIRE, "agent");
            asm volatile("s_waitcnt vmcnt(0)" ::: "memory");
        }
    }
    __syncthreads();
}

struct Args { const float* in[21]; float* out; unsigned char* ws; };
template <int MODE> __device__ __forceinline__ bool attn_item(int i, int G, int bx, int& s, int& x) {
    constexpr int NS = MODE == 0 ? 64 : 32;
    if ((G & 7) == 0) { const int xcd = bx & 7, k = bx >> 3, kpx = G >> 3; const int idx = k + i * kpx; if (idx >= (NS / 8) * 32) return false; s = (idx >> 5) * 8 + xcd; x = idx & 31; return true; }
    const int L = bx + i * G; if (L >= NS * 32) return false; s = L >> 5; x = L & 31; return true;
}
template <int MODE> __device__ __forceinline__ att::BlockRef attn_ref(int s, int qb, int jlo, const bf16* QKV, bf16* Obuf, const float* CB) {
    att::BlockRef r; r.P0 = qb * 256; r.jlo = jlo;
    constexpr size_t HS = (size_t)SEQ * 128;
    if (MODE == 0) { const int xcd = s & 7, sl = s >> 3, vh = sl & 1, c = (sl >> 1) & 1, bh = xcd * 2 + ((sl >> 2) & 1), b = bh >> 3, h = bh & 7;
        r.Q = QKV + (size_t)((0 + b) * 16 + h * 2 + c) * HS + (size_t)r.P0 * 128; r.K = QKV + (size_t)((2 + b) * 16 + h * 2 + c) * HS; r.V = QKV + (size_t)((4 + b) * 16 + h * 2 + vh) * HS;
        r.O = Obuf + (size_t)c * TOK * DM + ((size_t)b * SEQ + r.P0) * DM + h * 256 + vh * 128; r.CB = nullptr; r.h = h; }
    else { const int b = s >> 4, h = s & 15;
        r.Q = QKV + (size_t)((0 + b) * 16 + h) * HS + (size_t)r.P0 * 128; r.K = QKV + (size_t)((2 + b) * 16 + h) * HS; r.V = QKV + (size_t)((4 + b) * 16 + h) * HS;
        r.O = Obuf + ((size_t)b * SEQ + r.P0) * DM + h * 128; r.CB = CB + (size_t)s * SEQ; r.h = 0; }
    return r;
}
template <int MODE> __device__ __forceinline__ void attn_phase(char* lds, const bf16* QKV, bf16* Obuf, const float* CB, const unsigned* NRM, int G, int bx) {
    int* jt = (int*)(lds + att::OFF_TB);
    if (MODE == 1) {
        int tid = threadIdx.x; asm volatile("" : "+v"(tid)); const int w = __builtin_amdgcn_readfirstlane(tid >> 6), lane = tid & 63;
        if (tid < 64) jt[tid] = 0;
        __syncthreads();
        for (int e = w; e < 64; e += 8) { int s, x; if (!attn_item<MODE>(e >> 1, G, bx, s, x)) break;
            const int qb = (e & 1) ? 63 - x : x, jmax = qb * 4; const float* cb = CB + (size_t)s * SEQ;
            const float qn = sqrtf(__uint_as_float(NRM[s * 2])) * 1.01f, kn = sqrtf(__uint_as_float(NRM[s * 2 + 1])) * 1.01f;
            const float thr = cb[qb * 256] - 110.f * 11.313708498984761f - 2.f * qn * kn;
            int need = 0;
            for (int j0 = jmax - 1; j0 >= 0; j0 -= 64) { const int j = j0 - lane; const bool c = (j >= 0) && (cb[(j >= 0 ? j : 0) * 64 + 63] >= thr);
                const unsigned long long m = __ballot(c); const int n = __builtin_popcountll(m); need += n; if (n < 64) break; }
            if (lane == 0) jt[e] = jmax - need; }
        __syncthreads();
    }
    for (int i = 0; ; ++i) { int s, x; if (!attn_item<MODE>(i, G, bx, s, x)) break;
        for (int pass = 0; pass < 2; ++pass) {
            const int jl = (MODE == 1 && i < 32) ? jt[i * 2 + pass] : 0;
            const att::BlockRef cur = attn_ref<MODE>(s, pass ? 63 - x : x, jl, QKV, Obuf, CB);
            att::attn_block<MODE>(cur, lds); } }
}

__global__ void __launch_bounds__(NWAVES * 64, 2) yoco_fwd(Args args) {
    extern __shared__ __attribute__((aligned(16))) unsigned char lds[];
    cg::grid_group grid = cg::this_grid();
    LAS unsigned char* ldsl = (LAS unsigned char*)lds;
    const int G = gridDim.x, bx = blockIdx.x, NGW = G * NWAVES;
    int tid, lane, wave, gw;
#define FRESH() do { tid = threadIdx.x; asm volatile("" : "+v"(tid)); lane = tid & 63; wave = __builtin_amdgcn_readfirstlane(tid >> 6); gw = bx * NWAVES + wave; } while (0)
    FRESH();
#define WSP(T, off) ((T*)(launder_g((GAS unsigned char*)args.ws) + (off)))
#define Wqkv0 WSP(bf16, WS_WQKV0)
#define Woa WSP(bf16, WS_WOA)
#define Wmi0 WSP(bf16, WS_WMI0)
#define Wmo0 WSP(bf16, WS_WMO0)
#define Wqkv1 WSP(bf16, WS_WQKV1)
#define Wob WSP(bf16, WS_WOB)
#define Wmi1 WSP(bf16, WS_WMI1)
#define Wmo1 WSP(bf16, WS_WMO1)
#define QKV WSP(bf16, WS_QKV)
#define OC WSP(bf16, WS_OC)
#define HID WSP(bf16, WS_HID)
#define XN WSP(bf16, WS_XN)
#define Fb WSP(float, WS_F)
#define CB WSP(float, WS_CB)
#define NRM WSP(unsigned, WS_NRM)
#define RS WSP(float, WS_RS)
#define HB WSP(bf16, WS_HB)
#define out ((float*)launder_g((GAS unsigned char*)args.out))
#define XIN ((const float*)launder_g((GAS unsigned char*)args.in[0]))
    volatile LAS unsigned* xst = (volatile LAS unsigned*)(ldsl + LDS_BYTES - 64);
    if (tid < 2) xst[tid] = 0u;
    __syncthreads();
    const XcdBarrier xbar = xcd_barrier_post(WSP(unsigned, WS_BAR), xst);

    {
        LAS float* scr = (LAS float*)(ldsl + wave * 16640);
        bf16* const wqkv1 = Wqkv1;
        const float* ag = args.in[2]; const float* mg = args.in[3]; const float* kg = args.in[11];
        constexpr int I_QKV = (DM / 64) * (NQKV / 64), I_DD = (DM / 64) * (DM / 64), I_MI = (DM / 64) * (FF / 64), I_MO = (FF / 64) * (DM / 64);
        constexpr int NITEMS = I_QKV + 5 * I_DD + 2 * I_MI + 2 * I_MO;
        for (int it = gw; it < NITEMS; it += NGW) {
            int r = it;
            if (r < I_QKV) { transpose_item(args.in[4], DM, NQKV, Wqkv0, 0, ag, scr, r, lane); continue; } r -= I_QKV;
            if (r < I_DD) { transpose_item(args.in[10], DM, DM, Woa, 0, nullptr, scr, r, lane); continue; } r -= I_DD;
            if (r < I_DD) { transpose_item(args.in[16], DM, DM, wqkv1, 0, ag + DM, scr, r, lane); continue; } r -= I_DD;
            if (r < I_DD) { transpose_item(args.in[12], DM, DM, wqkv1, DM, kg, scr, r, lane); continue; } r -= I_DD;
            if (r < I_DD) { transpose_item(args.in[13], DM, DM, wqkv1, 2 * DM, kg, scr, r, lane); continue; } r -= I_DD;
            if (r < I_DD) { transpose_item(args.in[17], DM, DM, Wob, 0, nullptr, scr, r, lane); continue; } r -= I_DD;
            if (r < I_MI) { transpose_item(args.in[18], DM, FF, Wmi0, 0, mg, scr, r, lane); continue; } r -= I_MI;
            if (r < I_MI) { transpose_item(args.in[18] + (size_t)DM * FF, DM, FF, Wmi1, 0, mg + DM, scr, r, lane); continue; } r -= I_MI;
            if (r < I_MO) { transpose_item(args.in[19], FF, DM, Wmo0, 0, nullptr, scr, r, lane); continue; } r -= I_MO;
            transpose_item(args.in[19] + (size_t)FF * DM, FF, DM, Wmo1, 0, nullptr, scr, r, lane);
        }
        { const float* wf = args.in[14]; const int gt = bx * 512 + tid, NT_ = G * 512;
          for (int e = gt; e < (NQKV1 - NQKV) * DM; e += NT_) { const int n = e / DM, k = e % DM; wqkv1[(size_t)(NQKV + n) * DM + k] = (n < FH) ? (bf16)f2bf(wf[(size_t)k * FH + n] * kg[k]) : (bf16)0; } }
        if (bx == 0 && tid < 64) NRM[tid] = 0u;
        { float* rsz = RS; for (int e = bx * 512 + tid; e < 4 * TOK; e += G * 512) rsz[e] = 0.f; }
        norm_phase(XIN, XN, gw, NGW, lane);
    }
    grid.sync();
#define GSYNC() xcd_barrier(xbar)
#define GEMM_PHASE(EPI, A_, B_, N_, K_, ...) do { pg8::Gemm g{A_, B_, TOK, N_, K_}; pg8::StaticOrder S; S.init(TOK, N_, G, bx); EPI E{__VA_ARGS__}; \
        pg8::gemm_phase<EPI, pg8::StaticOrder, PG8_ALIGN, PG8_SP2>(ldsl, g, S, E); } while (0)
    typedef pg8::EpiX<0, false, false, false> EpiQKV0; typedef pg8::EpiX<3, true, false, false> EpiQKV1; typedef pg8::EpiX<1, true, false, false> EpiMlpIn;
    typedef pg8::EpiX<2, false, true, true> EpiRes; typedef pg8::EpiX<2, false, false, true> EpiResLast;
    GEMM_PHASE(EpiQKV0, XN, Wqkv0, NQKV, DM, QKV, NQKV, nullptr, nullptr, nullptr, nullptr, nullptr);
    GSYNC();
    {
      FRESH(); const float* tab = args.in[1]; float* tb = (float*)(lds + att::OFF_TB);
      for (int idx = tid; idx < 2048; idx += 512) { const int h = idx >> 8, rel = (idx & 255) - 192; const int n = rel < 0 ? -rel : rel;
          int bk = n < 8 ? n : 8 + (n >= 12) + (n >= 16) + (n >= 23) + (n >= 32) + (n >= 46) + (n >= 64) + (n >= 91); if (rel > 0) bk += 16;
          tb[idx] = (tab[bk * 8 + h] - tab[15 * 8 + h]) * 11.313708498984761f; }
      __syncthreads();
      attn_phase<0>((char*)lds, QKV, OC, nullptr, nullptr, G, bx);
    }
    GSYNC();
    FRESH(); combine_phase(OC, XN, args.in[5], args.in[6], args.in[7], args.in[8], args.in[9], gw, NGW, lane);
    GSYNC();
    GEMM_PHASE(EpiRes, XN, Woa, DM, DM, HB, DM, XIN, out, nullptr, nullptr, RS);
    GSYNC();
    GEMM_PHASE(EpiMlpIn, HB, Wmi0, FF, DM, HID, FF, nullptr, nullptr, nullptr, RS, nullptr);
    GSYNC();
    GEMM_PHASE(EpiRes, HID, Wmo0, DM, FF, XN, DM, out, out, nullptr, nullptr, RS + TOK);
    GSYNC();
    GEMM_PHASE(EpiQKV1, XN, Wqkv1, NQKV1, DM, QKV, NQKV, nullptr, nullptr, Fb, RS + TOK, nullptr);
    GSYNC();
    FRESH(); cumsum_phase(Fb, args.in[15], CB, ldsl, bx, G, tid);
    rownorm_phase(QKV, NRM, bx, G, tid);
    GSYNC();
    attn_phase<1>((char*)lds, QKV, XN, CB, NRM, G, bx);
    GSYNC();
    GEMM_PHASE(EpiRes, XN, Wob, DM, DM, HB, DM, out, out, nullptr, nullptr, RS + 2 * TOK);
    GSYNC();
    GEMM_PHASE(EpiMlpIn, HB, Wmi1, FF, DM, HID, FF, nullptr, nullptr, nullptr, RS + 2 * TOK, nullptr);
    GSYNC();
    GEMM_PHASE(EpiResLast, HID, Wmo1, DM, FF, nullptr, DM, out, out, nullptr, nullptr, RS + 3 * TOK);
    GSYNC();
    FRESH(); final_norm_phase(out, args.in[20], RS + 3 * TOK, gw, NGW, lane);
}

#undef out
#undef XIN
extern "C" void kernel_launch(void* const* d_in, const int* in_sizes, int n_in, void* d_out, int out_size, void* d_ws, size_t ws_size, hipStream_t stream) {
    static int grid = 0;
    if (grid == 0) {
        if (n_in != 21 || in_sizes[0] != TOK * DM || out_size != TOK * DM || ws_size < WS_END) { fprintf(stderr, "kernel_launch: unexpected shapes (n_in %d, in0 %d, out %d, ws %zu)\n", n_in, n_in > 0 ? in_sizes[0] : -1, out_size, ws_size); grid = -1; return; }
        int dev = 0, cus = 0, per_cu = 0;
        (void)hipGetDevice(&dev); (void)hipDeviceGetAttribute(&cus, hipDeviceAttributeMultiprocessorCount, dev);
        if (hipFuncSetAttribute((const void*)yoco_fwd, hipFuncAttributeMaxDynamicSharedMemorySize, LDS_BYTES) != hipSuccess) { fprintf(stderr, "kernel_launch: hipFuncSetAttribute failed\n"); grid = -1; return; }
        if (hipOccupancyMaxActiveBlocksPerMultiprocessor(&per_cu, (const void*)yoco_fwd, NWAVES * 64, LDS_BYTES) != hipSuccess || per_cu < 1) { fprintf(stderr, "kernel_launch: occupancy query gives %d\n", per_cu); per_cu = 1; }
        (void)hipGetLastError();
        grid = cus > 0 ? cus : 256;
    }
    if (grid < 0) return;
    if (hipMemsetAsync((char*)d_ws + WS_BAR, 0, 16384, stream) != hipSuccess) { fprintf(stderr, "kernel_launch: hipMemsetAsync failed\n"); return; }
    Args a{};
    for (int i = 0; i < 21; ++i) a.in[i] = (const float*)d_in[i];
    a.out = (float*)d_out; a.ws = (unsigned char*)d_ws;
    void* kargs[] = {&a};
    hipError_t e = hipLaunchCooperativeKernel((const void*)yoco_fwd, dim3(grid), dim3(NWAVES * 64), kargs, LDS_BYTES, stream);
    if (e != hipSuccess) fprintf(stderr, "kernel_launch: cooperative launch failed: %s (grid %d)\n", hipGetErrorString(e), grid);
}
```

```cpp
#include <hip/hip_runtime.h>
#include <hip/hip_cooperative_groups.h>
#include <cstdio>
#include <cstdint>
namespace cg = cooperative_groups;
namespace pg8 {
#define PG8_LAS __attribute__((address_space(3)))
typedef unsigned short bf16_t;
typedef short bf16x8 __attribute__((ext_vector_type(8)));
typedef float f32x4 __attribute__((ext_vector_type(4)));
typedef unsigned u32x4 __attribute__((ext_vector_type(4)));
constexpr int BM = 256, BK = 64, HALF = 128, HTB = HALF * BK * 2  , STAGE_BYTES = 8 * HTB, NXCD = 8, WGM = 8;

__host__ __device__ __forceinline__ int lds_byte(int r, int c) { const int st = (r >> 4) * 2 + (c >> 5), rr = r & 15, cc = c & 31, ob = rr * 64 + cc * 2; return st * 1024 + (ob ^ (((ob >> 9) & 1) << 5)); }
__host__ __device__ __forceinline__ void stage_rc(int b, int& R, int& C) { const int st = b / 1024, sb = b % 1024, swz = sb ^ (((sb >> 9) & 1) << 5); R = (st >> 1) * 16 + swz / 64; C = (st & 1) * 32 + (swz % 64) / 2; }
__host__ __device__ __forceinline__ int perm32(int rho) { const int n = rho >> 4, i = rho & 15; return 8 * (i >> 2) + 4 * n + (i & 3); }

struct Unit { int pm, pn; };
struct Gemm { const bf16_t* A; const bf16_t* Bt; int M, N, K; };

struct StaticOrder {
    int nM, nN, nwg, G, c;
    __host__ __device__ void init(int M, int N, int G_, int c_) { nM = M / BM; nN = N / BM; nwg = nM * nN; G = G_; c = c_; }
    __host__ __device__ bool next(int i, Unit& u) const {
        const long L = (long)i * G + c; if (L >= nwg) return false;
        int wgid = (int)L; { const int q = nwg / NXCD, r = nwg % NXCD, xcd = wgid % NXCD, off = wgid / NXCD; wgid = (xcd < r ? xcd * (q + 1) : r * (q + 1) + (xcd - r) * q) + off; }
        const int nig = WGM * nN, gid = wgid / nig, fm = gid * WGM, gsz = (nM - fm) < WGM ? (nM - fm) : WGM;
        u.pm = fm + ((wgid % nig) % gsz); u.pn = (wgid % nig) / gsz; return true;
    }
    __device__ __forceinline__ void a_ready(const Unit&) const {}
    __device__ __forceinline__ void done(const Unit&) const {}
};

__device__ __forceinline__ unsigned cvt_pk_bf16(float lo, float hi) { unsigned r; asm volatile("v_cvt_pk_bf16_f32 %0, %1, %2" : "=v"(r) : "v"(lo), "v"(hi)); return r; }
typedef float f32x2 __attribute__((ext_vector_type(2)));
__device__ __forceinline__ size_t hm_off(int row, int col) { return ((size_t)(((col >> 11) * 2 + (row >> 14)) * 16 + ((col >> 7) & 15)) << 21) + ((size_t)(row & 16383) << 7) + (size_t)(col & 127); }
template <int MODE, bool RS_IN, bool COPY, bool SUMSQ> struct EpiX {
    static constexpr bool PERM = true, AFTER_DRAIN = false;
    bf16_t* O; int ldc; const float* base; float* out; float* F; const float* rs_in; float* rs_out;
    __device__ __forceinline__ void operator()(const f32x4 (&acc)[2][2][4][2], const Unit& u, int wr, int wc, int fr, int fq) const {
        const int row0 = u.pm * BM + wr * 64 + fr, col0 = u.pn * BM + wc * 32 + 8 * fq;
        const bool ftile = (MODE == 3) && (u.pn * BM >= 6144);
#pragma unroll
        for (int ai = 0; ai < 2; ++ai)
#pragma unroll
            for (int m = 0; m < 4; ++m) { const size_t row = (size_t)(row0 + ai * HALF + m * 16);
                float rs = 1.f; if (RS_IN) rs = 1.f / sqrtf(rs_in[row] * (1.f / 2048.f) + 1e-6f);
                float ss = 0.f;
#pragma unroll
                for (int bj = 0; bj < 2; ++bj) { f32x4 v0 = acc[ai][bj][m][0], v1 = acc[ai][bj][m][1]; const int col = col0 + bj * HALF;
                    if (RS_IN) { v0 = v0 * rs; v1 = v1 * rs; }
                    if (MODE == 2) { const float* bp = base + row * ldc + col; float* op = out + row * ldc + col;
                        const f32x4 b0 = *(const f32x4*)bp, b1 = *(const f32x4*)(bp + 4); v0 = b0 + v0; v1 = b1 + v1; *(f32x4*)op = v0; *(f32x4*)(op + 4) = v1;
                        if (SUMSQ) ss += (v0[0] * v0[0] + v0[1] * v0[1]) + (v0[2] * v0[2] + v0[3] * v0[3]) + (v1[0] * v1[0] + v1[1] * v1[1]) + (v1[2] * v1[2] + v1[3] * v1[3]);
                        if (COPY) { u32x4 w; w.x = cvt_pk_bf16(v0[0], v0[1]); w.y = cvt_pk_bf16(v0[2], v0[3]); w.z = cvt_pk_bf16(v1[0], v1[1]); w.w = cvt_pk_bf16(v1[2], v1[3]); *(u32x4*)(O + row * ldc + col) = w; } }
                    else if (ftile) { if (bj == 0 && wc == 0 && fq < 2) { float* fp = F + row * 16 + 8 * fq; *(f32x4*)fp = v0; *(f32x4*)(fp + 4) = v1; } }
                    else { if (MODE == 1) {
#pragma unroll
                            for (int e = 0; e < 4; ++e) { const float a = fmaxf(v0[e], 0.f), b = fmaxf(v1[e], 0.f); v0[e] = a * a; v1[e] = b * b; } }
                        u32x4 w; w.x = cvt_pk_bf16(v0[0], v0[1]); w.y = cvt_pk_bf16(v0[2], v0[3]); w.z = cvt_pk_bf16(v1[0], v1[1]); w.w = cvt_pk_bf16(v1[2], v1[3]);
                        if (MODE == 0 || MODE == 3) *(u32x4*)(O + hm_off((int)row, col)) = w;
                        else __builtin_nontemporal_store(w, (u32x4*)(O + row * ldc + col)); } }
                if (SUMSQ) { ss += __shfl_xor(ss, 16); ss += __shfl_xor(ss, 32); if (fq == 0) atomicAdd(rs_out + row, ss); }
                if (MODE == 2) asm volatile("" ::: "memory"); }
    }
};
template <class Epi, class Sched, bool ALIGN_EPI = false, bool SP2 = false>
__device__ __forceinline__ void gemm_phase(PG8_LAS unsigned char* lds, const Gemm g, const Sched& S, const Epi& E) {
    int tid = threadIdx.x; asm volatile("" : "+v"(tid));
    const int wid = __builtin_amdgcn_readfirstlane(tid >> 6), lane = tid & 63, wr = wid >> 2, wc = wid & 3, fr = lane & 15, fq = lane >> 4;
    const int K = g.K, nt = K / BK;
    unsigned voffA[2], voffB[2];
#pragma unroll
    for (int i = 0; i < 2; ++i) { int R, C; stage_rc(tid * 16 + i * 8192, R, C); const int Rb = Epi::PERM ? ((R & ~31) + perm32(R & 31)) : R;
        voffA[i] = (unsigned)(R * K + C) * 2u; voffB[i] = (unsigned)(Rb * K + C) * 2u; }
    const size_t kstep = (size_t)(BK * 2);
    const size_t hstep = (size_t)HALF * K * 2;
    const size_t tstep = 2 * hstep;
    const unsigned ldsw = (unsigned)wid * 1024u;
    const int aoff = lds_byte(wr * 64 + fr, fq * 8), boff = lds_byte(wc * 32 + fr, fq * 8);
#define PG8_SA(b, h) (((b) * 2 + (h)) * HTB)
#define PG8_SB(b, h) ((4 + (b) * 2 + (h)) * HTB)
#define PG8_STAGE(bufoff, gbase, voff) do { _Pragma("unroll") for (int _i = 0; _i < 2; ++_i) \
        __builtin_amdgcn_global_load_lds((const unsigned*)((const char*)(gbase) + (voff)[_i]), (PG8_LAS unsigned*)(lds + (bufoff) + ldsw + _i * 8192), 16, 0, 0); } while (0)
#define PG8_LDA(dst, b, h) do { _Pragma("unroll") for (int m = 0; m < 4; ++m) _Pragma("unroll") for (int k = 0; k < 2; ++k) dst[m][k] = *(const PG8_LAS bf16x8*)(lds + PG8_SA(b, h) + aoff + m * 2048 + k * 1024); } while (0)
#define PG8_LDB(dst, b, h) do { _Pragma("unroll") for (int n = 0; n < 2; ++n) _Pragma("unroll") for (int k = 0; k < 2; ++k) dst[n][k] = *(const PG8_LAS bf16x8*)(lds + PG8_SB(b, h) + boff + n * 2048 + k * 1024); } while (0)
#define PG8_MMA(ai, bj, At, Bt) do { __builtin_amdgcn_s_setprio(1); _Pragma("unroll") for (int m = 0; m < 4; ++m) _Pragma("unroll") for (int n = 0; n < 2; ++n) _Pragma("unroll") for (int k = 0; k < 2; ++k) \
        acc[ai][bj][m][n] = __builtin_amdgcn_mfma_f32_16x16x32_bf16(Bt[n][k], At[m][k], acc[ai][bj][m][n], 0, 0, 0); __builtin_amdgcn_s_setprio(0); } while (0)
#define PG8_WAIT_V(n) asm volatile("s_waitcnt vmcnt(" #n ")" ::: "memory")
#define PG8_WAIT_L(n) asm volatile("s_waitcnt lgkmcnt(" #n ")" ::: "memory")
#define PG8_BAR __builtin_amdgcn_s_barrier()
#define PG8_SCHED __builtin_amdgcn_sched_barrier(0)
    Unit cur, nxt; int ui = 0;
    if (!S.next(0, cur)) return;
    f32x4 acc[2][2][4][2];
#pragma unroll
    for (int a = 0; a < 2; ++a)
#pragma unroll
        for (int b = 0; b < 2; ++b)
#pragma unroll
            for (int m = 0; m < 4; ++m)
#pragma unroll
                for (int n = 0; n < 2; ++n) acc[a][b][m][n] = (f32x4){0.f, 0.f, 0.f, 0.f};
    bf16x8 At[4][2], B0[2][2], B1[2][2];
    const char* cA = (const char*)g.A + (size_t)cur.pm * tstep; const char* cB = (const char*)g.Bt + (size_t)cur.pn * tstep;
    S.a_ready(cur);
    if constexpr (SP2) {
        PG8_STAGE(PG8_SB(0, 0), cB, voffB); PG8_STAGE(PG8_SB(0, 1), cB + hstep, voffB); PG8_STAGE(PG8_SA(0, 0), cA, voffA); PG8_STAGE(PG8_SA(0, 1), cA + hstep, voffA);
        if (wr == 1) PG8_BAR;
        PG8_WAIT_V(2); PG8_BAR;
        PG8_STAGE(PG8_SB(1, 0), cB + kstep, voffB); PG8_STAGE(PG8_SA(1, 0), cA + kstep, voffA); PG8_STAGE(PG8_SB(1, 1), cB + hstep + kstep, voffB);
        PG8_WAIT_V(6); PG8_BAR;
    } else {
        PG8_STAGE(PG8_SB(0, 0), cB, voffB); PG8_STAGE(PG8_SA(0, 0), cA, voffA); PG8_STAGE(PG8_SB(0, 1), cB + hstep, voffB); PG8_STAGE(PG8_SA(0, 1), cA + hstep, voffA);
        if (wr == 1) PG8_BAR;
        PG8_WAIT_V(4); PG8_BAR;
        PG8_STAGE(PG8_SB(1, 0), cB + kstep, voffB); PG8_STAGE(PG8_SA(1, 0), cA + kstep, voffA); PG8_STAGE(PG8_SB(1, 1), cB + hstep + kstep, voffB);
        PG8_WAIT_V(6); PG8_BAR;
    }
    for (;;) {
        const bool has_next = S.next(ui + 1, nxt);
        const char* nA = has_next ? (const char*)g.A + (size_t)nxt.pm * tstep : cA; const char* nB = has_next ? (const char*)g.Bt + (size_t)nxt.pn * tstep : cB;
        for (int t = 0; t < nt; t += 2) {
            const bool last = (t == nt - 2);
            const char* a1 = cA + (size_t)(t + 1) * kstep;
            const char* a2 = last ? nA : cA + (size_t)(t + 2) * kstep; const char* b2 = last ? nB : cB + (size_t)(t + 2) * kstep;
            const char* a3 = a2 + kstep; const char* b3 = b2 + kstep;
            if (last && has_next) S.a_ready(nxt);
            if constexpr (SP2) {
            PG8_LDB(B0, 0, 0); PG8_LDB(B1, 0, 1); PG8_SCHED; PG8_LDA(At, 0, 0); PG8_STAGE(PG8_SA(1, 1), a1 + hstep, voffA);
            PG8_WAIT_V(8); PG8_WAIT_L(0); PG8_BAR; PG8_MMA(0, 0, At, B0); PG8_MMA(0, 1, At, B1); PG8_BAR; PG8_SCHED;
            PG8_LDA(At, 0, 1); PG8_STAGE(PG8_SB(0, 0), b2, voffB); PG8_STAGE(PG8_SB(0, 1), b2 + hstep, voffB); PG8_STAGE(PG8_SA(0, 0), a2, voffA);
            PG8_WAIT_V(8); PG8_WAIT_L(0); PG8_BAR; PG8_MMA(1, 0, At, B0); PG8_MMA(1, 1, At, B1); PG8_BAR; PG8_SCHED;
            PG8_LDB(B0, 1, 0); PG8_LDB(B1, 1, 1); PG8_SCHED; PG8_LDA(At, 1, 0); PG8_STAGE(PG8_SA(0, 1), a2 + hstep, voffA);
            PG8_WAIT_V(8); PG8_WAIT_L(0); PG8_BAR; PG8_MMA(0, 0, At, B0); PG8_MMA(0, 1, At, B1); PG8_BAR; PG8_SCHED;
            PG8_LDA(At, 1, 1); PG8_STAGE(PG8_SB(1, 0), b3, voffB); PG8_STAGE(PG8_SB(1, 1), b3 + hstep, voffB); PG8_STAGE(PG8_SA(1, 0), a3, voffA);
            PG8_WAIT_V(8); PG8_WAIT_L(0); PG8_BAR; PG8_MMA(1, 0, At, B0); PG8_MMA(1, 1, At, B1); PG8_BAR; PG8_SCHED;
            } else {
            PG8_LDB(B0, 0, 0); PG8_SCHED; PG8_LDA(At, 0, 0); PG8_STAGE(PG8_SA(1, 1), a1 + hstep, voffA);
            PG8_WAIT_L(8); PG8_BAR; PG8_WAIT_L(0); PG8_MMA(0, 0, At, B0); PG8_BAR; PG8_SCHED;
            PG8_LDB(B1, 0, 1); PG8_STAGE(PG8_SB(0, 0), b2, voffB);
            PG8_BAR; PG8_WAIT_L(0); PG8_MMA(0, 1, At, B1); PG8_BAR;
            PG8_LDA(At, 0, 1); PG8_STAGE(PG8_SA(0, 0), a2, voffA);
            PG8_BAR; PG8_WAIT_L(0); PG8_MMA(1, 0, At, B0); PG8_BAR; PG8_SCHED;
            PG8_STAGE(PG8_SB(0, 1), b2 + hstep, voffB);
            PG8_WAIT_V(6); PG8_BAR; PG8_MMA(1, 1, At, B1); PG8_BAR;
            PG8_LDB(B0, 1, 0); PG8_SCHED; PG8_LDA(At, 1, 0); PG8_STAGE(PG8_SA(0, 1), a2 + hstep, voffA);
            PG8_WAIT_L(8); PG8_BAR; PG8_WAIT_L(0); PG8_MMA(0, 0, At, B0); PG8_BAR; PG8_SCHED;
            PG8_LDB(B1, 1, 1); PG8_STAGE(PG8_SB(1, 0), b3, voffB);
            PG8_BAR; PG8_WAIT_L(0); PG8_MMA(0, 1, At, B1); PG8_BAR;
            PG8_LDA(At, 1, 1); PG8_STAGE(PG8_SA(1, 0), a3, voffA);
            PG8_BAR; PG8_WAIT_L(0); PG8_MMA(1, 0, At, B0); PG8_BAR; PG8_SCHED;
            PG8_STAGE(PG8_SB(1, 1), b3 + hstep, voffB);
            PG8_WAIT_V(6); PG8_BAR; PG8_MMA(1, 1, At, B1); PG8_BAR;
            }
        }
        if constexpr (ALIGN_EPI) { if (wr == 0) PG8_BAR; }
        if constexpr (!Epi::AFTER_DRAIN) { E(acc, cur, wr, wc, fr, fq); S.done(cur); }
        if (!has_next) break;
#pragma unroll
        for (int a = 0; a < 2; ++a)
#pragma unroll
            for (int b = 0; b < 2; ++b)
#pragma unroll
                for (int m = 0; m < 4; ++m)
#pragma unroll
                    for (int n = 0; n < 2; ++n) acc[a][b][m][n] = (f32x4){0.f, 0.f, 0.f, 0.f};
        cur = nxt; cA = nA; cB = nB; ++ui;
        if constexpr (ALIGN_EPI) { if (wr == 1) PG8_BAR; }
    }
    PG8_WAIT_V(0);
    if constexpr (!ALIGN_EPI) { if (wr == 0) PG8_BAR; }
    PG8_BAR;
    if constexpr (Epi::AFTER_DRAIN) { E.fused(acc, cur, wr, wc, fr, fq, lds, wid, lane); S.done(cur); }
#undef PG8_SA
#undef PG8_SB
#undef PG8_STAGE
#undef PG8_LDA
#undef PG8_LDB
#undef PG8_MMA
#undef PG8_WAIT_V
#undef PG8_WAIT_L
#undef PG8_BAR
#undef PG8_SCHED
}
}
#ifndef PG8_SP2
#define PG8_SP2 true
#endif
#ifndef PG8_ALIGN
#define PG8_ALIGN true
#endif
namespace att {
typedef unsigned short bf16;
typedef short bf16x8 __attribute__((ext_vector_type(8)));
typedef short s16x4 __attribute__((ext_vector_type(4)));
typedef float f32x16 __attribute__((ext_vector_type(16)));
typedef float f32x4 __attribute__((ext_vector_type(4)));
typedef unsigned u32x4 __attribute__((ext_vector_type(4)));
constexpr int D = 128, NW = 8, QBLK = 32, KVBLK = 64, QB = NW * QBLK, LDQ = 128, LDO = 2048;
constexpr float SCALE = 0.08838834764831845f, THR = 8.f;
constexpr int SHM_V = KVBLK * D * 2, SHM_K = KVBLK * D * 2, NSLOT = 3;
constexpr int OFF_V = 0, OFF_K = NSLOT * SHM_V, OFF_WS = OFF_K + NSLOT * SHM_K, OFF_CL = OFF_WS + NW * 64 * 4, OFF_TB = OFF_CL + NSLOT * 256, LDS_BYTES = OFF_TB + 8192;
#define KSWZ(row, colB) ((row) * 256 + ((colB) ^ (((row) & 7) << 4)))
#define SBAR() __builtin_amdgcn_sched_barrier(0)
__device__ __forceinline__ int v_st(int k, int c) { const int kk = (k & ~0xC) | ((k & 4) << 1) | ((k & 8) >> 1); return ((kk >> 3) * 4 + (c >> 5)) * 512 + ((kk & 7) * 32 + (c & 31)) * 2; }
__device__ __forceinline__ int v_rd_base(int lane) { return ((lane & 3) << 3) | (((lane >> 2) & 3) << 6) | (((lane >> 4) & 1) << 5) | (((lane >> 5) & 1) << 8); }
constexpr int v_rd_off(int d0, int ks, int half) { return d0 * 512 + ks * 4096 + half * 2048; }
__device__ __forceinline__ int crow(int r, int hi) { return (r & 3) + 8 * (r >> 2) + 4 * hi; }
__device__ __forceinline__ unsigned cvtpk(float lo, float hi) { unsigned r; asm volatile("v_cvt_pk_bf16_f32 %0, %1, %2" : "=v"(r) : "v"(lo), "v"(hi)); return r; }
__device__ __forceinline__ void mask_tile(f32x16& p0, f32x16& p1, int dq, unsigned W) {
    const float NEG = -__builtin_inff();
#pragma unroll
    for (int r = 0; r < 16; ++r) { const int c = (r & 3) + 8 * (r >> 2);
        if ((unsigned)(dq - c) >= W) p0[r] = NEG;
        if ((unsigned)(dq - c - 32) >= W) p1[r] = NEG; }
}
__device__ __forceinline__ void add_bias(f32x16& p0, f32x16& p1, const float* tb, int relbase) {
    const float* t = tb + relbase;
#pragma unroll
    for (int r = 0; r < 16; ++r) { const int c = (r & 3) + 8 * (r >> 2); p0[r] += t[c]; p1[r] += t[c + 32]; }
}
__device__ __forceinline__ void partialSM(f32x16& p0, f32x16& p1, float& m_reg, float& mn, float& alpha) {
    float pmax = p0[0]; for (int r = 1; r < 16; ++r) pmax = fmaxf(pmax, p0[r]); for (int r = 0; r < 16; ++r) pmax = fmaxf(pmax, p1[r]);
    { auto rr = __builtin_amdgcn_permlane32_swap(__float_as_uint(pmax), __float_as_uint(pmax), false, false);
      pmax = fmaxf(__uint_as_float(rr[0]), __uint_as_float(rr[1])); }
    constexpr float C2 = 1.4426950408889634f * SCALE;
    if (__builtin_expect(__all((pmax - m_reg) * SCALE <= THR), 1)) { mn = m_reg; alpha = 1.f; }
    else { mn = fmaxf(m_reg, pmax); alpha = __builtin_amdgcn_exp2f((m_reg - mn) * C2); m_reg = mn; }
    const float mnL = -mn * C2;
    for (int r = 0; r < 16; ++r) p0[r] = fmaf(p0[r], C2, mnL); for (int r = 0; r < 16; ++r) p1[r] = fmaf(p1[r], C2, mnL);
    for (int r = 0; r < 16; ++r) p0[r] = __builtin_amdgcn_exp2f(p0[r]);
}
__device__ __forceinline__ void finishSM(f32x16& p0, f32x16& p1, float alpha, float& l_reg, bf16x8& pa0, bf16x8& pa1, bf16x8& pa2, bf16x8& pa3) {
    for (int r = 0; r < 16; ++r) p1[r] = __builtin_amdgcn_exp2f(p1[r]);
    float ps = 0; for (int r = 0; r < 16; ++r) ps += p0[r]; for (int r = 0; r < 16; ++r) ps += p1[r];
    { auto rr = __builtin_amdgcn_permlane32_swap(__float_as_uint(ps), __float_as_uint(ps), false, false);
      ps = __uint_as_float(rr[0]) + __uint_as_float(rr[1]); }
    l_reg = l_reg * alpha + ps;
#define PK4(P, B_, OUT) do { unsigned a0 = cvtpk(P[B_+0], P[B_+1]), a1 = cvtpk(P[B_+2], P[B_+3]);                          \
        unsigned b0 = cvtpk(P[B_+4], P[B_+5]), b1 = cvtpk(P[B_+6], P[B_+7]);                                             \
        auto r0 = __builtin_amdgcn_permlane32_swap(a0, b0, false, false); auto r1 = __builtin_amdgcn_permlane32_swap(a1, b1, false, false); \
        u32x4 w = {r0[0], r1[0], r0[1], r1[1]}; OUT = *reinterpret_cast<bf16x8*>(&w); } while (0)
    PK4(p0, 0, pa0); PK4(p0, 8, pa1); PK4(p1, 0, pa2); PK4(p1, 8, pa3);
#undef PK4
}
template <bool SK, int MODE>
__device__ __forceinline__ void qkt(f32x16& p0, f32x16& p1, const char* lds, int kslot  , int cslot  , int r32, int hi, const bf16x8* qr, bool act) {
    if (SK && !act) { const float NEG = -__builtin_inff();
#pragma unroll
        for (int r = 0; r < 16; ++r) { p0[r] = NEG; p1[r] = NEG; } return; }
    if (MODE == 1) { const float* cl = (const float*)(lds + OFF_CL) + cslot + 4 * hi;
#pragma unroll
        for (int g = 0; g < 4; ++g) { const f32x4 a = *(const f32x4*)(cl + 8 * g), b = *(const f32x4*)(cl + 32 + 8 * g);
            p0[4 * g] = a[0]; p0[4 * g + 1] = a[1]; p0[4 * g + 2] = a[2]; p0[4 * g + 3] = a[3];
            p1[4 * g] = b[0]; p1[4 * g + 1] = b[1]; p1[4 * g + 2] = b[2]; p1[4 * g + 3] = b[3]; } }
    else { p0 = f32x16{}; p1 = f32x16{}; }
    const char* K_lds = lds + OFF_K + kslot;
    const char* kb[4];
#pragma unroll
    for (int dd = 0; dd < 4; ++dd) kb[dd] = K_lds + KSWZ(r32, (dd * 16 + hi * 8) * 2);
    __builtin_amdgcn_s_setprio(1);
#pragma unroll
    for (int d0 = 0; d0 < 8; ++d0) { const char* a = kb[d0 & 3] + (d0 >> 2) * 128;
        bf16x8 b0 = *reinterpret_cast<const bf16x8*>(a);
        bf16x8 b1 = *reinterpret_cast<const bf16x8*>(a + 32 * 256);
        p0 = __builtin_amdgcn_mfma_f32_32x32x16_bf16(b0, qr[d0], p0, 0, 0, 0);
        p1 = __builtin_amdgcn_mfma_f32_32x32x16_bf16(b1, qr[d0], p1, 0, 0, 0); }
    __builtin_amdgcn_s_setprio(0);
}
template <bool SK>
__device__ __forceinline__ void pv_tile(f32x16* o, int vb0  , bf16x8 pa0, bf16x8 pa1, bf16x8 pa2, bf16x8 pa3, bool act) {
    if (SK && !act) return;
#define TRRD(dst, off) asm volatile("ds_read_b64_tr_b16 %0, %1 offset:%2" : "=&v"(dst) : "v"(vb0), "i"(off) : "memory")
#define RD_D0(d0, L0, H0, L1, H1, L2, H2, L3, H3) do { constexpr int b_ = v_rd_off(d0, 0, 0); \
        TRRD(L0, b_); TRRD(H0, b_ + 2048); TRRD(L1, b_ + 4096); TRRD(H1, b_ + 6144); TRRD(L2, b_ + 8192); TRRD(H2, b_ + 10240); TRRD(L3, b_ + 12288); TRRD(H3, b_ + 14336); } while (0)
#define MM_D0(d0, L0, H0, L1, H1, L2, H2, L3, H3) do { __builtin_amdgcn_s_setprio(1); \
        o[d0] = __builtin_amdgcn_mfma_f32_32x32x16_bf16(pa0, (bf16x8){L0[0], L0[1], L0[2], L0[3], H0[0], H0[1], H0[2], H0[3]}, o[d0], 0, 0, 0);   \
        o[d0] = __builtin_amdgcn_mfma_f32_32x32x16_bf16(pa1, (bf16x8){L1[0], L1[1], L1[2], L1[3], H1[0], H1[1], H1[2], H1[3]}, o[d0], 0, 0, 0);   \
        o[d0] = __builtin_amdgcn_mfma_f32_32x32x16_bf16(pa2, (bf16x8){L2[0], L2[1], L2[2], L2[3], H2[0], H2[1], H2[2], H2[3]}, o[d0], 0, 0, 0);   \
        o[d0] = __builtin_amdgcn_mfma_f32_32x32x16_bf16(pa3, (bf16x8){L3[0], L3[1], L3[2], L3[3], H3[0], H3[1], H3[2], H3[3]}, o[d0], 0, 0, 0); __builtin_amdgcn_s_setprio(0); } while (0)
    s16x4 al0, ah0, al1, ah1, al2, ah2, al3, ah3, bl0, bh0, bl1, bh1, bl2, bh2, bl3, bh3;
    SBAR();
    RD_D0(0, al0, ah0, al1, ah1, al2, ah2, al3, ah3);
    RD_D0(1, bl0, bh0, bl1, bh1, bl2, bh2, bl3, bh3);
    asm volatile("s_waitcnt lgkmcnt(8)" ::: "memory"); SBAR();
    MM_D0(0, al0, ah0, al1, ah1, al2, ah2, al3, ah3); SBAR();
    RD_D0(2, al0, ah0, al1, ah1, al2, ah2, al3, ah3);
    asm volatile("s_waitcnt lgkmcnt(8)" ::: "memory"); SBAR();
    MM_D0(1, bl0, bh0, bl1, bh1, bl2, bh2, bl3, bh3); SBAR();
    RD_D0(3, bl0, bh0, bl1, bh1, bl2, bh2, bl3, bh3);
    asm volatile("s_waitcnt lgkmcnt(8)" ::: "memory"); SBAR();
    MM_D0(2, al0, ah0, al1, ah1, al2, ah2, al3, ah3); SBAR();
    asm volatile("s_waitcnt lgkmcnt(0)" ::: "memory"); SBAR();
    MM_D0(3, bl0, bh0, bl1, bh1, bl2, bh2, bl3, bh3);
#undef MM_D0
#undef RD_D0
#undef TRRD
}
struct BlockRef { const bf16* Q; const bf16* K; const bf16* V; bf16* O; const float* CB; int P0, jlo, h; };
__device__ __forceinline__ void glds16(const void* sbase, unsigned voff, unsigned lds_dst) { unsigned keep;
    asm volatile("s_mov_b32 %0, m0\n\ts_mov_b32 m0, %3\n\ts_nop 0\n\tglobal_load_lds_dwordx4 %1, %2\n\ts_mov_b32 m0, %0" : "=&s"(keep) : "v"(voff), "s"(sbase), "s"(lds_dst) : "memory"); }
__device__ __forceinline__ void glds4(const void* sbase, unsigned voff, unsigned lds_dst) { unsigned keep;
    asm volatile("s_mov_b32 %0, m0\n\ts_mov_b32 m0, %3\n\ts_nop 0\n\tglobal_load_lds_dword %1, %2\n\ts_mov_b32 m0, %0" : "=&s"(keep) : "v"(voff), "s"(sbase), "s"(lds_dst) : "memory"); }
#define WAIT_BAR(N) asm volatile("s_waitcnt vmcnt(" #N ") lgkmcnt(0)\n\ts_barrier" ::: "memory")
#define LD8(p) (*reinterpret_cast<const bf16x8*>(p))
template <int MODE>
__device__ __forceinline__ void attn_block(const BlockRef& cur, char* lds) {
    constexpr bool SK = (MODE == 0);
    constexpr int NDMA = (MODE == 1) ? 5 : 4;
    int tid = threadIdx.x; asm volatile("" : "+v"(tid));
    const int wid = __builtin_amdgcn_readfirstlane(tid >> 6), lane = tid & 63, r32 = lane & 31, hi = lane >> 5;
    const int j_lo = cur.jlo, NT = cur.P0 / KVBLK + QB / KVBLK - j_lo;
    const int qlo = cur.P0 + wid * QBLK, qm = qlo + r32 - 4 * hi;
    float* ws = (float*)(lds + OFF_WS) + wid * 64; float* li_l = ws, * al_l = ws + 32;
    const float* tbh = (const float*)(lds + OFF_TB) + cur.h * 256;
    float m_reg = -1e30f, l_reg = 0; f32x16 o[4] = {};
    const unsigned lds0 = (unsigned)(uintptr_t)lds;
    const int vb0 = (int)lds0 + OFF_V + v_rd_base(lane);
    unsigned koff0, koff1, voff0, voff1;
    { const int pc = wid * 2; int row = pc * 4 + (lane >> 4), c = (lane & 15) ^ (row & 7); koff0 = (unsigned)((row * LDQ + c * 8) * 2);
      row += 4; c = (lane & 15) ^ (row & 7); koff1 = (unsigned)((row * LDQ + c * 8) * 2);
      int st = 2 * pc + (lane >> 5), kk = ((st >> 2) << 3) | ((lane & 31) >> 2), k = (kk & ~0xC) | ((kk & 4) << 1) | ((kk & 8) >> 1); voff0 = (unsigned)((k * LDQ + (st & 3) * 32 + (lane & 3) * 8) * 2);
      st += 2; kk = ((st >> 2) << 3) | ((lane & 31) >> 2); k = (kk & ~0xC) | ((kk & 4) << 1) | ((kk & 8) >> 1); voff1 = (unsigned)((k * LDQ + (st & 3) * 32 + (lane & 3) * 8) * 2); }
    const unsigned kdst = lds0 + OFF_K + wid * 2048, vdst = lds0 + OFF_V + wid * 2048, cdst = lds0 + OFF_CL, lane4 = (unsigned)lane * 4u;
#define TIDX(t) (MODE == 1 ? (j_lo + NT - 1 - (t)) : (j_lo + (t)))
#define TILEB(t) ((size_t)TIDX(t) * (KVBLK * LDQ * 2))
#define DMA_K(t, slot) do { const char* g_ = (const char*)cur.K + TILEB(t); glds16(g_, koff0, kdst + (slot)); glds16(g_, koff1, kdst + (slot) + 1024); \
                            if (MODE == 1) glds4(cur.CB + (size_t)TIDX(t) * KVBLK, lane4, cdst + ((slot) >> 6)); } while (0)
#define DMA_V(t, slot) do { const char* g_ = (const char*)cur.V + TILEB(t); glds16(g_, voff0, vdst + (slot)); glds16(g_, voff1, vdst + (slot) + 1024); } while (0)
#define RESC(a) do { if (__any((a) < 1.f)) { if (hi == 0) al_l[r32] = (a); asm volatile("s_waitcnt lgkmcnt(0)" ::: "memory");              \
                     for (int d_ = 0; d_ < 4; ++d_) for (int r = 0; r < 16; ++r) o[d_][r] *= al_l[crow(r, hi)]; } } while (0)
#define KBASE(t) (TIDX(t) * KVBLK)
#define ACT(t) (MODE == 0 ? (KBASE(t) <= qlo) : true)
#define MASKT(P0_, P1_, t) do { const int kb_ = KBASE(t);                                                                              \
        if (MODE == 1) { if (kb_ + KVBLK - 1 > qlo) mask_tile(P0_, P1_, qm - kb_, 0x40000000u); }                                       \
        else { if (kb_ <= qlo && kb_ + KVBLK - 1 - qlo >= -90) add_bias(P0_, P1_, tbh, kb_ - qm + 192); } } while (0)
    DMA_K(0, 0); DMA_V(0, 0); DMA_K(1, SHM_K);
    bf16x8 qr[8];
    { const unsigned qo = (unsigned)(((wid * QBLK + r32) * LDQ + hi * 8) * 2);
#pragma unroll
      for (int d0 = 0; d0 < 8; ++d0) qr[d0] = LD8((const char*)cur.Q + qo + d0 * 32); }
    WAIT_BAR(0);
    int sl_prev = 2 * SHM_K, sl_cur = 0, sl_nxt = SHM_K;
#define ROT() do { const int t_ = sl_prev; sl_prev = sl_cur; sl_cur = sl_nxt; sl_nxt = t_; } while (0)
    f32x16 pA0, pA1, pB0, pB1; float mnA, mnB, alA, alB; bf16x8 pa0, pa1, pa2, pa3;
    DMA_K(2, sl_prev); DMA_V(1, sl_nxt);
    SBAR(); qkt<SK, MODE>(pA0, pA1, lds, sl_cur, sl_cur >> 8, r32, hi, qr, ACT(0));
    MASKT(pA0, pA1, 0); partialSM(pA0, pA1, m_reg, mnA, alA);
    if (2 < NT) { if (MODE == 1) WAIT_BAR(5); else WAIT_BAR(4); } else WAIT_BAR(0);
    ROT();
#define STEP(PL, PX0, PX1, mnX, alX, PY0, PY1, alY, s) do {                                                                    \
        if ((PL) || (s) + 2 < NT) DMA_K((s) + 2, sl_prev);                                                                     \
        if ((PL) || (s) + 1 < NT) DMA_V((s) + 1, sl_nxt);                                                                      \
        SBAR(); qkt<(SK && !(PL)), MODE>(PX0, PX1, lds, sl_cur, sl_cur >> 8, r32, hi, qr, ACT(s));                             \
        finishSM(PY0, PY1, alY, l_reg, pa0, pa1, pa2, pa3); SBAR();                                                            \
        pv_tile<(SK && !(PL))>(o, vb0 + sl_prev, pa0, pa1, pa2, pa3, ACT((s) - 1)); if (!(PL) || MODE == 1) MASKT(PX0, PX1, (s)); partialSM(PX0, PX1, m_reg, mnX, alX); \
        RESC(alX);                                                                                                             \
        if ((PL) || (s) + 2 < NT) { if (MODE == 1) WAIT_BAR(5); else WAIT_BAR(4); } else WAIT_BAR(0);                          \
        ROT(); } while (0)
    int s = 1;
    { const int NH = NT - (MODE == 0 ? 6 : 0) - 2;
      for (; s + 1 < NH; s += 2) {
        STEP(true, pB0, pB1, mnB, alB, pA0, pA1, alA, s);
        STEP(true, pA0, pA1, mnA, alA, pB0, pB1, alB, s + 1);
      } }
    for (; s + 1 < NT; s += 2) {
        STEP(false, pB0, pB1, mnB, alB, pA0, pA1, alA, s);
        STEP(false, pA0, pA1, mnA, alA, pB0, pB1, alB, s + 1);
    }
    if (s < NT) {
        STEP(false, pB0, pB1, mnB, alB, pA0, pA1, alA, s);
        finishSM(pB0, pB1, alB, l_reg, pa0, pa1, pa2, pa3); SBAR(); pv_tile<SK>(o, vb0 + sl_prev, pa0, pa1, pa2, pa3, ACT(NT - 1));
    } else {
        finishSM(pA0, pA1, alA, l_reg, pa0, pa1, pa2, pa3); SBAR(); pv_tile<SK>(o, vb0 + sl_prev, pa0, pa1, pa2, pa3, ACT(NT - 1));
    }
    if (hi == 0) li_l[r32] = l_reg; asm volatile("s_waitcnt lgkmcnt(0)" ::: "memory");
    float rli[16];
#pragma unroll
    for (int r = 0; r < 16; ++r) rli[r] = __builtin_amdgcn_rcpf(li_l[crow(r, hi)]);
    char* Ow = (char*)cur.O; const unsigned oo = (unsigned)(((wid * QBLK + 4 * hi) * LDO + r32) * 2);
#pragma unroll
    for (int r = 0; r < 16; ++r) { const unsigned orow = (unsigned)(((r & 3) + 8 * (r >> 2)) * LDO * 2);
#pragma unroll
        for (int d0 = 0; d0 < 4; ++d0) { const float v = o[d0][r] * rli[r];
            const float vn = __shfl_xor(v, 1);
            if ((r32 & 1) == 0) *(unsigned*)(Ow + (oo + orow + d0 * 64)) = cvtpk(v, vn); } }
    asm volatile("s_waitcnt lgkmcnt(0)\n\ts_barrier" ::: "memory");
#undef TILEB
#undef TIDX
#undef DMA_K
#undef DMA_V
#undef RESC
#undef KBASE
#undef ACT
#undef MASKT
#undef ROT
#undef STEP
}
#undef WAIT_BAR
#undef LD8
#undef SBAR
#undef KSWZ
}
#define GAS __attribute__((address_space(1)))
#define LAS __attribute__((address_space(3)))
typedef unsigned short bf16;
typedef unsigned v4u __attribute__((ext_vector_type(4)));
typedef unsigned v2u __attribute__((ext_vector_type(2)));
typedef float f32x4 __attribute__((ext_vector_type(4)));
constexpr int NWAVES = 8;
constexpr int BATCH = 2, SEQ = 16384, DM = 2048, TOK = BATCH * SEQ, FF = 8192, NQKV = 6144, NQKV1 = 6400, FH = 16;
constexpr float NORM_EPS = 1e-6f, SUBLN_EPS = 1e-5f, LAMBDA_INIT = 0.2f;
constexpr size_t MiB = 1u << 20;
constexpr size_t WS_F = 0, WS_CB = 2 * MiB;
constexpr size_t WS_WQKV0 = 4 * MiB, WS_WOA = 28 * MiB, WS_WMI0 = 36 * MiB, WS_WMO0 = 68 * MiB, WS_WQKV1 = 100 * MiB, WS_WOB = 126 * MiB, WS_WMI1 = 134 * MiB, WS_WMO1 = 166 * MiB;
constexpr size_t WS_NRM = 198 * MiB;
constexpr size_t WS_RS = 198 * MiB + 65536;
constexpr size_t WS_BAR = 199 * MiB;
constexpr size_t WS_HB = 712 * MiB;
constexpr size_t WS_QKV = 200 * MiB;
constexpr size_t WS_OC = 584 * MiB;
constexpr size_t WS_HID = 200 * MiB;
constexpr size_t WS_XN = 840 * MiB;
constexpr size_t WS_END = 968 * MiB;
constexpr int LDS_BYTES = 147456;

__device__ __forceinline__ GAS unsigned char* launder_g(GAS unsigned char* p) { asm volatile("" : "+s"(p)); return p; }
__device__ __forceinline__ unsigned f2bf(float f) { unsigned u = __builtin_bit_cast(unsigned, f); return (u + 0x7fffu + ((u >> 16) & 1u)) >> 16; }
__device__ __forceinline__ unsigned pk2(float lo, float hi) { return f2bf(lo) | (f2bf(hi) << 16); }
__device__ __forceinline__ float bf2f(unsigned short b) { return __builtin_bit_cast(float, (unsigned)b << 16); }
__device__ __forceinline__ float wave_sum(float v) {
#pragma unroll
    for (int o = 1; o < 64; o <<= 1) v += __shfl_xor(v, o);
    return v;
}
__device__ __forceinline__ void transpose_item(const float* W, int K, int N, bf16* WT, int row_off, const float* g, LAS float* scr, int item, int lane) {
    const int nblk = N / 64, kb = item / nblk, nb = item % nblk, k0 = 64 * kb, n0 = 64 * nb, kr = lane >> 4, nq = lane & 15;
    f32x4 v[16];
#pragma unroll
    for (int i = 0; i < 16; ++i) v[i] = *(const f32x4*)(W + (size_t)(k0 + 4 * i + kr) * N + n0 + 4 * nq);
#pragma unroll
    for (int i = 0; i < 16; ++i) { const int kk = 4 * i + kr; f32x4 t = v[i]; if (g) t = t * g[k0 + kk];
        scr[(4 * nq + 0) * 65 + kk] = t[0]; scr[(4 * nq + 1) * 65 + kk] = t[1]; scr[(4 * nq + 2) * 65 + kk] = t[2]; scr[(4 * nq + 3) * 65 + kk] = t[3]; }
    asm volatile("s_waitcnt lgkmcnt(0)" ::: "memory");
    const int c = lane & 7;
#pragma unroll
    for (int j = 0; j < 8; ++j) { const int n = (lane >> 3) + 8 * j; const LAS float* sp = scr + n * 65 + 8 * c;
        v4u o; o.x = pk2(sp[0], sp[1]); o.y = pk2(sp[2], sp[3]); o.z = pk2(sp[4], sp[5]); o.w = pk2(sp[6], sp[7]);
        *(v4u*)(WT + (size_t)(row_off + n0 + n) * K + k0 + 8 * c) = o; }
    asm volatile("s_waitcnt lgkmcnt(0)" ::: "memory");
}
__device__ __forceinline__ void norm_row_to_bf16(const float* xrow, bf16* orow, int lane) {
    const f32x4* xr = (const f32x4*)xrow + lane;
    f32x4 v[8]; float s = 0.f;
#pragma unroll
    for (int j = 0; j < 8; ++j) { v[j] = xr[64 * j]; s += (v[j].x * v[j].x + v[j].y * v[j].y) + (v[j].z * v[j].z + v[j].w * v[j].w); }
    const float rstd = 1.f / sqrtf(wave_sum(s) * (1.f / DM) + NORM_EPS);
    v2u* o8 = (v2u*)orow + lane;
#pragma unroll
    for (int j = 0; j < 8; ++j) { v2u w; w.x = pk2(v[j].x * rstd, v[j].y * rstd); w.y = pk2(v[j].z * rstd, v[j].w * rstd); o8[64 * j] = w; }
}
__device__ __forceinline__ void norm_phase(const float* src, bf16* dst, int gw, int NGW, int lane) {
    for (int m = gw; m < TOK; m += NGW) norm_row_to_bf16(src + (size_t)m * DM, dst + (size_t)m * DM, lane);
}
__device__ __forceinline__ void final_norm_phase(float* io, const float* g, const float* rs, int gw, int NGW, int lane) {
    for (int m = gw; m < TOK; m += NGW) {
        f32x4* xr = (f32x4*)(io + (size_t)m * DM) + lane; const f32x4* gr = (const f32x4*)g + lane;
        const float rstd = 1.f / sqrtf(rs[m] * (1.f / DM) + NORM_EPS);
#pragma unroll
        for (int j = 0; j < 8; ++j) xr[64 * j] = xr[64 * j] * rstd * gr[64 * j];
    }
}
__device__ __forceinline__ void combine_phase(const bf16* OC, bf16* O, const float* lq1, const float* lk1, const float* lq2, const float* lk2, const float* sg, int gw, int NGW, int lane) {
    const float s1 = wave_sum(lq1[lane] * lk1[lane] + lq1[lane + 64] * lk1[lane + 64]), s2 = wave_sum(lq2[lane] * lk2[lane] + lq2[lane + 64] * lk2[lane + 64]);
    const float lam = expf(s1) - expf(s2) + LAMBDA_INIT;
    float gs[8];
#pragma unroll
    for (int e = 0; e < 8; ++e) gs[e] = sg[(lane & 31) * 8 + e] * (1.f - LAMBDA_INIT);
    for (int m = gw; m < TOK; m += NGW) {
        const v4u* a = (const v4u*)(OC + (size_t)m * DM) + lane; const v4u* b = (const v4u*)(OC + (size_t)TOK * DM + (size_t)m * DM) + lane; v4u* o = (v4u*)(O + (size_t)m * DM) + lane;
#pragma unroll
        for (int st = 0; st < 4; ++st) { const v4u av = a[64 * st], bv = b[64 * st]; float d[8]; float ss = 0.f;
#pragma unroll
            for (int e = 0; e < 4; ++e) { const unsigned aw = av[e], bw = bv[e];
                d[2 * e] = __builtin_bit_cast(float, aw << 16) - lam * __builtin_bit_cast(float, bw << 16);
                d[2 * e + 1] = __builtin_bit_cast(float, aw & 0xffff0000u) - lam * __builtin_bit_cast(float, bw & 0xffff0000u);
                ss += d[2 * e] * d[2 * e] + d[2 * e + 1] * d[2 * e + 1]; }
#pragma unroll
            for (int of = 1; of < 32; of <<= 1) ss += __shfl_xor(ss, of);
            const float rstd = 1.f / sqrtf(ss * (1.f / 256.f) + SUBLN_EPS);
            v4u w; w.x = pk2(d[0] * rstd * gs[0], d[1] * rstd * gs[1]); w.y = pk2(d[2] * rstd * gs[2], d[3] * rstd * gs[3]);
            w.z = pk2(d[4] * rstd * gs[4], d[5] * rstd * gs[5]); w.w = pk2(d[6] * rstd * gs[6], d[7] * rstd * gs[7]); o[64 * st] = w; }
    }
}
__device__ __forceinline__ void cumsum_phase(const float* F, const float* bfb, float* CB, LAS unsigned char* lds, int bx, int G, int tid) {
    LAS double* sc = (LAS double*)lds;
    for (int bh = bx; bh < BATCH * FH; bh += G) {
        const int b = bh / FH, h = bh % FH; const float bias = bfb[h];
        const float* fp = F + ((size_t)b * SEQ + (size_t)tid * 32) * FH + h;
        float ls[32]; double run = 0.0;
#pragma unroll
        for (int i = 0; i < 32; ++i) { const float x = fp[(size_t)i * FH] + bias; ls[i] = fminf(x, 0.f) - log1pf(expf(-fabsf(x))); run += (double)ls[i]; }
        sc[tid] = run; __syncthreads();
        int cur = 0;
        for (int of = 1; of < 512; of <<= 1) { double v = sc[cur * 512 + tid]; if (tid >= of) v += sc[cur * 512 + tid - of]; sc[(cur ^ 1) * 512 + tid] = v; cur ^= 1; __syncthreads(); }
        double acc = sc[cur * 512 + tid] - run;
        float* op = CB + (size_t)bh * SEQ + (size_t)tid * 32;
#pragma unroll
        for (int i = 0; i < 32; ++i) { acc += (double)ls[i]; op[i] = (float)(-acc * 11.313708498984761); }
        __syncthreads();
    }
}

__device__ __forceinline__ void rownorm_phase(const bf16* QKV, unsigned* NRM, int bx, int G, int tid) {
    for (int vw = bx; vw < 256; vw += G) {
        const int bh = vw >> 3, part = vw & 7, b = bh >> 4, h = bh & 15;
        const char* base = (const char*)(QKV + ((size_t)(b * 16 + h) * SEQ + (size_t)part * 2048) * 128);
        const unsigned vo = (unsigned)(((tid >> 4) * 128 + (tid & 15) * 8) * 2);
        constexpr size_t KOFF = (size_t)32 * SEQ * 128 * 2;
        float mq = 0.f, mk = 0.f;
#pragma unroll 4
        for (int it = 0; it < 64; ++it) {
            const char* rp = base + (size_t)it * 32 * 128 * 2;
            const v4u qv = *(const v4u*)(rp + vo), kv = *(const v4u*)(rp + KOFF + vo);
            float sq = 0.f, sk = 0.f;
#pragma unroll
            for (int e = 0; e < 4; ++e) { const float a0 = __builtin_bit_cast(float, qv[e] << 16), a1 = __builtin_bit_cast(float, qv[e] & 0xffff0000u), b0 = __builtin_bit_cast(float, kv[e] << 16), b1 = __builtin_bit_cast(float, kv[e] & 0xffff0000u);
                sq += a0 * a0 + a1 * a1; sk += b0 * b0 + b1 * b1; }
#pragma unroll
            for (int of = 1; of < 16; of <<= 1) { sq += __shfl_xor(sq, of); sk += __shfl_xor(sk, of); }
            mq = fmaxf(mq, sq); mk = fmaxf(mk, sk);
        }
        mq = fmaxf(mq, __shfl_xor(mq, 16)); mq = fmaxf(mq, __shfl_xor(mq, 32)); mk = fmaxf(mk, __shfl_xor(mk, 16)); mk = fmaxf(mk, __shfl_xor(mk, 32));
        if ((tid & 63) == 0) { atomicMax(NRM + bh * 2, __float_as_uint(mq)); atomicMax(NRM + bh * 2 + 1, __float_as_uint(mk)); }
    }
}

#define XB_TMO      128
#define XB_XCNT(j)  (256  + 64 * (j))
#define XB_XSUB(j)  (1280 + 64 * (j))
#define XB_XGEN(j)  (2304 + 64 * (j))
#define XB_TOP      3328
#define XB_TOPGEN   3392
#define XCD_BAR_WORDS 3456
#define XB_SPIN_CAP (1u << 18)

__device__ __forceinline__ unsigned xb_ld(unsigned* p)              { return __hip_atomic_load(p, __ATOMIC_RELAXED, __HIP_MEMORY_SCOPE_AGENT); }
__device__ __forceinline__ unsigned xb_add(unsigned* p, unsigned v) { return __hip_atomic_fetch_add(p, v, __ATOMIC_RELAXED, __HIP_MEMORY_SCOPE_AGENT); }
__device__ __forceinline__ unsigned xb_xcc_id() { return (unsigned)__builtin_amdgcn_s_getreg((3 << 11) | 20) & 0xFu; }
#define XB_SPIN(cond, bar) do { unsigned _sp = 0; while (cond) { __builtin_amdgcn_s_sleep(1); \
    if ((++_sp & 255u) == 0u) { if (xb_ld(&(bar)[XB_TMO])) break; if (_sp > XB_SPIN_CAP) { atomicAdd(&(bar)[XB_TMO], 1u); break; } } } } while (0)

struct XcdBarrier {
    unsigned* bar; unsigned x;
    volatile LAS unsigned* st;
};

__device__ __forceinline__ XcdBarrier xcd_barrier_post(unsigned* bar, volatile LAS unsigned* st) {
    XcdBarrier b; b.bar = bar; b.x = xb_xcc_id(); b.st = st;
    if (threadIdx.x == 0) (void)xb_add(&bar[XB_XCNT(b.x)], 1u);
    return b;
}
__device__ __forceinline__ void xcd_barrier_complete(unsigned* bar, unsigned x, unsigned& nloc, unsigned& nx) {
    const unsigned G = gridDim.x * gridDim.y * gridDim.z;
    unsigned sum, cnt, mine, sp = 0u;
    for (;;) {
        sum = 0u; cnt = 0u; mine = 0u;
#pragma unroll
        for (unsigned j = 0; j < 16; ++j) { const unsigned c = xb_ld(&bar[XB_XCNT(j)]); sum += c; cnt += (c > 0u) ? 1u : 0u; mine = (j == x) ? c : mine; }
        if (sum == G) break;
        __builtin_amdgcn_s_sleep(1);
        if ((++sp & 255u) == 0u) { if (xb_ld(&bar[XB_TMO])) break; if (sp > XB_SPIN_CAP) { atomicAdd(&bar[XB_TMO], 1u); break; } }
    }
    nloc = mine > 0u ? mine : 1u; nx = cnt > 0u ? cnt : 1u;
}

__device__ __forceinline__ void xcd_barrier(const XcdBarrier& b) {
    asm volatile("s_waitcnt vmcnt(0)" ::: "memory");
    __syncthreads();
    if (threadIdx.x == 0) {
        unsigned* bar = b.bar;
        __builtin_amdgcn_s_waitcnt(0);
        unsigned nloc = b.st[0], nx = b.st[1];
        if (nloc == 0u) { xcd_barrier_complete(bar, b.x, nloc, nx); b.st[0] = nloc; b.st[1] = nx; }
        const unsigned old = xb_add(&bar[XB_XSUB(b.x)], 1u);
        const unsigned gen = old / nloc;
        if (old + 1u == (gen + 1u) * nloc) {
            __builtin_amdgcn_fence(__ATOMIC_RELEASE, "agent");
            asm volatile("s_waitcnt vmcnt(0)" ::: "memory");
            const unsigned og = xb_add(&bar[XB_TOP], 1u);
            const unsigned tg = og / nx;
            if (og + 1u == (tg + 1u) * nx) xb_add(&bar[XB_TOPGEN], 1u);
            else XB_SPIN(xb_ld(&bar[XB_TOPGEN]) == tg, bar);
            __builtin_amdgcn_fence(__ATOMIC_ACQUIRE, "agent");
            xb_add(&bar[XB_XGEN(b.x)], 1u);
            asm volatile("s_waitcnt vmcnt(0)" ::: "memory");
        } else {
            XB_SPIN(xb_ld(&bar[XB_XGEN(b.x)]) == gen, bar);
            __builtin_amdgcn_fence(__ATOMIC_ACQUIRE, "agent");
            asm volatile("s_waitcnt vmcnt(0)" ::: "memory");
        }
    }
    __syncthreads();
}

struct Args { const float* in[21]; float* out; unsigned char* ws; };
template <int MODE> __device__ __forceinline__ bool attn_item(int i, int G, int bx, int& s, int& x) {
    constexpr int NS = MODE == 0 ? 64 : 32;
    if ((G & 7) == 0) { const int xcd = bx & 7, k = bx >> 3, kpx = G >> 3; const int idx = k + i * kpx; if (idx >= (NS / 8) * 32) return false; s = (idx >> 5) * 8 + xcd; x = idx & 31; return true; }
    const int L = bx + i * G; if (L >= NS * 32) return false; s = L >> 5; x = L & 31; return true;
}
template <int MODE> __device__ __forceinline__ att::BlockRef attn_ref(int s, int qb, int jlo, const bf16* QKV, bf16* Obuf, const float* CB) {
    att::BlockRef r; r.P0 = qb * 256; r.jlo = jlo;
    constexpr size_t HS = (size_t)SEQ * 128;
    if (MODE == 0) { const int xcd = s & 7, sl = s >> 3, vh = sl & 1, c = (sl >> 1) & 1, bh = xcd * 2 + ((sl >> 2) & 1), b = bh >> 3, h = bh & 7;
        r.Q = QKV + (size_t)((0 + b) * 16 + h * 2 + c) * HS + (size_t)r.P0 * 128; r.K = QKV + (size_t)((2 + b) * 16 + h * 2 + c) * HS; r.V = QKV + (size_t)((4 + b) * 16 + h * 2 + vh) * HS;
        r.O = Obuf + (size_t)c * TOK * DM + ((size_t)b * SEQ + r.P0) * DM + h * 256 + vh * 128; r.CB = nullptr; r.h = h; }
    else { const int b = s >> 4, h = s & 15;
        r.Q = QKV + (size_t)((0 + b) * 16 + h) * HS + (size_t)r.P0 * 128; r.K = QKV + (size_t)((2 + b) * 16 + h) * HS; r.V = QKV + (size_t)((4 + b) * 16 + h) * HS;
        r.O = Obuf + ((size_t)b * SEQ + r.P0) * DM + h * 128; r.CB = CB + (size_t)s * SEQ; r.h = 0; }
    return r;
}
template <int MODE> __device__ __forceinline__ void attn_phase(char* lds, const bf16* QKV, bf16* Obuf, const float* CB, const unsigned* NRM, int G, int bx) {
    int* jt = (int*)(lds + att::OFF_TB);
    if (MODE == 1) {
        int tid = threadIdx.x; asm volatile("" : "+v"(tid)); const int w = __builtin_amdgcn_readfirstlane(tid >> 6), lane = tid & 63;
        if (tid < 64) jt[tid] = 0;
        __syncthreads();
        for (int e = w; e < 64; e += 8) { int s, x; if (!attn_item<MODE>(e >> 1, G, bx, s, x)) break;
            const int qb = (e & 1) ? 63 - x : x, jmax = qb * 4; const float* cb = CB + (size_t)s * SEQ;
            const float qn = sqrtf(__uint_as_float(NRM[s * 2])) * 1.01f, kn = sqrtf(__uint_as_float(NRM[s * 2 + 1])) * 1.01f;
            const float thr = cb[qb * 256] - 110.f * 11.313708498984761f - 2.f * qn * kn;
            int need = 0;
            for (int j0 = jmax - 1; j0 >= 0; j0 -= 64) { const int j = j0 - lane; const bool c = (j >= 0) && (cb[(j >= 0 ? j : 0) * 64 + 63] >= thr);
                const unsigned long long m = __ballot(c); const int n = __builtin_popcountll(m); need += n; if (n < 64) break; }
            if (lane == 0) jt[e] = jmax - need; }
        __syncthreads();
    }
    for (int i = 0; ; ++i) { int s, x; if (!attn_item<MODE>(i, G, bx, s, x)) break;
        for (int pass = 0; pass < 2; ++pass) {
            const int jl = (MODE == 1 && i < 32) ? jt[i * 2 + pass] : 0;
            const att::BlockRef cur = attn_ref<MODE>(s, pass ? 63 - x : x, jl, QKV, Obuf, CB);
            att::attn_block<MODE>(cur, lds); } }
}

__global__ void __launch_bounds__(NWAVES * 64, 2) yoco_fwd(Args args) {
    extern __shared__ __attribute__((aligned(16))) unsigned char lds[];
    cg::grid_group grid = cg::this_grid();
    LAS unsigned char* ldsl = (LAS unsigned char*)lds;
    const int G = gridDim.x, bx = blockIdx.x, NGW = G * NWAVES;
    int tid, lane, wave, gw;
#define FRESH() do { tid = threadIdx.x; asm volatile("" : "+v"(tid)); lane = tid & 63; wave = __builtin_amdgcn_readfirstlane(tid >> 6); gw = bx * NWAVES + wave; } while (0)
    FRESH();
#define WSP(T, off) ((T*)(launder_g((GAS unsigned char*)args.ws) + (off)))
#define Wqkv0 WSP(bf16, WS_WQKV0)
#define Woa WSP(bf16, WS_WOA)
#define Wmi0 WSP(bf16, WS_WMI0)
#define Wmo0 WSP(bf16, WS_WMO0)
#define Wqkv1 WSP(bf16, WS_WQKV1)
#define Wob WSP(bf16, WS_WOB)
#define Wmi1 WSP(bf16, WS_WMI1)
#define Wmo1 WSP(bf16, WS_WMO1)
#define QKV WSP(bf16, WS_QKV)
#define OC WSP(bf16, WS_OC)
#define HID WSP(bf16, WS_HID)
#define XN WSP(bf16, WS_XN)
#define Fb WSP(float, WS_F)
#define CB WSP(float, WS_CB)
#define NRM WSP(unsigned, WS_NRM)
#define RS WSP(float, WS_RS)
#define HB WSP(bf16, WS_HB)
#define out ((float*)launder_g((GAS unsigned char*)args.out))
#define XIN ((const float*)launder_g((GAS unsigned char*)args.in[0]))
    volatile LAS unsigned* xst = (volatile LAS unsigned*)(ldsl + LDS_BYTES - 64);
    if (tid < 2) xst[tid] = 0u;
    __syncthreads();
    const XcdBarrier xbar = xcd_barrier_post(WSP(unsigned, WS_BAR), xst);

    {
        LAS float* scr = (LAS float*)(ldsl + wave * 16640);
        bf16* const wqkv1 = Wqkv1;
        const float* ag = args.in[2]; const float* mg = args.in[3]; const float* kg = args.in[11];
        constexpr int I_QKV = (DM / 64) * (NQKV / 64), I_DD = (DM / 64) * (DM / 64), I_MI = (DM / 64) * (FF / 64), I_MO = (FF / 64) * (DM / 64);
        constexpr int NITEMS = I_QKV + 5 * I_DD + 2 * I_MI + 2 * I_MO;
        for (int it = gw; it < NITEMS; it += NGW) {
            int r = it;
            if (r < I_QKV) { transpose_item(args.in[4], DM, NQKV, Wqkv0, 0, ag, scr, r, lane); continue; } r -= I_QKV;
            if (r < I_DD) { transpose_item(args.in[10], DM, DM, Woa, 0, nullptr, scr, r, lane); continue; } r -= I_DD;
            if (r < I_DD) { transpose_item(args.in[16], DM, DM, wqkv1, 0, ag + DM, scr, r, lane); continue; } r -= I_DD;
            if (r < I_DD) { transpose_item(args.in[12], DM, DM, wqkv1, DM, kg, scr, r, lane); continue; } r -= I_DD;
            if (r < I_DD) { transpose_item(args.in[13], DM, DM, wqkv1, 2 * DM, kg, scr, r, lane); continue; } r -= I_DD;
            if (r < I_DD) { transpose_item(args.in[17], DM, DM, Wob, 0, nullptr, scr, r, lane); continue; } r -= I_DD;
            if (r < I_MI) { transpose_item(args.in[18], DM, FF, Wmi0, 0, mg, scr, r, lane); continue; } r -= I_MI;
            if (r < I_MI) { transpose_item(args.in[18] + (size_t)DM * FF, DM, FF, Wmi1, 0, mg + DM, scr, r, lane); continue; } r -= I_MI;
            if (r < I_MO) { transpose_item(args.in[19], FF, DM, Wmo0, 0, nullptr, scr, r, lane); continue; } r -= I_MO;
            transpose_item(args.in[19] + (size_t)FF * DM, FF, DM, Wmo1, 0, nullptr, scr, r, lane);
        }
        { const float* wf = args.in[14]; const int gt = bx * 512 + tid, NT_ = G * 512;
          for (int e = gt; e < (NQKV1 - NQKV) * DM; e += NT_) { const int n = e / DM, k = e % DM; wqkv1[(size_t)(NQKV + n) * DM + k] = (n < FH) ? (bf16)f2bf(wf[(size_t)k * FH + n] * kg[k]) : (bf16)0; } }
        if (bx == 0 && tid < 64) NRM[tid] = 0u;
        { float* rsz = RS; for (int e = bx * 512 + tid; e < 4 * TOK; e += G * 512) rsz[e] = 0.f; }
        norm_phase(XIN, XN, gw, NGW, lane);
    }
    grid.sync();
#define GSYNC() xcd_barrier(xbar)
#define GEMM_PHASE(EPI, A_, B_, N_, K_, ...) do { pg8::Gemm g{A_, B_, TOK, N_, K_}; pg8::StaticOrder S; S.init(TOK, N_, G, bx); EPI E{__VA_ARGS__}; \
        pg8::gemm_phase<EPI, pg8::StaticOrder, PG8_ALIGN, PG8_SP2>(ldsl, g, S, E); } while (0)
    typedef pg8::EpiX<0, false, false, false> EpiQKV0; typedef pg8::EpiX<3, true, false, false> EpiQKV1; typedef pg8::EpiX<1, true, false, false> EpiMlpIn;
    typedef pg8::EpiX<2, false, true, true> EpiRes; typedef pg8::EpiX<2, false, false, true> EpiResLast;
    GEMM_PHASE(EpiQKV0, XN, Wqkv0, NQKV, DM, QKV, NQKV, nullptr, nullptr, nullptr, nullptr, nullptr);
    GSYNC();
    {
      FRESH(); const float* tab = args.in[1]; float* tb = (float*)(lds + att::OFF_TB);
      for (int idx = tid; idx < 2048; idx += 512) { const int h = idx >> 8, rel = (idx & 255) - 192; const int n = rel < 0 ? -rel : rel;
          int bk = n < 8 ? n : 8 + (n >= 12) + (n >= 16) + (n >= 23) + (n >= 32) + (n >= 46) + (n >= 64) + (n >= 91); if (rel > 0) bk += 16;
          tb[idx] = (tab[bk * 8 + h] - tab[15 * 8 + h]) * 11.313708498984761f; }
      __syncthreads();
      attn_phase<0>((char*)lds, QKV, OC, nullptr, nullptr, G, bx);
    }
    GSYNC();
    FRESH(); combine_phase(OC, XN, args.in[5], args.in[6], args.in[7], args.in[8], args.in[9], gw, NGW, lane);
    GSYNC();
    GEMM_PHASE(EpiRes, XN, Woa, DM, DM, HB, DM, XIN, out, nullptr, nullptr, RS);
    GSYNC();
    GEMM_PHASE(EpiMlpIn, HB, Wmi0, FF, DM, HID, FF, nullptr, nullptr, nullptr, RS, nullptr);
    GSYNC();
    GEMM_PHASE(EpiRes, HID, Wmo0, DM, FF, XN, DM, out, out, nullptr, nullptr, RS + TOK);
    GSYNC();
    GEMM_PHASE(EpiQKV1, XN, Wqkv1, NQKV1, DM, QKV, NQKV, nullptr, nullptr, Fb, RS + TOK, nullptr);
    GSYNC();
    FRESH(); cumsum_phase(Fb, args.in[15], CB, ldsl, bx, G, tid);
    rownorm_phase(QKV, NRM, bx, G, tid);
    GSYNC();
    attn_phase<1>((char*)lds, QKV, XN, CB, NRM, G, bx);
    GSYNC();
    GEMM_PHASE(EpiRes, XN, Wob, DM, DM, HB, DM, out, out, nullptr, nullptr, RS + 2 * TOK);
    GSYNC();
    GEMM_PHASE(EpiMlpIn, HB, Wmi1, FF, DM, HID, FF, nullptr, nullptr, nullptr, RS + 2 * TOK, nullptr);
    GSYNC();
    GEMM_PHASE(EpiResLast, HID, Wmo1, DM, FF, nullptr, DM, out, out, nullptr, nullptr, RS + 3 * TOK);
    GSYNC();
    FRESH(); final_norm_phase(out, args.in[20], RS + 3 * TOK, gw, NGW, lane);
}

#undef out
#undef XIN
extern "C" void kernel_launch(void* const* d_in, const int* in_sizes, int n_in, void* d_out, int out_size, void* d_ws, size_t ws_size, hipStream_t stream) {
    static int grid = 0;
    if (grid == 0) {
        if (n_in != 21 || in_sizes[0] != TOK * DM || out_size != TOK * DM || ws_size < WS_END) { fprintf(stderr, "kernel_launch: unexpected shapes (n_in %d, in0 %d, out %d, ws %zu)\n", n_in, n_in > 0 ? in_sizes[0] : -1, out_size, ws_size); grid = -1; return; }
        int dev = 0, cus = 0, per_cu = 0;
        (void)hipGetDevice(&dev); (void)hipDeviceGetAttribute(&cus, hipDeviceAttributeMultiprocessorCount, dev);
        if (hipFuncSetAttribute((const void*)yoco_fwd, hipFuncAttributeMaxDynamicSharedMemorySize, LDS_BYTES) != hipSuccess) { fprintf(stderr, "kernel_launch: hipFuncSetAttribute failed\n"); grid = -1; return; }
        if (hipOccupancyMaxActiveBlocksPerMultiprocessor(&per_cu, (const void*)yoco_fwd, NWAVES * 64, LDS_BYTES) != hipSuccess || per_cu < 1) { fprintf(stderr, "kernel_launch: occupancy query gives %d\n", per_cu); per_cu = 1; }
        (void)hipGetLastError();
        grid = cus > 0 ? cus : 256;
    }
    if (grid < 0) return;
    if (hipMemsetAsync((char*)d_ws + WS_BAR, 0, 16384, stream) != hipSuccess) { fprintf(stderr, "kernel_launch: hipMemsetAsync failed\n"); return; }
    Args a{};
    for (int i = 0; i < 21; ++i) a.in[i] = (const float*)d_in[i];
    a.out = (float*)d_out; a.ws = (unsigned char*)d_ws;
    void* kargs[] = {&a};
    hipError_t e = hipLaunchCooperativeKernel((const void*)yoco_fwd, dim3(grid), dim3(NWAVES * 64), kargs, LDS_BYTES, stream);
    if (e != hipSuccess) fprintf(stderr, "kernel_launch: cooperative launch failed: %s (grid %d)\n", hipGetErrorString(e), grid);
}
```
